# Optimizing an MI355X kernel written in HIP

```python
import math
import jax, jax.numpy as jnp
from jax import lax
import numpy as np

D_MODEL = 4096
BATCH = 1
SEQ = 8192
DEPTH = 1
DEC_BATCH = 4
DEC_SEQ = 4096
PAST_LEN = 128

N_META = 16
GRID_W = 64
WIN_H_MAX = 8
WIN_W = 16
NA_HEADS = 16
NA_DH = 128
NA_WIDTH = NA_HEADS * NA_DH
DIFF_HEADS = 8
DIFF_DH = 128
DIFF_WIDTH = DIFF_HEADS * 2 * DIFF_DH
MIX_WIDTH = NA_WIDTH + DIFF_WIDTH
IN_WIDTH = 3 * NA_WIDTH + 3 * DIFF_WIDTH
D_FF = 11008
ROPE_THETA = 500000.0
ROPE_DIM = DIFF_DH // 4
Q_BLOCK = 128
EPS = 1e-6
SUBLN_EPS = 1e-5

kernel_name = "hymba_natten_diffattn_macaron_encoder"


def rms_norm(x, g, eps=EPS):
    xf = x.astype(jnp.float32)
    y = xf * lax.rsqrt(jnp.mean(xf * xf, axis=-1, keepdims=True) + eps)
    return (y * g.astype(jnp.float32)).astype(x.dtype)


def swiglu(x, wg, wu, wd):
    return (jax.nn.silu(x @ wg) * (x @ wu)) @ wd


def rope_partial(x, pos):
    half = ROPE_DIM // 2
    inv = ROPE_THETA ** (-2.0 * jnp.arange(half, dtype=jnp.float32) / ROPE_DIM)
    ang = pos.astype(jnp.float32)[:, None] * inv[None, :]
    cos = jnp.cos(ang)[None, :, None, :]
    sin = jnp.sin(ang)[None, :, None, :]
    xr = x[..., :ROPE_DIM].astype(jnp.float32)
    x1, x2 = xr[..., :half], xr[..., half:]
    rot = jnp.concatenate([x1 * cos - x2 * sin, x1 * sin + x2 * cos], axis=-1).astype(x.dtype)
    return jnp.concatenate([rot, x[..., ROPE_DIM:]], axis=-1)


def neighbourhood_attention(q, k, v, rpb):
    B, L, H, dh = q.shape
    S = L - N_META
    rows = S // GRID_W
    kh = min(WIN_H_MAX, rows)
    scale = NA_DH ** -0.5
    qm, km, vm = q[:, :N_META], k[:, :N_META], v[:, :N_META]
    qg = q[:, N_META:].reshape(B, rows, GRID_W, H, dh)
    kg = k[:, N_META:].reshape(B, rows, GRID_W, H, dh)
    vg = v[:, N_META:].reshape(B, rows, GRID_W, H, dh)
    row_start = np.clip(np.arange(rows) - kh // 2, 0, rows - kh)
    col_start = np.clip(np.arange(GRID_W) - WIN_W // 2, 0, GRID_W - WIN_W)
    col_idx = col_start[:, None] + np.arange(WIN_W)
    dc = col_idx - np.arange(GRID_W)[:, None] + (WIN_W - 1)

    def row_block(args):
        q_row, r, r0 = args
        k_band = lax.dynamic_slice_in_dim(kg, r0, kh, axis=1)
        v_band = lax.dynamic_slice_in_dim(vg, r0, kh, axis=1)
        k_win = k_band[:, :, col_idx]
        v_win = v_band[:, :, col_idx]
        dr = r0 + jnp.arange(kh) - r + (WIN_H_MAX - 1)
        bias = rpb[:, dr[None, :, None], dc[:, None, :]]
        s_win = jnp.einsum('bchd,bicjhd->bhcij', q_row, k_win,
                           preferred_element_type=jnp.float32) * scale + bias.astype(jnp.float32)[None]
        s_meta = jnp.einsum('bchd,bmhd->bhcm', q_row, km,
                            preferred_element_type=jnp.float32) * scale
        s = jnp.concatenate([s_win.reshape(B, H, GRID_W, kh * WIN_W), s_meta], axis=-1)
        p = jax.nn.softmax(s, axis=-1).astype(v.dtype)
        p_win = p[..., :kh * WIN_W].reshape(B, H, GRID_W, kh, WIN_W)
        p_meta = p[..., kh * WIN_W:]
        return (jnp.einsum('bhcij,bicjhd->bchd', p_win, v_win)
                + jnp.einsum('bhcm,bmhd->bchd', p_meta, vm))

    out_rows = lax.map(row_block, (jnp.moveaxis(qg, 1, 0),
                                   jnp.arange(rows, dtype=jnp.int32),
                                   jnp.asarray(row_start, dtype=jnp.int32)))
    out_real = jnp.moveaxis(out_rows, 0, 1).reshape(B, S, H, dh)
    s_mm = jnp.einsum('bqhd,bkhd->bhqk', qm, km, preferred_element_type=jnp.float32) * scale
    out_meta = jnp.einsum('bhqk,bkhd->bqhd', jax.nn.softmax(s_mm, axis=-1).astype(v.dtype), vm)
    return jnp.concatenate([out_meta, out_real], axis=1)


def diff_attend(q, k, v, lam):
    s = jnp.einsum('bqhmd,bkhmd->bhmqk', q, k, preferred_element_type=jnp.float32) * (DIFF_DH ** -0.5)
    p = jax.nn.softmax(s, axis=-1)
    a = p[:, :, 0] - lam * p[:, :, 1]
    return jnp.einsum('bhqk,bkhe->bqhe', a.astype(v.dtype), v)


def differential_attention(q, k, v, lam):
    B, L = q.shape[0], q.shape[1]
    S = L - N_META
    nb = S // Q_BLOCK
    q_real = q[:, N_META:].reshape((B, nb, Q_BLOCK) + q.shape[2:])
    out_blocks = lax.map(lambda qb: diff_attend(qb, k, v, lam), jnp.moveaxis(q_real, 1, 0))
    out_real = jnp.moveaxis(out_blocks, 0, 1).reshape(B, S, DIFF_HEADS, 2 * DIFF_DH)
    out_meta = diff_attend(q[:, :N_META], k, v, lam)
    return jnp.concatenate([out_meta, out_real], axis=1)


def token_mixing(hn, pos, layer, w_in, na_rpb, na_norm, diff_lq1, diff_lk1, diff_lq2, diff_lk2,
                 diff_norm, w_out):
    B, L, _ = hn.shape
    proj = hn @ w_in
    cuts = np.cumsum([NA_WIDTH, NA_WIDTH, NA_WIDTH, DIFF_WIDTH, DIFF_WIDTH])
    q_na, k_na, v_na, q_d, k_d, v_d = jnp.split(proj, cuts, axis=-1)
    na_shape = (B, L, NA_HEADS, NA_DH)
    na_out = neighbourhood_attention(q_na.reshape(na_shape), k_na.reshape(na_shape),
                                     v_na.reshape(na_shape), na_rpb)
    na_out = rms_norm(na_out, na_norm).reshape(B, L, NA_WIDTH)
    qd = rope_partial(q_d.reshape(B, L, DIFF_HEADS * 2, DIFF_DH), pos).reshape(B, L, DIFF_HEADS, 2, DIFF_DH)
    kd = rope_partial(k_d.reshape(B, L, DIFF_HEADS * 2, DIFF_DH), pos).reshape(B, L, DIFF_HEADS, 2, DIFF_DH)
    vd = v_d.reshape(B, L, DIFF_HEADS, 2 * DIFF_DH)
    lam_init = 0.8 - 0.6 * math.exp(-0.3 * layer)
    lam = (jnp.exp(jnp.sum(diff_lq1.astype(jnp.float32) * diff_lk1.astype(jnp.float32)))
           - jnp.exp(jnp.sum(diff_lq2.astype(jnp.float32) * diff_lk2.astype(jnp.float32)))
           + lam_init)
    d_out = differential_attention(qd, kd, vd, lam)
    d_out = (rms_norm(d_out, diff_norm, SUBLN_EPS) * (1.0 - lam_init)).reshape(B, L, DIFF_WIDTH)
    return jnp.concatenate([na_out, d_out], axis=-1) @ w_out


def encode(x, meta_tokens, ffn1_norm, ffn1_wg, ffn1_wu, ffn1_wd, mix_norm, w_in, na_rpb, na_norm,
           diff_lq1, diff_lk1, diff_lq2, diff_lk2, diff_norm, w_out, ffn2_norm, ffn2_wg, ffn2_wu,
           ffn2_wd, final_norm):
    B, S, D = x.shape
    meta = jnp.broadcast_to(meta_tokens.astype(x.dtype)[None], (B, N_META, D))
    h = jnp.concatenate([meta, x], axis=1)
    pos = jnp.arange(N_META + S, dtype=jnp.int32)
    for l in range(DEPTH):
        h = h + 0.5 * swiglu(rms_norm(h, ffn1_norm[l]), ffn1_wg[l], ffn1_wu[l], ffn1_wd[l])
        h = h + token_mixing(rms_norm(h, mix_norm[l]), pos, l, w_in[l], na_rpb[l], na_norm[l],
                             diff_lq1[l], diff_lk1[l], diff_lq2[l], diff_lk2[l], diff_norm[l], w_out[l])
        h = h + 0.5 * swiglu(rms_norm(h, ffn2_norm[l]), ffn2_wg[l], ffn2_wu[l], ffn2_wd[l])
    return rms_norm(h[:, N_META:], final_norm)


def setup_inputs(seed: int = 0) -> dict:
    key = jax.random.key(seed)
    ks = jax.random.split(key, 24)
    f32 = jnp.float32
    nrm = lambda k, shape, s: jax.random.normal(k, shape, f32) * s
    gain = lambda k, shape: 1.0 + 0.02 * jax.random.normal(k, shape, f32)
    return {
        "x_prompt": nrm(ks[0], (BATCH, SEQ, D_MODEL), 1.0),
        "x_sample": nrm(ks[1], (DEC_BATCH, DEC_SEQ, D_MODEL), 1.0),
        "meta_tokens": nrm(ks[2], (N_META, D_MODEL), 1.0),
        "ffn1_norm": gain(ks[3], (DEPTH, D_MODEL)),
        "ffn1_wg": nrm(ks[4], (DEPTH, D_MODEL, D_FF), D_MODEL ** -0.5),
        "ffn1_wu": nrm(ks[5], (DEPTH, D_MODEL, D_FF), D_MODEL ** -0.5),
        "ffn1_wd": nrm(ks[6], (DEPTH, D_FF, D_MODEL), D_FF ** -0.5),
        "mix_norm": gain(ks[7], (DEPTH, D_MODEL)),
        "w_in": nrm(ks[8], (DEPTH, D_MODEL, IN_WIDTH), D_MODEL ** -0.5),
        "na_rpb": nrm(ks[9], (DEPTH, NA_HEADS, 2 * WIN_H_MAX - 1, 2 * WIN_W - 1), 0.1),
        "na_norm": gain(ks[10], (DEPTH, NA_HEADS, NA_DH)),
        "diff_lq1": nrm(ks[11], (DEPTH, DIFF_DH), 0.1),
        "diff_lk1": nrm(ks[12], (DEPTH, DIFF_DH), 0.1),
        "diff_lq2": nrm(ks[13], (DEPTH, DIFF_DH), 0.1),
        "diff_lk2": nrm(ks[14], (DEPTH, DIFF_DH), 0.1),
        "diff_norm": gain(ks[15], (DEPTH, 2 * DIFF_DH)),
        "w_out": nrm(ks[16], (DEPTH, MIX_WIDTH, D_MODEL), MIX_WIDTH ** -0.5),
        "ffn2_norm": gain(ks[17], (DEPTH, D_MODEL)),
        "ffn2_wg": nrm(ks[18], (DEPTH, D_MODEL, D_FF), D_MODEL ** -0.5),
        "ffn2_wu": nrm(ks[19], (DEPTH, D_MODEL, D_FF), D_MODEL ** -0.5),
        "ffn2_wd": nrm(ks[20], (DEPTH, D_FF, D_MODEL), D_FF ** -0.5),
        "final_norm": gain(ks[21], (D_MODEL,)),
    }


def reference(x_prompt, x_sample, meta_tokens, ffn1_norm, ffn1_wg, ffn1_wu, ffn1_wd, mix_norm, w_in,
              na_rpb, na_norm, diff_lq1, diff_lk1, diff_lq2, diff_lk2, diff_norm, w_out, ffn2_norm,
              ffn2_wg, ffn2_wu, ffn2_wd, final_norm):
    y_prompt = encode(x_prompt, meta_tokens, ffn1_norm, ffn1_wg, ffn1_wu, ffn1_wd, mix_norm, w_in,
                      na_rpb, na_norm, diff_lq1, diff_lk1, diff_lq2, diff_lk2, diff_norm, w_out,
                      ffn2_norm, ffn2_wg, ffn2_wu, ffn2_wd, final_norm)
    y_sample = encode(x_sample, meta_tokens, ffn1_norm, ffn1_wg, ffn1_wu, ffn1_wd, mix_norm, w_in,
                      na_rpb, na_norm, diff_lq1, diff_lk1, diff_lq2, diff_lk2, diff_norm, w_out,
                      ffn2_norm, ffn2_wg, ffn2_wu, ffn2_wd, final_norm)
    return (y_prompt, y_sample)
```

```cpp
#include <hip/hip_runtime.h>
#include <cstdio>
#include <cstdint>
#include <cmath>
namespace pg8 {
#define PG8_LAS __attribute__((address_space(3)))
typedef unsigned short bf16_t;
typedef short bf16x8 __attribute__((ext_vector_type(8)));
typedef float f32x4 __attribute__((ext_vector_type(4)));
typedef unsigned u32x4 __attribute__((ext_vector_type(4)));
constexpr int BM = 256, BK = 64, HALF = 128, HTB = HALF * BK * 2  , STAGE_BYTES = 8 * HTB, NXCD = 8, WGM = 8;

__host__ __device__ __forceinline__ int lds_byte(int r, int c) { const int st = (r >> 4) * 2 + (c >> 5), rr = r & 15, cc = c & 31, ob = rr * 64 + cc * 2; return st * 1024 + (ob ^ (((ob >> 9) & 1) << 5)); }
__host__ __device__ __forceinline__ void stage_rc(int b, int& R, int& C) { const int st = b / 1024, sb = b % 1024, swz = sb ^ (((sb >> 9) & 1) << 5); R = (st >> 1) * 16 + swz / 64; C = (st & 1) * 32 + (swz % 64) / 2; }
__host__ __device__ __forceinline__ int perm32(int rho) { const int n = rho >> 4, i = rho & 15; return 8 * (i >> 2) + 4 * n + (i & 3); }

struct Unit { int pm, pn; };
struct Gemm { const bf16_t* A; const bf16_t* Bt; int M, N, K; };

struct StaticOrder {
    int nM, nN, nwg, G, c;
    __host__ __device__ void init(int M, int N, int G_, int c_) { nM = M / BM; nN = N / BM; nwg = nM * nN; G = G_; c = c_; }
    __host__ __device__ bool next(int i, Unit& u) const {
        const long L = (long)i * G + c; if (L >= nwg) return false;
        int wgid = (int)L; { const int q = nwg / NXCD, r = nwg % NXCD, xcd = wgid % NXCD, off = wgid / NXCD; wgid = (xcd < r ? xcd * (q + 1) : r * (q + 1) + (xcd - r) * q) + off; }
        const int nig = WGM * nN, gid = wgid / nig, fm = gid * WGM, gsz = (nM - fm) < WGM ? (nM - fm) : WGM;
        u.pm = fm + ((wgid % nig) % gsz); u.pn = (wgid % nig) / gsz; return true;
    }
    __device__ __forceinline__ void a_ready(const Unit&) const {}
    __device__ __forceinline__ void done(const Unit&) const {}
};

__device__ __forceinline__ unsigned cvt_pk_bf16(float lo, float hi) { unsigned r; asm volatile("v_cvt_pk_bf16_f32 %0, %1, %2" : "=v"(r) : "v"(lo), "v"(hi)); return r; }
typedef float f32x2 __attribute__((ext_vector_type(2)));

struct EpiSwiglu {
    static constexpr bool PERM = true, AFTER_DRAIN = false;
    bf16_t* O; int ldc;
    __device__ __forceinline__ void operator()(const f32x4 (&acc)[2][2][4][2], const Unit& u, int wr, int wc, int fr, int fq) const {
        const int row0 = u.pm * BM + wr * 64 + fr, col0 = u.pn * HALF + wc * 32 + 8 * fq;
#pragma unroll
        for (int ai = 0; ai < 2; ++ai)
#pragma unroll
            for (int m = 0; m < 4; ++m) { bf16_t* rowp = O + (size_t)(row0 + ai * HALF + m * 16) * ldc + col0;
                float v[8];
#pragma unroll
                for (int n = 0; n < 2; ++n)
#pragma unroll
                    for (int j = 0; j < 4; ++j) { const float g = acc[ai][0][m][n][j], up = acc[ai][1][m][n][j];
                        const float e = __builtin_amdgcn_exp2f(g * -1.4426950408889634f);
                        v[n * 4 + j] = g * __builtin_amdgcn_rcpf(1.0f + e) * up; }
                u32x4 w; w.x = cvt_pk_bf16(v[0], v[1]); w.y = cvt_pk_bf16(v[2], v[3]); w.z = cvt_pk_bf16(v[4], v[5]); w.w = cvt_pk_bf16(v[6], v[7]);
                *(u32x4*)rowp = w; }
    }
};
struct EpiProj {
    static constexpr bool PERM = true, AFTER_DRAIN = false;
    bf16_t* O; int ldc;
    __device__ __forceinline__ void operator()(const f32x4 (&acc)[2][2][4][2], const Unit& u, int wr, int wc, int fr, int fq) const {
        const int row0 = u.pm * BM + wr * 64 + fr, col0 = u.pn * BM + wc * 32 + 8 * fq;
#pragma unroll
        for (int ai = 0; ai < 2; ++ai)
#pragma unroll
            for (int m = 0; m < 4; ++m) { bf16_t* rowp = O + (size_t)(row0 + ai * HALF + m * 16) * ldc + col0;
#pragma unroll
                for (int bj = 0; bj < 2; ++bj) { const f32x4 v0 = acc[ai][bj][m][0], v1 = acc[ai][bj][m][1];
                    u32x4 w; w.x = cvt_pk_bf16(v0[0], v0[1]); w.y = cvt_pk_bf16(v0[2], v0[3]); w.z = cvt_pk_bf16(v1[0], v1[1]); w.w = cvt_pk_bf16(v1[2], v1[3]);
                    *(u32x4*)(rowp + bj * HALF) = w; } }
    }
};
struct EpiResid {
    static constexpr bool PERM = false, AFTER_DRAIN = false;
    const float* s0; const float* s1; const float* s2; float* d0; float* d2; float alpha; int ldc;
    __device__ __forceinline__ void operator()(const f32x4 (&acc)[2][2][4][2], const Unit& u, int wr, int wc, int fr, int fq) const {
        const int pm = u.pm;
        const float* s = pm < 32 ? s0 + (size_t)pm * BM * ldc : (pm < 96 ? s1 + (size_t)(pm - 32) * BM * ldc : s2);
        float* d = pm < 96 ? d0 + (size_t)pm * BM * ldc : d2;
        const int row0 = wr * 64 + fr, col0 = u.pn * BM + wc * 32 + 4 * fq;
#pragma unroll
        for (int ai = 0; ai < 2; ++ai)
#pragma unroll
            for (int m = 0; m < 4; ++m) { const size_t off = (size_t)(row0 + ai * HALF + m * 16) * ldc + col0;
                f32x4 rv[2][2];
#pragma unroll
                for (int bj = 0; bj < 2; ++bj)
#pragma unroll
                    for (int n = 0; n < 2; ++n) rv[bj][n] = *(const f32x4*)(s + off + bj * HALF + n * 16);
#pragma unroll
                for (int bj = 0; bj < 2; ++bj)
#pragma unroll
                    for (int n = 0; n < 2; ++n) *(f32x4*)(d + off + bj * HALF + n * 16) = rv[bj][n] + acc[ai][bj][m][n] * alpha;
                if (m & 1) asm volatile("" ::: "memory"); }
    }
};

template <class Epi, class Sched, bool ALIGN_EPI = false, bool SP2 = false>
__device__ __forceinline__ void gemm_phase(PG8_LAS unsigned char* lds, const Gemm g, const Sched& S, const Epi& E) {
    const int tid = threadIdx.x, wid = __builtin_amdgcn_readfirstlane(tid >> 6), lane = tid & 63, wr = wid >> 2, wc = wid & 3, fr = lane & 15, fq = lane >> 4;
    const int K = g.K, nt = K / BK;
    unsigned voffA[2], voffB[2];
#pragma unroll
    for (int i = 0; i < 2; ++i) { int R, C; stage_rc(tid * 16 + i * 8192, R, C); const int Rb = Epi::PERM ? ((R & ~31) + perm32(R & 31)) : R;
        voffA[i] = (unsigned)(R * K + C) * 2u; voffB[i] = (unsigned)(Rb * K + C) * 2u; }
    const size_t kstep = (size_t)(BK * 2);
    const size_t hstep = (size_t)HALF * K * 2;
    const size_t tstep = 2 * hstep;
    const unsigned ldsw = (unsigned)wid * 1024u;
    const int aoff = lds_byte(wr * 64 + fr, fq * 8), boff = lds_byte(wc * 32 + fr, fq * 8);
#define PG8_SA(b, h) (((b) * 2 + (h)) * HTB)
#define PG8_SB(b, h) ((4 + (b) * 2 + (h)) * HTB)
#define PG8_STAGE(bufoff, gbase, voff) do { _Pragma("unroll") for (int _i = 0; _i < 2; ++_i) \
        __builtin_amdgcn_global_load_lds((const unsigned*)((const char*)(gbase) + (voff)[_i]), (PG8_LAS unsigned*)(lds + (bufoff) + ldsw + _i * 8192), 16, 0, 0); } while (0)
#define PG8_LDA(dst, b, h) do { _Pragma("unroll") for (int m = 0; m < 4; ++m) _Pragma("unroll") for (int k = 0; k < 2; ++k) dst[m][k] = *(const PG8_LAS bf16x8*)(lds + PG8_SA(b, h) + aoff + m * 2048 + k * 1024); } while (0)
#define PG8_LDB(dst, b, h) do { _Pragma("unroll") for (int n = 0; n < 2; ++n) _Pragma("unroll") for (int k = 0; k < 2; ++k) dst[n][k] = *(const PG8_LAS bf16x8*)(lds + PG8_SB(b, h) + boff + n * 2048 + k * 1024); } while (0)
#define PG8_MMA(ai, bj, At, Bt) do { __builtin_amdgcn_s_setprio(1); _Pragma("unroll") for (int m = 0; m < 4; ++m) _Pragma("unroll") for (int n = 0; n < 2; ++n) _Pragma("unroll") for (int k = 0; k < 2; ++k) \
        acc[ai][bj][m][n] = __builtin_amdgcn_mfma_f32_16x16x32_bf16(Bt[n][k], At[m][k], acc[ai][bj][m][n], 0, 0, 0); __builtin_amdgcn_s_setprio(0); } while (0)
#define PG8_WAIT_V(n) asm volatile("s_waitcnt vmcnt(" #n ")" ::: "memory")
#define PG8_WAIT_L(n) asm volatile("s_waitcnt lgkmcnt(" #n ")" ::: "memory")
#define PG8_BAR __builtin_amdgcn_s_barrier()
#define PG8_SCHED __builtin_amdgcn_sched_barrier(0)
    Unit cur, nxt; int ui = 0;
    if (!S.next(0, cur)) return;
    f32x4 acc[2][2][4][2];
#pragma unroll
    for (int a = 0; a < 2; ++a)
#pragma unroll
        for (int b = 0; b < 2; ++b)
#pragma unroll
            for (int m = 0; m < 4; ++m)
#pragma unroll
                for (int n = 0; n < 2; ++n) acc[a][b][m][n] = (f32x4){0.f, 0.f, 0.f, 0.f};
    bf16x8 At[4][2], B0[2][2], B1[2][2];
    const char* cA = (const char*)g.A + (size_t)cur.pm * tstep; const char* cB = (const char*)g.Bt + (size_t)cur.pn * tstep;
    S.a_ready(cur);
    if constexpr (SP2) {
        PG8_STAGE(PG8_SB(0, 0), cB, voffB); PG8_STAGE(PG8_SB(0, 1), cB + hstep, voffB); PG8_STAGE(PG8_SA(0, 0), cA, voffA); PG8_STAGE(PG8_SA(0, 1), cA + hstep, voffA);
        if (wr == 1) PG8_BAR;
        PG8_WAIT_V(2); PG8_BAR;
        PG8_STAGE(PG8_SB(1, 0), cB + kstep, voffB); PG8_STAGE(PG8_SA(1, 0), cA + kstep, voffA); PG8_STAGE(PG8_SB(1, 1), cB + hstep + kstep, voffB);
        PG8_WAIT_V(6); PG8_BAR;
    } else {
        PG8_STAGE(PG8_SB(0, 0), cB, voffB); PG8_STAGE(PG8_SA(0, 0), cA, voffA); PG8_STAGE(PG8_SB(0, 1), cB + hstep, voffB); PG8_STAGE(PG8_SA(0, 1), cA + hstep, voffA);
        if (wr == 1) PG8_BAR;
        PG8_WAIT_V(4); PG8_BAR;
        PG8_STAGE(PG8_SB(1, 0), cB + kstep, voffB); PG8_STAGE(PG8_SA(1, 0), cA + kstep, voffA); PG8_STAGE(PG8_SB(1, 1), cB + hstep + kstep, voffB);
        PG8_WAIT_V(6); PG8_BAR;
    }
    for (;;) {
        const bool has_next = S.next(ui + 1, nxt);
        const char* nA = has_next ? (const char*)g.A + (size_t)nxt.pm * tstep : cA; const char* nB = has_next ? (const char*)g.Bt + (size_t)nxt.pn * tstep : cB;
        for (int t = 0; t < nt; t += 2) {
            const bool last = (t == nt - 2);
            const char* a1 = cA + (size_t)(t + 1) * kstep;
            const char* a2 = last ? nA : cA + (size_t)(t + 2) * kstep; const char* b2 = last ? nB : cB + (size_t)(t + 2) * kstep;
            const char* a3 = a2 + kstep; const char* b3 = b2 + kstep;
            if (last && has_next) S.a_ready(nxt);
            if constexpr (SP2) {
            PG8_LDB(B0, 0, 0); PG8_LDB(B1, 0, 1); PG8_SCHED; PG8_LDA(At, 0, 0); PG8_STAGE(PG8_SA(1, 1), a1 + hstep, voffA);
            PG8_WAIT_V(8); PG8_WAIT_L(0); PG8_BAR; PG8_MMA(0, 0, At, B0); PG8_MMA(0, 1, At, B1); PG8_BAR; PG8_SCHED;
            PG8_LDA(At, 0, 1); PG8_STAGE(PG8_SB(0, 0), b2, voffB); PG8_STAGE(PG8_SB(0, 1), b2 + hstep, voffB); PG8_STAGE(PG8_SA(0, 0), a2, voffA);
            PG8_WAIT_V(8); PG8_WAIT_L(0); PG8_BAR; PG8_MMA(1, 0, At, B0); PG8_MMA(1, 1, At, B1); PG8_BAR; PG8_SCHED;
            PG8_LDB(B0, 1, 0); PG8_LDB(B1, 1, 1); PG8_SCHED; PG8_LDA(At, 1, 0); PG8_STAGE(PG8_SA(0, 1), a2 + hstep, voffA);
            PG8_WAIT_V(8); PG8_WAIT_L(0); PG8_BAR; PG8_MMA(0, 0, At, B0); PG8_MMA(0, 1, At, B1); PG8_BAR; PG8_SCHED;
            PG8_LDA(At, 1, 1); PG8_STAGE(PG8_SB(1, 0), b3, voffB); PG8_STAGE(PG8_SB(1, 1), b3 + hstep, voffB); PG8_STAGE(PG8_SA(1, 0), a3, voffA);
            PG8_WAIT_V(8); PG8_WAIT_L(0); PG8_BAR; PG8_MMA(1, 0, At, B0); PG8_MMA(1, 1, At, B1); PG8_BAR; PG8_SCHED;
            } else {
            PG8_LDB(B0, 0, 0); PG8_SCHED; PG8_LDA(At, 0, 0); PG8_STAGE(PG8_SA(1, 1), a1 + hstep, voffA);
            PG8_WAIT_L(8); PG8_BAR; PG8_WAIT_L(0); PG8_MMA(0, 0, At, B0); PG8_BAR; PG8_SCHED;
            PG8_LDB(B1, 0, 1); PG8_STAGE(PG8_SB(0, 0), b2, voffB);
            PG8_BAR; PG8_WAIT_L(0); PG8_MMA(0, 1, At, B1); PG8_BAR;
            PG8_LDA(At, 0, 1); PG8_STAGE(PG8_SA(0, 0), a2, voffA);
            PG8_BAR; PG8_WAIT_L(0); PG8_MMA(1, 0, At, B0); PG8_BAR; PG8_SCHED;
            PG8_STAGE(PG8_SB(0, 1), b2 + hstep, voffB);
            PG8_WAIT_V(6); PG8_BAR; PG8_MMA(1, 1, At, B1); PG8_BAR;
            PG8_LDB(B0, 1, 0); PG8_SCHED; PG8_LDA(At, 1, 0); PG8_STAGE(PG8_SA(0, 1), a2 + hstep, voffA);
            PG8_WAIT_L(8); PG8_BAR; PG8_WAIT_L(0); PG8_MMA(0, 0, At, B0); PG8_BAR; PG8_SCHED;
            PG8_LDB(B1, 1, 1); PG8_STAGE(PG8_SB(1, 0), b3, voffB);
            PG8_BAR; PG8_WAIT_L(0); PG8_MMA(0, 1, At, B1); PG8_BAR;
            PG8_LDA(At, 1, 1); PG8_STAGE(PG8_SA(1, 0), a3, voffA);
            PG8_BAR; PG8_WAIT_L(0); PG8_MMA(1, 0, At, B0); PG8_BAR; PG8_SCHED;
            PG8_STAGE(PG8_SB(1, 1), b3 + hstep, voffB);
            PG8_WAIT_V(6); PG8_BAR; PG8_MMA(1, 1, At, B1); PG8_BAR;
            }
        }
        if constexpr (ALIGN_EPI) { if (wr == 0) PG8_BAR; }
        if constexpr (!Epi::AFTER_DRAIN) { E(acc, cur, wr, wc, fr, fq); S.done(cur); }
        if (!has_next) break;
#pragma unroll
        for (int a = 0; a < 2; ++a)
#pragma unroll
            for (int b = 0; b < 2; ++b)
#pragma unroll
                for (int m = 0; m < 4; ++m)
#pragma unroll
                    for (int n = 0; n < 2; ++n) acc[a][b][m][n] = (f32x4){0.f, 0.f, 0.f, 0.f};
        cur = nxt; cA = nA; cB = nB; ++ui;
        if constexpr (ALIGN_EPI) { if (wr == 1) PG8_BAR; }
    }
    PG8_WAIT_V(0);
    if constexpr (!ALIGN_EPI) { if (wr == 0) PG8_BAR; }
    PG8_BAR;
    if constexpr (Epi::AFTER_DRAIN) { E.fused(acc, cur, wr, wc, fr, fq, lds, wid, lane); S.done(cur); }
#undef PG8_SA
#undef PG8_SB
#undef PG8_STAGE
#undef PG8_LDA
#undef PG8_LDB
#undef PG8_MMA
#undef PG8_WAIT_V
#undef PG8_WAIT_L
#undef PG8_BAR
#undef PG8_SCHED
}
}

namespace att {
#define ATT_LAS __attribute__((address_space(3)))
typedef unsigned short bf16_t;
using bf16x8 = __attribute__((ext_vector_type(8))) short;
using s16x4  = __attribute__((ext_vector_type(4))) short;
using f32x16 = __attribute__((ext_vector_type(16))) float;
using u32x4  = __attribute__((ext_vector_type(4))) unsigned;
constexpr int   D = 128, NW = 8, QBLK = 32, KVBLK = 64;
constexpr float SCALE = 0.088388347648318440f;
constexpr float THR = 8.f;
constexpr float NEG = -1.0e30f;
constexpr int   LD = 12288;
constexpr int   META_ROW = 24576;
constexpr int   SHM_V = KVBLK * D * 2, SHM_K = KVBLK * D * 2, SHM_ATTN = 2 * SHM_V + 2 * SHM_K + NW * 64 * 4;
#define KSWZ(row, colB) ((row) * 256 + ((colB) ^ (((row) & 7) << 4)))
#define SBAR() __builtin_amdgcn_sched_barrier(0)
__device__ __forceinline__ int crow(int r, int hi) { return (r & 3) + 8 * (r >> 2) + 4 * hi; }
__device__ __forceinline__ unsigned cvtpk(float lo, float hi) { unsigned r; asm volatile("v_cvt_pk_bf16_f32 %0, %1, %2" : "=v"(r) : "v"(lo), "v"(hi)); return r; }

struct NaCtx { int qrow, r0, kr_first, c, c0; const ATT_LAS float* rpb; };

__device__ __forceinline__ void partialSM(f32x16& p0, f32x16& p1, float& m_reg, float& mn, float& alpha) {
  constexpr float C = SCALE * 1.4426950408889634f;
  float pmax = p0[0];
#pragma unroll
  for (int r = 1; r < 16; ++r) pmax = fmaxf(pmax, p0[r]);
#pragma unroll
  for (int r = 0; r < 16; ++r) pmax = fmaxf(pmax, p1[r]);
  { auto rr = __builtin_amdgcn_permlane32_swap(__float_as_uint(pmax), __float_as_uint(pmax), false, false);
    pmax = fmaxf(__uint_as_float(rr[0]), __uint_as_float(rr[1])); }
  if (__builtin_expect(__all(pmax - m_reg <= THR / SCALE), 1)) { mn = m_reg; alpha = 1.f; }
  else { mn = fmaxf(m_reg, pmax); alpha = __builtin_amdgcn_exp2f((m_reg - mn) * C); m_reg = mn; }
  float mnC = -mn * C;
#pragma unroll
  for (int r = 0; r < 16; ++r) p0[r] = fmaf(p0[r], C, mnC);
#pragma unroll
  for (int r = 0; r < 16; ++r) p1[r] = fmaf(p1[r], C, mnC);
#pragma unroll
  for (int r = 0; r < 16; ++r) p0[r] = __builtin_amdgcn_exp2f(p0[r]);
}
__device__ __forceinline__ void finishSM(f32x16& p0, f32x16& p1, float alpha, float& l_reg, bf16x8& pa0, bf16x8& pa1, bf16x8& pa2, bf16x8& pa3) {
#pragma unroll
  for (int r = 0; r < 16; ++r) p1[r] = __builtin_amdgcn_exp2f(p1[r]);
  float ps = 0;
#pragma unroll
  for (int r = 0; r < 16; ++r) ps += p0[r];
#pragma unroll
  for (int r = 0; r < 16; ++r) ps += p1[r];
  { auto rr = __builtin_amdgcn_permlane32_swap(__float_as_uint(ps), __float_as_uint(ps), false, false);
    ps = __uint_as_float(rr[0]) + __uint_as_float(rr[1]); }
  l_reg = l_reg * alpha + ps;
#define PK4(P, BASE, OUT) do { unsigned a0 = cvtpk(P[BASE + 0], P[BASE + 1]), a1 = cvtpk(P[BASE + 2], P[BASE + 3]);   \
    unsigned b0 = cvtpk(P[BASE + 4], P[BASE + 5]), b1 = cvtpk(P[BASE + 6], P[BASE + 7]);                              \
    auto r0 = __builtin_amdgcn_permlane32_swap(a0, b0, false, false); auto r1 = __builtin_amdgcn_permlane32_swap(a1, b1, false, false); \
    u32x4 w = {r0[0], r1[0], r0[1], r1[1]}; OUT = *reinterpret_cast<bf16x8*>(&w); } while (0)
  PK4(p0, 0, pa0); PK4(p0, 8, pa1); PK4(p1, 0, pa2); PK4(p1, 8, pa3);
#undef PK4
}
__device__ __forceinline__ void qkt(f32x16& p0, f32x16& p1, const ATT_LAS char* Ks, const bf16x8* qr, int r32, int hi) {
  p0 = f32x16{}; p1 = f32x16{};
#pragma unroll
  for (int d0 = 0; d0 < 8; ++d0) { int cb = (d0 * 16 + hi * 8) * 2;
    bf16x8 b0 = *reinterpret_cast<const ATT_LAS bf16x8*>(Ks + KSWZ(r32, cb));
    bf16x8 b1 = *reinterpret_cast<const ATT_LAS bf16x8*>(Ks + KSWZ(32 + r32, cb));
    p0 = __builtin_amdgcn_mfma_f32_32x32x16_bf16(b0, qr[d0], p0, 0, 0, 0);
    p1 = __builtin_amdgcn_mfma_f32_32x32x16_bf16(b1, qr[d0], p1, 0, 0, 0); }
}
__device__ __forceinline__ int v_st(int k, int c) { const int kk = (k & ~0xC) | ((k & 4) << 1) | ((k & 8) >> 1); return ((kk >> 3) * 4 + (c >> 5)) * 512 + ((kk & 7) * 32 + (c & 31)) * 2; }
__device__ __forceinline__ int v_rd_base(int lane) { return ((lane & 3) << 3) | (((lane >> 2) & 3) << 6) | (((lane >> 4) & 1) << 5) | (((lane >> 5) & 1) << 8); }
constexpr int v_rd_off(int d0, int ks, int half) { return d0 * 512 + ks * 4096 + half * 2048; }
template <int OFF> __device__ __forceinline__ s16x4 tr_read(int vb) {
  s16x4 r; asm volatile("ds_read_b64_tr_b16 %0, %1 offset:%2" : "=&v"(r) : "v"(vb), "i"(OFF) : "memory"); return r;
}
template <int D0> __device__ __forceinline__ void pv_one(f32x16& od, int vb, bf16x8 pa0, bf16x8 pa1, bf16x8 pa2, bf16x8 pa3) {
  const s16x4 l0 = tr_read<v_rd_off(D0, 0, 0)>(vb), h0 = tr_read<v_rd_off(D0, 0, 1)>(vb), l1 = tr_read<v_rd_off(D0, 1, 0)>(vb), h1 = tr_read<v_rd_off(D0, 1, 1)>(vb);
  const s16x4 l2 = tr_read<v_rd_off(D0, 2, 0)>(vb), h2 = tr_read<v_rd_off(D0, 2, 1)>(vb), l3 = tr_read<v_rd_off(D0, 3, 0)>(vb), h3 = tr_read<v_rd_off(D0, 3, 1)>(vb);
  asm volatile("s_waitcnt lgkmcnt(0)" ::: "memory"); SBAR();
#define PK(L, H) (bf16x8){L[0], L[1], L[2], L[3], H[0], H[1], H[2], H[3]}
  od = __builtin_amdgcn_mfma_f32_32x32x16_bf16(pa0, PK(l0, h0), od, 0, 0, 0);
  od = __builtin_amdgcn_mfma_f32_32x32x16_bf16(pa1, PK(l1, h1), od, 0, 0, 0);
  od = __builtin_amdgcn_mfma_f32_32x32x16_bf16(pa2, PK(l2, h2), od, 0, 0, 0);
  od = __builtin_amdgcn_mfma_f32_32x32x16_bf16(pa3, PK(l3, h3), od, 0, 0, 0);
#undef PK
}
__device__ __forceinline__ void pv_d0(f32x16* o, int vb, bf16x8 pa0, bf16x8 pa1, bf16x8 pa2, bf16x8 pa3) {
  pv_one<0>(o[0], vb, pa0, pa1, pa2, pa3); pv_one<1>(o[1], vb, pa0, pa1, pa2, pa3); pv_one<2>(o[2], vb, pa0, pa1, pa2, pa3); pv_one<3>(o[3], vb, pa0, pa1, pa2, pa3);
}
template <bool IS_NA> __device__ __forceinline__ void mask_tile(f32x16& p0, f32x16& p1, int j, const NaCtx& na, int hi) {
  if constexpr (IS_NA) {
    const int kr = na.kr_first + (j - 1);
    if ((unsigned)(kr - na.r0) >= 8u) {
#pragma unroll
      for (int r = 0; r < 16; ++r) { p0[r] = NEG; p1[r] = NEG; }
    } else {
      const ATT_LAS float* rb = na.rpb + (kr - na.qrow + 7) * 31 + 15 - na.c + 4 * hi;
      const int dbase = 4 * hi - na.c0;
#pragma unroll
      for (int r = 0; r < 16; ++r) { const int kc = (r & 3) + 8 * (r >> 2);
        const float b0 = rb[kc], b1 = rb[kc + 32];
        p0[r] = ((unsigned)(kc + dbase) < 16u) ? p0[r] + b0 : NEG;
        p1[r] = ((unsigned)(kc + 32 + dbase) < 16u) ? p1[r] + b1 : NEG; }
    }
  }
}

typedef __amdgpu_buffer_rsrc_t rsrc_t;
__device__ __forceinline__ bf16x8 bld(rsrc_t rs, unsigned voff, unsigned soff) { auto v = __builtin_amdgcn_raw_buffer_load_b128(rs, (int)voff, (int)soff, 0); return __builtin_bit_cast(bf16x8, v); }
template <bool IS_NA>
__device__ __forceinline__ void attn_run(const rsrc_t rs, const unsigned qoffB  , const unsigned kcolB, const unsigned vcolB  ,
                                         const int krow1, const int NT, ATT_LAS char* lds, const NaCtx na, f32x16 (&o)[4]) {
  const int tid = threadIdx.x, wid = tid >> 6, lane = tid & 63, r32 = lane & 31, hi = lane >> 5;
  ATT_LAS char* V_lds = lds; ATT_LAS char* K_lds = lds + 2 * SHM_V;
  ATT_LAS float* wsf = (ATT_LAS float*)(lds + 2 * SHM_V + 2 * SHM_K) + wid * 64; ATT_LAS float* li_l = wsf; ATT_LAS float* al_l = wsf + 32;
  float m_reg = NEG, l_reg = 0; bf16x8 qr[8];
#pragma unroll
  for (int d = 0; d < 4; ++d) o[d] = f32x16{};
  { const unsigned qv = (unsigned)((wid * QBLK + r32) * LD + hi * 8) * 2u;
#pragma unroll
    for (int d0 = 0; d0 < 8; ++d0) qr[d0] = bld(rs, qv + d0 * 32, qoffB); }
  const int sr = tid >> 4, sc = (tid & 15) * 8, vst0 = v_st(sr, sc), vst1 = v_st(32 + sr, sc);
  const int vb0 = (int)(unsigned)(uintptr_t)V_lds + v_rd_base(lane);
  struct { bf16x8 vs0, vs1, ks0, ks1; } sr_[2];
#define TROW(j) ((j) == 0 ? META_ROW : krow1 + ((j) - 1) * KVBLK)
  const unsigned stv = (unsigned)(sr * LD + sc) * 2u;
#define SLOAD(i, j) do { const unsigned t0_ = (unsigned)TROW(j) * (unsigned)(LD * 2); sr_[i].vs0 = bld(rs, stv, t0_ + vcolB); sr_[i].vs1 = bld(rs, stv, t0_ + vcolB + 32u * LD * 2u); \
    sr_[i].ks0 = bld(rs, stv, t0_ + kcolB); sr_[i].ks1 = bld(rs, stv, t0_ + kcolB + 32u * LD * 2u); } while (0)
#define SWRITE(b, i) do { *(ATT_LAS bf16x8*)(V_lds + (b) * SHM_V + vst0) = sr_[i].vs0;          \
    *(ATT_LAS bf16x8*)(V_lds + (b) * SHM_V + vst1) = sr_[i].vs1; const int kc_ = sc * 2;               \
    *(ATT_LAS bf16x8*)(K_lds + (b) * SHM_K + KSWZ(sr, kc_)) = sr_[i].ks0;                       \
    *(ATT_LAS bf16x8*)(K_lds + (b) * SHM_K + KSWZ(32 + sr, kc_)) = sr_[i].ks1; } while (0)
#define SWAIT() asm volatile("s_waitcnt vmcnt(4)" ::: "memory")
#define RESC(a) do { if (__any((a) < 1.f)) { if (hi == 0) al_l[r32] = (a); asm volatile("s_waitcnt lgkmcnt(0)" ::: "memory"); \
    _Pragma("unroll") for (int d = 0; d < 4; ++d) _Pragma("unroll") for (int r = 0; r < 16; ++r) o[d][r] *= al_l[crow(r, hi)]; } } while (0)
  f32x16 pA0, pA1, pB0, pB1; float mnA, mnB, alA, alB; bf16x8 pa0, pa1, pa2, pa3;
  constexpr int SE = 0, SO = 1;
  __syncthreads();
  SLOAD(SE, 0); asm volatile("s_waitcnt vmcnt(0)" ::: "memory"); SWRITE(0, SE); __syncthreads();
  qkt(pA0, pA1, K_lds, qr, r32, hi);
#pragma unroll
  for (int r = 8; r < 16; ++r) pA0[r] = NEG;
#pragma unroll
  for (int r = 0; r < 16; ++r) pA1[r] = NEG;
  partialSM(pA0, pA1, m_reg, mnA, alA);
  SLOAD(SO, 1); if (2 < NT) SLOAD(SE, 2);
  SWAIT(); SWRITE(1, SO); __syncthreads();
  for (int j = 1; j + 1 < NT; j += 2) {
    SBAR(); qkt(pB0, pB1, K_lds + SHM_K, qr, r32, hi);
    finishSM(pA0, pA1, alA, l_reg, pa0, pa1, pa2, pa3); SBAR();
    if (j + 2 < NT) SLOAD(SO, j + 2); SBAR();
    pv_d0(o, vb0, pa0, pa1, pa2, pa3); mask_tile<IS_NA>(pB0, pB1, j, na, hi); partialSM(pB0, pB1, m_reg, mnB, alB);
    __syncthreads(); SWAIT(); SWRITE(0, SE);
    RESC(alB); __syncthreads();
    SBAR(); qkt(pA0, pA1, K_lds, qr, r32, hi);
    finishSM(pB0, pB1, alB, l_reg, pa0, pa1, pa2, pa3); SBAR();
    if (j + 3 < NT) SLOAD(SE, j + 3); SBAR();
    pv_d0(o, vb0 + SHM_V, pa0, pa1, pa2, pa3); mask_tile<IS_NA>(pA0, pA1, j + 1, na, hi); partialSM(pA0, pA1, m_reg, mnA, alA);
    __syncthreads(); SWAIT(); if (j + 2 < NT) SWRITE(1, SO);
    RESC(alA); __syncthreads();
  }
  finishSM(pA0, pA1, alA, l_reg, pa0, pa1, pa2, pa3); SBAR();
  pv_d0(o, vb0, pa0, pa1, pa2, pa3);
  if (hi == 0) li_l[r32] = l_reg; asm volatile("s_waitcnt lgkmcnt(0)" ::: "memory");
#pragma unroll
  for (int r = 0; r < 16; ++r) { const float rl = __builtin_amdgcn_rcpf(li_l[crow(r, hi)]);
#pragma unroll
    for (int d = 0; d < 4; ++d) o[d][r] *= rl; }
#undef TROW
#undef SLOAD
#undef SWRITE
#undef SWAIT
#undef RESC
}
__device__ __forceinline__ float half_sum(float v) {
#pragma unroll
  for (int o = 1; o < 32; o <<= 1) v += __shfl_xor(v, o);
  return v;
}
}


#ifndef MK_N_LAUNCHES
#define MK_N_LAUNCHES 12
#endif
constexpr int NWAVES = 8;
constexpr int N_PHASES = 12;
constexpr int N_LAUNCHES = MK_N_LAUNCHES;

constexpr int DM = 4096, DFF = 11008, NMETA = 16;
constexpr int S_P = 8192, S_S = 4096, NB_S = 4;
constexpr int NTOK = S_P + NB_S * S_S;
constexpr int MP = NTOK + 256;
constexpr int NA_W = 2048, DF_W = 2048, IN_W = 12288;
constexpr int C_QNA = 0, C_KNA = 2048, C_VNA = 4096, C_QD = 6144, C_KD = 8192, C_VD = 10240;
constexpr float EPS = 1e-6f, SUBLN_EPS = 1e-5f, LAM_INIT = 0.2f;

constexpr size_t MiB = 1u << 20;
constexpr size_t WS_CTL = 0, CTL_ZERO_BYTES = 1 * MiB;
constexpr size_t SZ_WA = (size_t)2 * DFF * DM * 2, SZ_WD = (size_t)DM * DFF * 2, SZ_WIN = (size_t)IN_W * DM * 2, SZ_WOUT = (size_t)DM * DM * 2;
constexpr size_t WS_W1A = 1 * MiB, WS_W1D = WS_W1A + SZ_WA, WS_WIN = WS_W1D + SZ_WD, WS_WOUT = WS_WIN + SZ_WIN, WS_W2A = WS_WOUT + SZ_WOUT, WS_W2D = WS_W2A + SZ_WA;
constexpr size_t WS_XMETA = WS_W2D + SZ_WD;
constexpr size_t WS_HMETA = WS_XMETA + (size_t)256 * DM * 4;
constexpr size_t WS_HN = WS_HMETA + (size_t)256 * DM * 4;
constexpr size_t WS_BIG = WS_HN + (size_t)MP * DM * 2;
constexpr size_t WS_SCR = WS_BIG + (size_t)MP * IN_W * 2;
constexpr size_t WS_END = WS_SCR + (size_t)256 * 2 * 64 * 512 * 4;
constexpr int CW_BAR = 4096;

constexpr int RING_OFF = 0, RING_BYTES = 131072;
constexpr int ATT_RPB_OFF = 69632, ATT_SSQ_OFF = ATT_RPB_OFF + 2048;
constexpr int TR_BYTES = 64 * 65 * 4;
constexpr int LDSCTL_OFF = 143360, MISC_OFF = LDSCTL_OFF + 320;
constexpr int LDS_BYTES = 147456;
static_assert(NWAVES * TR_BYTES <= LDSCTL_OFF && att::SHM_ATTN <= ATT_RPB_OFF && ATT_SSQ_OFF + 1024 <= LDSCTL_OFF && MISC_OFF + 128 <= LDS_BYTES, "LDS map");

#define GAS __attribute__((address_space(1)))
#define LAS __attribute__((address_space(3)))
typedef unsigned short bf16;
typedef unsigned v4u __attribute__((ext_vector_type(4)));
typedef float f32x4 __attribute__((ext_vector_type(4)));
typedef short bf16x8 __attribute__((ext_vector_type(8)));
typedef GAS unsigned gu32;
typedef GAS unsigned long long gu64;
#define RLX_AGENT __ATOMIC_RELAXED, __HIP_MEMORY_SCOPE_AGENT
#define LDS_WAIT() asm volatile("s_waitcnt lgkmcnt(0)" ::: "memory")
#define VM_WAIT() asm volatile("s_waitcnt vmcnt(0)" ::: "memory")
__device__ __forceinline__ unsigned long long rt() { return __builtin_amdgcn_s_memrealtime(); }
__device__ __forceinline__ unsigned f2bf(float f) { unsigned u = __builtin_bit_cast(unsigned, f); return (u + 0x7fffu + ((u >> 16) & 1u)) >> 16; }
__device__ __forceinline__ unsigned pk2(float lo, float hi) { return f2bf(lo) | (f2bf(hi) << 16); }

#define XB_TMO      128
#define XB_XCNT(j)  (256  + 64 * (j))
#define XB_XSUB(j)  (1280 + 64 * (j))
#define XB_XGEN(j)  (2304 + 64 * (j))
#define XB_TOP      3328
#define XB_TOPGEN   3392
#define XCD_BAR_WORDS 3456
#define XB_SPIN_CAP (1u << 18)

__device__ __forceinline__ unsigned xb_ld(unsigned* p)              { return __hip_atomic_load(p, __ATOMIC_RELAXED, __HIP_MEMORY_SCOPE_AGENT); }
__device__ __forceinline__ unsigned xb_add(unsigned* p, unsigned v) { return __hip_atomic_fetch_add(p, v, __ATOMIC_RELAXED, __HIP_MEMORY_SCOPE_AGENT); }
__device__ __forceinline__ unsigned xb_xcc_id() { return (unsigned)__builtin_amdgcn_s_getreg((3 << 11) | 20) & 0xFu; }
#define XB_SPIN(cond, bar) do { unsigned _sp = 0; while (cond) { __builtin_amdgcn_s_sleep(1); \
    if ((++_sp & 255u) == 0u) { if (xb_ld(&(bar)[XB_TMO])) break; if (_sp > XB_SPIN_CAP) { atomicAdd(&(bar)[XB_TMO], 1u); break; } } } } while (0)

struct XcdBarrier {
    unsigned* bar; unsigned x;
    volatile LAS unsigned* st;
};

__device__ __forceinline__ XcdBarrier xcd_barrier_post(unsigned* bar, volatile LAS unsigned* st) {
    XcdBarrier b; b.bar = bar; b.x = xb_xcc_id(); b.st = st;
    if (threadIdx.x == 0) (void)xb_add(&bar[XB_XCNT(b.x)], 1u);
    return b;
}
__device__ __forceinline__ void xcd_barrier_complete(unsigned* bar, unsigned x, unsigned& nloc, unsigned& nx) {
    const unsigned G = gridDim.x * gridDim.y * gridDim.z;
    unsigned sum, cnt, mine, sp = 0u;
    for (;;) {
        sum = 0u; cnt = 0u; mine = 0u;
#pragma unroll
        for (unsigned j = 0; j < 16; ++j) { const unsigned c = xb_ld(&bar[XB_XCNT(j)]); sum += c; cnt += (c > 0u) ? 1u : 0u; mine = (j == x) ? c : mine; }
        if (sum == G) break;
        __builtin_amdgcn_s_sleep(1);
        if ((++sp & 255u) == 0u) { if (xb_ld(&bar[XB_TMO])) break; if (sp > XB_SPIN_CAP) { atomicAdd(&bar[XB_TMO], 1u); break; } }
    }
    nloc = mine > 0u ? mine : 1u; nx = cnt > 0u ? cnt : 1u;
}

__device__ __forceinline__ void xcd_barrier(const XcdBarrier& b) {
    asm volatile("s_waitcnt vmcnt(0)" ::: "memory");
    __syncthreads();
    if (threadIdx.x == 0) {
        unsigned* bar = b.bar;
        __builtin_amdgcn_s_waitcnt(0);
        unsigned nloc = b.st[0], nx = b.st[1];
        if (nloc == 0u) { xcd_barrier_complete(bar, b.x, nloc, nx); b.st[0] = nloc; b.st[1] = nx; }
        const unsigned old = xb_add(&bar[XB_XSUB(b.x)], 1u);
        const unsigned gen = old / nloc;
        if (old + 1u == (gen + 1u) * nloc) {
            __builtin_amdgcn_fence(__ATOMIC_RELEASE, "agent");
            asm volatile("s_waitcnt vmcnt(0)" ::: "memory");
            const unsigned og = xb_add(&bar[XB_TOP], 1u);
            const unsigned tg = og / nx;
            if (og + 1u == (tg + 1u) * nx) xb_add(&bar[XB_TOPGEN], 1u);
            else XB_SPIN(xb_ld(&bar[XB_TOPGEN]) == tg, bar);
            __builtin_amdgcn_fence(__ATOMIC_ACQUIRE, "agent");
            xb_add(&bar[XB_XGEN(b.x)], 1u);
            asm volatile("s_waitcnt vmcnt(0)" ::: "memory");
        } else {
            XB_SPIN(xb_ld(&bar[XB_XGEN(b.x)]) == gen, bar);
            __builtin_amdgcn_fence(__ATOMIC_ACQUIRE, "agent");
            asm volatile("s_waitcnt vmcnt(0)" ::: "memory");
        }
    }
    __syncthreads();
}


struct Frame {
    LAS unsigned char* lds;
    volatile LAS unsigned* MISC;
    gu32* ctl;
    int tid, lane, wave;
    int vcu, G;
};
__device__ __forceinline__ float wave_sum(float v) {
#pragma unroll
    for (int o = 1; o < 64; o <<= 1) v += __shfl_xor(v, o);
    return v;
}
__device__ __forceinline__ unsigned short f2bf_s(float f) { return (unsigned short)f2bf(f); }

__device__ __forceinline__ void transpose_item(const float* __restrict__ W, int K, int N, bf16* __restrict__ WT, int mode, LAS float* scr, int item, int lane) {
    const int nblk = N / 64, kb = item / nblk, nb = item - kb * nblk, k0 = 64 * kb, n0 = 64 * nb;
    const int q = lane & 15, kr = lane >> 4;
#pragma unroll 4
    for (int i = 0; i < 16; ++i) { const int kk = 4 * i + kr; const f32x4 v = *(const f32x4*)(W + (size_t)(k0 + kk) * N + n0 + 4 * q);
        LAS float* s = scr + kk * 65 + 4 * q; s[0] = v.x; s[1] = v.y; s[2] = v.z; s[3] = v.w; }
    LDS_WAIT(); asm volatile("" ::: "memory");
    const int c = lane & 7;
#pragma unroll
    for (int j = 0; j < 8; ++j) { const int n = 8 * j + (lane >> 3); const LAS float* s = scr + (8 * c) * 65 + n;
        v4u o; o.x = pk2(s[0 * 65], s[1 * 65]); o.y = pk2(s[2 * 65], s[3 * 65]); o.z = pk2(s[4 * 65], s[5 * 65]); o.w = pk2(s[6 * 65], s[7 * 65]);
        const int ng = n0 + n; const int row = mode == 0 ? ng : 256 * (ng >> 7) + 128 * (mode - 1) + (ng & 127);
        *(v4u*)(WT + (size_t)row * K + k0 + 8 * c) = o; }
    LDS_WAIT(); asm volatile("" ::: "memory");
}
template <bool OUT_F32>
__device__ __forceinline__ void rms_row(const float* __restrict__ xrow, const float* __restrict__ g, void* orow, int lane) {
    const f32x4* xr = (const f32x4*)xrow + lane; const f32x4* gr = (const f32x4*)g + lane;
    f32x4 v[16]; float s = 0.f;
#pragma unroll
    for (int j = 0; j < 16; ++j) { v[j] = xr[64 * j]; s += (v[j].x * v[j].x + v[j].y * v[j].y) + (v[j].z * v[j].z + v[j].w * v[j].w); }
    const float rstd = 1.f / sqrtf(wave_sum(s) * (1.f / DM) + EPS);
    if constexpr (OUT_F32) { f32x4* o = (f32x4*)orow + lane;
#pragma unroll
        for (int j = 0; j < 16; ++j) { const f32x4 gg = gr[64 * j]; o[64 * j] = v[j] * rstd * gg; } }
    else { unsigned long long* o8 = (unsigned long long*)orow + lane;
#pragma unroll
        for (int j = 0; j < 16; ++j) { const f32x4 gg = gr[64 * j]; const f32x4 y = v[j] * rstd * gg;
            o8[64 * j] = (unsigned long long)pk2(y.x, y.y) | ((unsigned long long)pk2(y.z, y.w) << 32); } }
}
__device__ __forceinline__ void zero_row_bf16(bf16* orow, int lane) {
    unsigned long long* o8 = (unsigned long long*)orow + lane;
#pragma unroll
    for (int j = 0; j < 16; ++j) o8[64 * j] = 0ull;
}

struct Args { const float* in[22]; float* out; unsigned char* ws; int ph_lo, ph_hi; };
typedef const Args __attribute__((address_space(4)))* ArgsP;
#define ARGS_HERE(name) ArgsP name = (ArgsP)__builtin_amdgcn_kernarg_segment_ptr(); asm volatile("" : "+s"(name))

__device__ __forceinline__ void p0_prologue(Frame& F, ArgsP a) {
    LAS float* scr = (LAS float*)(F.lds + RING_OFF + F.wave * TR_BYTES);
    const int gw = F.vcu * NWAVES + F.wave, NGW = F.G * NWAVES;
    unsigned char* ws = a->ws;
    constexpr int I_G = (DM / 64) * (DFF / 64), I_D = (DFF / 64) * (DM / 64), I_IN = (DM / 64) * (IN_W / 64), I_OUT = (DM / 64) * (DM / 64);
    constexpr int NITEMS = 2 * (2 * I_G + I_D) + I_IN + I_OUT;
    for (int it = gw; it < NITEMS; it += NGW) {
        int r = it;
        if (r < I_G) { transpose_item(a->in[4], DM, DFF, (bf16*)(ws + WS_W1A), 1, scr, r, F.lane); continue; } r -= I_G;
        if (r < I_G) { transpose_item(a->in[5], DM, DFF, (bf16*)(ws + WS_W1A), 2, scr, r, F.lane); continue; } r -= I_G;
        if (r < I_D) { transpose_item(a->in[6], DFF, DM, (bf16*)(ws + WS_W1D), 0, scr, r, F.lane); continue; } r -= I_D;
        if (r < I_IN) { transpose_item(a->in[8], DM, IN_W, (bf16*)(ws + WS_WIN), 0, scr, r, F.lane); continue; } r -= I_IN;
        if (r < I_OUT) { transpose_item(a->in[16], DM, DM, (bf16*)(ws + WS_WOUT), 0, scr, r, F.lane); continue; } r -= I_OUT;
        if (r < I_G) { transpose_item(a->in[18], DM, DFF, (bf16*)(ws + WS_W2A), 1, scr, r, F.lane); continue; } r -= I_G;
        if (r < I_G) { transpose_item(a->in[19], DM, DFF, (bf16*)(ws + WS_W2A), 2, scr, r, F.lane); continue; } r -= I_G;
        transpose_item(a->in[20], DFF, DM, (bf16*)(ws + WS_W2D), 0, scr, r, F.lane);
    }
    bf16* HN = (bf16*)(ws + WS_HN); float* XM = (float*)(ws + WS_XMETA);
    for (int m = gw; m < MP; m += NGW) {
        if (m < NTOK) { const float* x = m < S_P ? a->in[0] + (size_t)m * DM : a->in[1] + (size_t)(m - S_P) * DM; rms_row<false>(x, a->in[3], HN + (size_t)m * DM, F.lane); }
        else { const int i = m - NTOK; f32x4* xm = (f32x4*)(XM + (size_t)i * DM) + F.lane;
            if (i < NMETA) { const float* x = a->in[2] + (size_t)i * DM; rms_row<false>(x, a->in[3], HN + (size_t)m * DM, F.lane);
#pragma unroll
                for (int j = 0; j < 16; ++j) xm[64 * j] = ((const f32x4*)x + F.lane)[64 * j]; }
            else { zero_row_bf16(HN + (size_t)m * DM, F.lane);
#pragma unroll
                for (int j = 0; j < 16; ++j) xm[64 * j] = (f32x4){0.f, 0.f, 0.f, 0.f}; } }
    }
}
__device__ __forceinline__ void p_norm(Frame& F, ArgsP a, const float* g, bool with_meta) {
    const int gw = F.vcu * NWAVES + F.wave, NGW = F.G * NWAVES;
    bf16* HN = (bf16*)(a->ws + WS_HN); const float* HM = (const float*)(a->ws + WS_HMETA);
    const int nrows = with_meta ? NTOK + NMETA : NTOK;
    for (int m = gw; m < nrows; m += NGW) {
        const float* x = m < NTOK ? a->out + (size_t)m * DM : HM + (size_t)(m - NTOK) * DM;
        rms_row<false>(x, g, HN + (size_t)m * DM, F.lane);
    }
}
__device__ __forceinline__ void p_rope(Frame& F, ArgsP a) {
    const int gw = F.vcu * NWAVES + F.wave, NGW = F.G * NWAVES;
    bf16* PR = (bf16*)(a->ws + WS_BIG);
    const int g = F.lane >> 1, ah = F.lane & 1;
    const int col = (g < 16 ? C_QD : C_KD) + (g & 15) * 128 + 8 * ah;
    float inv[8];
#pragma unroll
    for (int e = 0; e < 8; ++e) inv[e] = exp2f(-(float)(8 * ah + e) * (18.931568569324174f / 16.0f));
    for (int m = gw; m < NTOK + NMETA; m += NGW) {
        const int pos = m < S_P ? NMETA + m : (m < NTOK ? NMETA + ((m - S_P) & (S_S - 1)) : m - NTOK);
        bf16* p = PR + (size_t)m * IN_W + col;
        const v4u x1 = *(const v4u*)p, x2 = *(const v4u*)(p + 16);
        unsigned y1[4], y2[4];
#pragma unroll
        for (int e = 0; e < 4; ++e) {
            const unsigned w1 = x1[e], w2 = x2[e];
            const float a0 = __uint_as_float(w1 << 16), a1 = __uint_as_float(w1 & 0xffff0000u), b0 = __uint_as_float(w2 << 16), b1 = __uint_as_float(w2 & 0xffff0000u);
            const float t0 = (float)pos * inv[2 * e], t1 = (float)pos * inv[2 * e + 1];
            const float c0 = cosf(t0), s0 = sinf(t0), c1 = cosf(t1), s1 = sinf(t1);
            y1[e] = pk2(a0 * c0 - b0 * s0, a1 * c1 - b1 * s1); y2[e] = pk2(a0 * s0 + b0 * c0, a1 * s1 + b1 * c1);
        }
        *(v4u*)p = (v4u){y1[0], y1[1], y1[2], y1[3]}; *(v4u*)(p + 16) = (v4u){y2[0], y2[1], y2[2], y2[3]};
    }
}
__device__ __forceinline__ void p_final(Frame& F, ArgsP a) {
    const int gw = F.vcu * NWAVES + F.wave, NGW = F.G * NWAVES;
    for (int m = gw; m < NTOK; m += NGW) rms_row<true>(a->out + (size_t)m * DM, a->in[21], a->out + (size_t)m * DM, F.lane);
}

__device__ __forceinline__ void diff_unit(Frame& F, ArgsP a, int seq_row0, int S, int h, int qb) {
    using namespace att;
    const att::rsrc_t rs = __builtin_amdgcn_make_buffer_rsrc((void*)(a->ws + WS_BIG), 0, (int)((size_t)MP * IN_W * 2), 0x00020000); bf16* MIX = (bf16*)(a->ws + WS_HN);
    ATT_LAS char* lds = (ATT_LAS char*)(F.lds + RING_OFF);
    const int qrow0 = seq_row0 + qb * 256, NT = 1 + S / 64;
    const NaCtx na{0, 0, 0, 0, 0, nullptr};
    for (int run = 0; run < 4; ++run) {
        const int map = run & 1, vh = run >> 1;
        f32x16 o[4];
        attn_run<false>(rs, ((unsigned)qrow0 * LD + C_QD + (h * 2 + map) * 128) * 2u, (unsigned)(C_KD + (h * 2 + map) * 128) * 2u, (unsigned)(C_VD + h * 256 + vh * 128) * 2u, seq_row0, NT, lds, na, o);
        int tt = F.tid; asm volatile("" : "+v"(tt));
        const int r32 = tt & 31, hi = (tt >> 5) & 1, wv = tt >> 6;
        f32x4* scr = (f32x4*)((float*)(a->ws + WS_SCR) + ((size_t)blockIdx.x * 512 + tt) * 128);
        ATT_LAS float* ssq_l = (ATT_LAS float*)(F.lds + ATT_SSQ_OFF) + wv * 32;
        if (map == 0) {
#pragma unroll
            for (int d = 0; d < 4; ++d)
#pragma unroll
                for (int q = 0; q < 4; ++q) scr[d * 4 + q] = (f32x4){o[d][4 * q], o[d][4 * q + 1], o[d][4 * q + 2], o[d][4 * q + 3]};
        } else {
            float lam; { const int ln = tt & 63; const float* lq1 = a->in[11]; const float* lk1 = a->in[12]; const float* lq2 = a->in[13]; const float* lk2 = a->in[14];
                const float d1 = wave_sum(lq1[ln] * lk1[ln] + lq1[ln + 64] * lk1[ln + 64]), d2 = wave_sum(lq2[ln] * lk2[ln] + lq2[ln + 64] * lk2[ln + 64]);
                lam = expf(d1) - expf(d2) + LAM_INIT; }
#pragma unroll
            for (int d = 0; d < 4; ++d)
#pragma unroll
                for (int q = 0; q < 4; ++q) { const f32x4 t = scr[d * 4 + q];
#pragma unroll
                    for (int e = 0; e < 4; ++e) o[d][4 * q + e] = t[e] - lam * o[d][4 * q + e]; }
            float sq[16];
#pragma unroll
            for (int r = 0; r < 16; ++r) { float s = 0.f;
#pragma unroll
                for (int d = 0; d < 4; ++d) s += o[d][r] * o[d][r];
                sq[r] = half_sum(s); }
            if (vh == 0) {
#pragma unroll
                for (int d = 0; d < 4; ++d)
#pragma unroll
                    for (int q = 0; q < 4; ++q) scr[16 + d * 4 + q] = (f32x4){o[d][4 * q], o[d][4 * q + 1], o[d][4 * q + 2], o[d][4 * q + 3]};
                if (r32 == 0) {
#pragma unroll
                    for (int r = 0; r < 16; ++r) ssq_l[crow(r, hi)] = sq[r]; }
            } else {
                float g0[4], g1[4]; const float* gn = a->in[15];
#pragma unroll
                for (int d = 0; d < 4; ++d) { g0[d] = gn[d * 32 + r32]; g1[d] = gn[128 + d * 32 + r32]; }
                bf16* ob = MIX + (size_t)(qrow0 + wv * 32 + 4 * hi) * DM + NA_W + h * 256 + r32;
#pragma unroll
                for (int q = 0; q < 4; ++q) {
                    f32x4 t[4];
#pragma unroll
                    for (int d = 0; d < 4; ++d) t[d] = scr[16 + d * 4 + q];
#pragma unroll
                    for (int e = 0; e < 4; ++e) { const int r = 4 * q + e;
                        const float rs = (1.0f - LAM_INIT) / sqrtf((sq[r] + ssq_l[8 * q + e + 4 * hi]) * (1.0f / 256.0f) + SUBLN_EPS);
                        bf16* op = ob + (size_t)(8 * q + e) * DM;
#pragma unroll
                        for (int d = 0; d < 4; ++d) { op[128 + d * 32] = f2bf_s(o[d][r] * rs * g1[d]); op[d * 32] = f2bf_s(t[d][e] * rs * g0[d]); } } }
            }
        }
    }
}
__device__ __forceinline__ void na_unit(Frame& F, ArgsP a, int seq_row0, int nrows, int h, int qb) {
    using namespace att;
    const att::rsrc_t rs = __builtin_amdgcn_make_buffer_rsrc((void*)(a->ws + WS_BIG), 0, (int)((size_t)MP * IN_W * 2), 0x00020000); bf16* MIX = (bf16*)(a->ws + WS_HN);
    ATT_LAS char* lds = (ATT_LAS char*)(F.lds + RING_OFF);
    ATT_LAS float* rpb = (ATT_LAS float*)(F.lds + ATT_RPB_OFF);
    const int r32 = F.lane & 31, hi = F.lane >> 5;
    __syncthreads();
    for (int i = F.tid; i < 15 * 31; i += NWAVES * 64) rpb[i] = a->in[9][h * 465 + i] * (1.0f / SCALE);
    const int qrow0 = seq_row0 + qb * 256;
    NaCtx na; na.qrow = 4 * qb + (F.wave >> 1); na.r0 = min(max(na.qrow - 4, 0), nrows - 8); na.kr_first = min(max(4 * qb - 4, 0), nrows - 12);
    na.c = 32 * (F.wave & 1) + r32; na.c0 = min(max(na.c - 8, 0), 48); na.rpb = rpb;
    f32x16 o[4];
    attn_run<true>(rs, ((unsigned)qrow0 * LD + C_QNA + h * 128) * 2u, (unsigned)(C_KNA + h * 128) * 2u, (unsigned)(C_VNA + h * 128) * 2u, seq_row0 + na.kr_first * 64, 13, lds, na, o);
    int tt = F.tid; asm volatile("" : "+v"(tt));
    const int e32 = tt & 31, ehi = (tt >> 5) & 1, wv = tt >> 6;
    const float* gn = a->in[10] + h * 128;
    float g[4];
#pragma unroll
    for (int d = 0; d < 4; ++d) g[d] = gn[d * 32 + e32];
    bf16* ob = MIX + (size_t)(qrow0 + wv * 32 + 4 * ehi) * DM + h * 128 + e32;
#pragma unroll
    for (int r = 0; r < 16; ++r) { float s = 0.f;
#pragma unroll
        for (int d = 0; d < 4; ++d) s += o[d][r] * o[d][r];
        const float rs = 1.0f / sqrtf(half_sum(s) * (1.0f / 128.0f) + EPS);
        bf16* op = ob + (size_t)((r & 3) + 8 * (r >> 2)) * DM;
#pragma unroll
        for (int d = 0; d < 4; ++d) op[d * 32] = f2bf_s(o[d][r] * rs * g[d]); }
}
__device__ __forceinline__ void p_attention(Frame& F, ArgsP a) {
    const int v = F.vcu;
    for (int i = 0; i < 3 * 256; i += 256) { const int u = i + v; if (v >= 256 && i > 0) break;
        int seq_row0, S, h, qb;
        if (F.G == 256) {
            const int x = v >> 5, w = v & 31;
            if (i == 0) { seq_row0 = 0; S = S_P; h = x; qb = w; }
            else { const int pair = 4 * x + 2 * ((i >> 8) - 1) + (w >> 4); seq_row0 = S_P + (pair >> 3) * S_S; S = S_S; h = pair & 7; qb = w & 15; }
        } else { seq_row0 = 0; S = S_P; h = 0; qb = 0; }
#ifndef ATT_NO_DIFF
        if (F.G == 256) diff_unit(F, a, seq_row0, S, h, qb);
#endif
        (void)u; }
    for (int n = v; n < 16 * 96; n += F.G) { const int h = n / 96, q = n - h * 96; int seq_row0, nrows, qb;
        if (q < 32) { seq_row0 = 0; nrows = S_P / 64; qb = q; }
        else { const int t = q - 32; seq_row0 = S_P + (t >> 4) * S_S; nrows = S_S / 64; qb = t & 15; }
#ifndef ATT_NO_NA
        na_unit(F, a, seq_row0, nrows, h, qb);
#endif
    }
}

__global__ void __launch_bounds__(NWAVES * 64, 2) mk_fwd(Args args) {
    extern __shared__ __attribute__((aligned(16))) unsigned char lds[];
    Frame F;
    F.lds = (LAS unsigned char*)lds;
    F.MISC = (volatile LAS unsigned*)(F.lds + MISC_OFF);
    F.tid = threadIdx.x; F.lane = F.tid & 63; F.wave = __builtin_amdgcn_readfirstlane(F.tid >> 6);
    F.G = gridDim.x; { const int bx = blockIdx.x; F.vcu = (F.G % 8 == 0) ? (bx % 8) * (F.G / 8) + bx / 8 : bx; }
    int lo, hi;
    { ARGS_HERE(a0); F.ctl = (gu32*)(a0->ws + WS_CTL); lo = a0->ph_lo; hi = a0->ph_hi; }
    for (int u = F.tid; u < (LDS_BYTES - LDSCTL_OFF) / 4; u += NWAVES * 64) ((LAS unsigned*)(F.lds + LDSCTL_OFF))[u] = 0u;
    __syncthreads();
    XcdBarrier bar; bar.bar = (unsigned*)(F.ctl + CW_BAR); bar.x = 0; bar.st = nullptr;
    if (N_LAUNCHES == 1) bar = xcd_barrier_post((unsigned*)(F.ctl + CW_BAR), F.MISC + 8);
#ifndef PH_MASK
#define PH_MASK 0xFFF
#endif
#define IN(k) ((((PH_MASK) >> (k)) & 1) && lo <= (k) && (k) < hi)
#define SEAM(k) do { if (IN(k) && IN((k) + 1)) xcd_barrier(bar); } while (0)
#define WSP(T, off) ((T*)(a->ws + (off)))

    if (IN(0)) { ARGS_HERE(a); p0_prologue(F, a); } SEAM(0);
    if (IN(1)) {
        ARGS_HERE(a);
        pg8::Gemm g{WSP(bf16, WS_HN), WSP(bf16, WS_W1A), MP, 2 * DFF, DM}; pg8::StaticOrder S; S.init(MP, 2 * DFF, F.G, (int)blockIdx.x);
        pg8::EpiSwiglu E{WSP(bf16, WS_BIG), DFF};
        pg8::gemm_phase<pg8::EpiSwiglu, pg8::StaticOrder, true, true>(F.lds + RING_OFF, g, S, E); } SEAM(1);
    if (IN(2)) {
        ARGS_HERE(a);
        pg8::Gemm g{WSP(bf16, WS_BIG), WSP(bf16, WS_W1D), MP, DM, DFF}; pg8::StaticOrder S; S.init(MP, DM, F.G, (int)blockIdx.x);
        pg8::EpiResid E{a->in[0], a->in[1], WSP(float, WS_XMETA), a->out, WSP(float, WS_HMETA), 0.5f, DM};
        pg8::gemm_phase<pg8::EpiResid, pg8::StaticOrder, true, true>(F.lds + RING_OFF, g, S, E); } SEAM(2);
    if (IN(3)) { ARGS_HERE(a); p_norm(F, a, a->in[7], true); } SEAM(3);
    if (IN(4)) {
        ARGS_HERE(a);
        pg8::Gemm g{WSP(bf16, WS_HN), WSP(bf16, WS_WIN), MP, IN_W, DM}; pg8::StaticOrder S; S.init(MP, IN_W, F.G, (int)blockIdx.x);
        pg8::EpiProj E{WSP(bf16, WS_BIG), IN_W};
        pg8::gemm_phase<pg8::EpiProj, pg8::StaticOrder, true, true>(F.lds + RING_OFF, g, S, E); } SEAM(4);
    if (IN(5)) { ARGS_HERE(a); p_rope(F, a); } SEAM(5);
    if (IN(6)) { ARGS_HERE(a); p_attention(F, a); } SEAM(6);
    if (IN(7)) {
        ARGS_HERE(a);
        pg8::Gemm g{WSP(bf16, WS_HN), WSP(bf16, WS_WOUT), NTOK, DM, DM}; pg8::StaticOrder S; S.init(NTOK, DM, F.G, (int)blockIdx.x);
        float* o = a->out;
        pg8::EpiResid E{o, o + (size_t)32 * 256 * DM, nullptr, o, nullptr, 1.0f, DM};
        pg8::gemm_phase<pg8::EpiResid, pg8::StaticOrder, true, true>(F.lds + RING_OFF, g, S, E); } SEAM(7);
    if (IN(8)) { ARGS_HERE(a); p_norm(F, a, a->in[17], false); } SEAM(8);
    if (IN(9)) {
        ARGS_HERE(a);
        pg8::Gemm g{WSP(bf16, WS_HN), WSP(bf16, WS_W2A), NTOK, 2 * DFF, DM}; pg8::StaticOrder S; S.init(NTOK, 2 * DFF, F.G, (int)blockIdx.x);
        pg8::EpiSwiglu E{WSP(bf16, WS_BIG), DFF};
        pg8::gemm_phase<pg8::EpiSwiglu, pg8::StaticOrder, true, true>(F.lds + RING_OFF, g, S, E); } SEAM(9);
    if (IN(10)) {
        ARGS_HERE(a);
        pg8::Gemm g{WSP(bf16, WS_BIG), WSP(bf16, WS_W2D), NTOK, DM, DFF}; pg8::StaticOrder S; S.init(NTOK, DM, F.G, (int)blockIdx.x);
        float* o = a->out;
        pg8::EpiResid E{o, o + (size_t)32 * 256 * DM, nullptr, o, nullptr, 0.5f, DM};
        pg8::gemm_phase<pg8::EpiResid, pg8::StaticOrder, true, true>(F.lds + RING_OFF, g, S, E); } SEAM(10);
    if (IN(11)) { ARGS_HERE(a); p_final(F, a); }
#undef IN
#undef SEAM
#undef WSP
}

extern "C" void kernel_launch(void* const* d_in, const int* in_sizes, int n_in, void* d_out, int out_size, void* d_ws, size_t ws_size, hipStream_t stream) {
    static int grid = 0;
    if (grid == 0) {
        if (n_in != 22 || in_sizes[0] != S_P * DM || in_sizes[1] != NB_S * S_S * DM || out_size != NTOK * DM || ws_size < WS_END) {
            fprintf(stderr, "kernel_launch: shape mismatch: n_in %d in0 %d in1 %d out %d ws %zu (need %zu)\n", n_in, n_in > 0 ? in_sizes[0] : -1, n_in > 1 ? in_sizes[1] : -1, out_size, ws_size, (size_t)WS_END); grid = -1; return; }
        int dev = 0, cus = 0, per_cu = 0;
        if (hipGetDevice(&dev) != hipSuccess || hipDeviceGetAttribute(&cus, hipDeviceAttributeMultiprocessorCount, dev) != hipSuccess) { grid = -1; return; }
        if (hipFuncSetAttribute((const void*)mk_fwd, hipFuncAttributeMaxDynamicSharedMemorySize, LDS_BYTES) != hipSuccess) { fprintf(stderr, "kernel_launch: hipFuncSetAttribute failed\n"); grid = -1; return; }
        if (hipOccupancyMaxActiveBlocksPerMultiprocessor(&per_cu, (const void*)mk_fwd, NWAVES * 64, LDS_BYTES) != hipSuccess || per_cu < 1)
            fprintf(stderr, "kernel_launch: note: occupancy query reports %d workgroups per CU\n", per_cu);
        (void)hipGetLastError();
        grid = cus;
    }
    if (grid < 0) return;
    if (hipMemsetAsync((char*)d_ws + WS_CTL, 0, CTL_ZERO_BYTES, stream) != hipSuccess) { fprintf(stderr, "kernel_launch: memset failed\n"); return; }
    Args a{};
    for (int i = 0; i < 22; ++i) a.in[i] = (const float*)d_in[i];
    a.out = (float*)d_out; a.ws = (unsigned char*)d_ws;
    for (int li = 0; li < N_LAUNCHES; ++li) {
        a.ph_lo = (N_LAUNCHES == 1) ? 0 : li; a.ph_hi = (N_LAUNCHES == 1) ? N_PHASES : li + 1;
        hipLaunchKernelGGL(mk_fwd, dim3(grid), dim3(NWAVES * 64), LDS_BYTES, stream, a);
        const hipError_t le = hipPeekAtLastError();
        if (le != hipSuccess) { fprintf(stderr, "kernel_launch: launch %d failed: %s\n", li, hipGetErrorName(le)); break; }
    }
}
```

```cpp
#include <hip/hip_runtime.h>
#include <cstdio>
#include <cstdint>
#include <cmath>
namespace pg8 {
#define PG8_LAS __attribute__((address_space(3)))
typedef unsigned short bf16_t;
typedef short bf16x8 __attribute__((ext_vector_type(8)));
typedef float f32x4 __attribute__((ext_vector_type(4)));
typedef unsigned u32x4 __attribute__((ext_vector_type(4)));
constexpr int BM = 256, BK = 64, HALF = 128, HTB = HALF * BK * 2  , STAGE_BYTES = 8 * HTB, NXCD = 8, WGM = 8;

__host__ __device__ __forceinline__ int lds_byte(int r, int c) { const int st = (r >> 4) * 2 + (c >> 5), rr = r & 15, cc = c & 31, ob = rr * 64 + cc * 2; return st * 1024 + (ob ^ (((ob >> 9) & 1) << 5)); }
__host__ __device__ __forceinline__ void stage_rc(int b, int& R, int& C) { const int st = b / 1024, sb = b % 1024, swz = sb ^ (((sb >> 9) & 1) << 5); R = (st >> 1) * 16 + swz / 64; C = (st & 1) * 32 + (swz % 64) / 2; }
__host__ __device__ __forceinline__ int perm32(int rho) { const int n = rho >> 4, i = rho & 15; return 8 * (i >> 2) + 4 * n + (i & 3); }

struct Unit { int pm, pn; };
struct Gemm { const bf16_t* A; const bf16_t* Bt; int M, N, K; };

struct StaticOrder {
    int nM, nN, nwg, G, c, fold;
    __host__ __device__ void init(int M, int N, int G_, int c_) { nM = M / BM; nN = N / BM; nwg = nM * nN; G = G_; c = c_; fold = 0; }
    __host__ __device__ bool next(int i, Unit& u) const {
        const long L = (long)i * G + c; if (L >= nwg) return false;
        int wgid = (int)L; { const int q = nwg / NXCD, r = nwg % NXCD, xcd = wgid % NXCD, off = wgid / NXCD; wgid = (xcd < r ? xcd * (q + 1) : r * (q + 1) + (xcd - r) * q) + off; }
        const int nig = WGM * nN, gid = wgid / nig, fm = gid * WGM, gsz = (nM - fm) < WGM ? (nM - fm) : WGM;
        u.pm = fm + ((wgid % nig) % gsz); u.pn = (wgid % nig) / gsz; if (fold) { u.pm &= 1; u.pn &= 1; } return true;
    }
    __device__ __forceinline__ void a_ready(const Unit&) const {}
    __device__ __forceinline__ void done(const Unit&) const {}
};

__device__ __forceinline__ unsigned cvt_pk_bf16(float lo, float hi) { unsigned r; asm volatile("v_cvt_pk_bf16_f32 %0, %1, %2" : "=v"(r) : "v"(lo), "v"(hi)); return r; }
typedef float f32x2 __attribute__((ext_vector_type(2)));

__device__ __forceinline__ int pg8_lane_now() { int l; asm volatile("v_mbcnt_lo_u32_b32 %0, -1, 0\n\tv_mbcnt_hi_u32_b32 %0, -1, %0" : "=v"(l)); return l; }
__device__ __forceinline__ float silu_mul(float g, float up) { const float e = __builtin_amdgcn_exp2f(g * -1.4426950408889634f); return g * __builtin_amdgcn_rcpf(1.0f + e) * up; }
__device__ __forceinline__ float bf_lo(unsigned w) { return __uint_as_float(w << 16); }
__device__ __forceinline__ float bf_hi(unsigned w) { return __uint_as_float(w & 0xffff0000u); }
struct EpiSwiglu {
    static constexpr bool PERM = true, AFTER_DRAIN = false;
    bf16_t* O; int ldc; const float* rs;
    __device__ __forceinline__ void operator()(const f32x4 (&acc)[2][2][4][2], const Unit& u, int wr, int wc, int fr, int fq) const {
        const int row0 = u.pm * BM + wr * 64 + fr, col0 = u.pn * HALF + wc * 32 + 8 * fq;
#pragma unroll
        for (int ai = 0; ai < 2; ++ai)
#pragma unroll
            for (int m = 0; m < 4; ++m) { const int row = row0 + ai * HALF + m * 16; bf16_t* rowp = O + (size_t)row * ldc + col0;
                const float sc = rs ? rs[row] : 1.0f;
                float v[8];
#pragma unroll
                for (int n = 0; n < 2; ++n)
#pragma unroll
                    for (int j = 0; j < 4; ++j) v[n * 4 + j] = silu_mul(acc[ai][0][m][n][j] * sc, acc[ai][1][m][n][j] * sc);
                u32x4 w; w.x = cvt_pk_bf16(v[0], v[1]); w.y = cvt_pk_bf16(v[2], v[3]); w.z = cvt_pk_bf16(v[4], v[5]); w.w = cvt_pk_bf16(v[6], v[7]);
                *(u32x4*)rowp = w; }
    }
};
struct EpiProj {
    static constexpr bool PERM = true, AFTER_DRAIN = false;
    bf16_t* O; int ldc; const float* rs;
    __device__ __forceinline__ void operator()(const f32x4 (&acc)[2][2][4][2], const Unit& u, int wr, int wc, int fr, int fq) const {
        const int row0 = u.pm * BM + wr * 64 + fr, col0 = u.pn * BM + wc * 32 + 8 * fq;
#pragma unroll
        for (int ai = 0; ai < 2; ++ai)
#pragma unroll
            for (int m = 0; m < 4; ++m) { const int row = row0 + ai * HALF + m * 16; bf16_t* rowp = O + (size_t)row * ldc + col0;
                const float sc = rs ? rs[row] : 1.0f;
#pragma unroll
                for (int bj = 0; bj < 2; ++bj) { const f32x4 v0 = acc[ai][bj][m][0] * sc, v1 = acc[ai][bj][m][1] * sc;
                    u32x4 w; w.x = cvt_pk_bf16(v0[0], v0[1]); w.y = cvt_pk_bf16(v0[2], v0[3]); w.z = cvt_pk_bf16(v1[0], v1[1]); w.w = cvt_pk_bf16(v1[2], v1[3]);
                    *(u32x4*)(rowp + bj * HALF) = w; } }
    }
};
template <int SRC, int DST> struct EpiRes {
    static constexpr bool PERM = true, AFTER_DRAIN = false;
    const float* s0; const float* s1; const bf16_t* sb; float* df; bf16_t* db; float* ssq; float alpha; int ldc;
    __device__ __forceinline__ void operator()(const f32x4 (&acc)[2][2][4][2], const Unit& u, int wr, int wc, int fr, int fq) const {
        const int pm = u.pm;
        const char* sfb = (const char*)(pm < 32 ? s0 + (size_t)pm * BM * ldc : s1 + (size_t)(pm - 32) * BM * ldc);
        const char* sbb = (const char*)(sb + (size_t)pm * BM * ldc); char* dbb = (char*)(db + (size_t)pm * BM * ldc); char* dfb = (char*)(df + (size_t)pm * BM * ldc);
        float* sqb = ssq + (size_t)pm * BM * 64 + 4 * u.pn + wc;
        const int rloc0 = wr * 64 + fr; const unsigned col0 = (unsigned)(u.pn * BM + wc * 32 + 8 * fq);
#pragma unroll
        for (int ai = 0; ai < 2; ++ai) {
            f32x4 hf[SRC == 0 ? 4 : 1][2][2]; u32x4 hw[SRC == 1 ? 4 : 1][2];
            if constexpr (SRC != 2)
#pragma unroll
            for (int m = 0; m < 4; ++m) { const unsigned eoff = (unsigned)(rloc0 + ai * HALF + m * 16) * (unsigned)ldc + col0;
#pragma unroll
                for (int bj = 0; bj < 2; ++bj) {
                    if constexpr (SRC == 0) { hf[m][bj][0] = *(const f32x4*)(sfb + (eoff + bj * HALF) * 4u); hf[m][bj][1] = *(const f32x4*)(sfb + (eoff + bj * HALF + 4) * 4u); }
                    else hw[m][bj] = *(const u32x4*)(sbb + (eoff + bj * HALF) * 2u); } }
#pragma unroll
            for (int m = 0; m < 4; ++m) { const int rloc = rloc0 + ai * HALF + m * 16; const unsigned eoff = (unsigned)rloc * (unsigned)ldc + col0;
                float sq = 0.f;
#pragma unroll
                for (int bj = 0; bj < 2; ++bj) { f32x4 h0, h1;
                    if constexpr (SRC == 0) { h0 = hf[m][bj][0]; h1 = hf[m][bj][1]; }
                    else if constexpr (SRC == 2) { h0 = (f32x4){0.f, 0.f, 0.f, 0.f}; h1 = h0; }
                    else { const u32x4 w = hw[m][bj]; h0 = (f32x4){bf_lo(w.x), bf_hi(w.x), bf_lo(w.y), bf_hi(w.y)}; h1 = (f32x4){bf_lo(w.z), bf_hi(w.z), bf_lo(w.w), bf_hi(w.w)}; }
                    h0 = h0 + acc[ai][bj][m][0] * alpha; h1 = h1 + acc[ai][bj][m][1] * alpha;
                    if constexpr (DST == 1) sq += ((h0[0] * h0[0] + h0[1] * h0[1]) + (h0[2] * h0[2] + h0[3] * h0[3])) + ((h1[0] * h1[0] + h1[1] * h1[1]) + (h1[2] * h1[2] + h1[3] * h1[3]));
                    if constexpr (DST == 0) { *(f32x4*)(dfb + (eoff + bj * HALF) * 4u) = h0; *(f32x4*)(dfb + (eoff + bj * HALF + 4) * 4u) = h1; }
                    else { u32x4 w; w.x = cvt_pk_bf16(h0[0], h0[1]); w.y = cvt_pk_bf16(h0[2], h0[3]); w.z = cvt_pk_bf16(h1[0], h1[1]); w.w = cvt_pk_bf16(h1[2], h1[3]);
                        *(u32x4*)(dbb + (eoff + bj * HALF) * 2u) = w; } }
                if constexpr (DST == 1) { sq += __shfl_xor(sq, 16); sq += __shfl_xor(sq, 32);
                    if (fq == 0) sqb[(unsigned)rloc * 64u] = sq; } }
            asm volatile("" ::: "memory"); }
    }
};

template <class Epi, class Sched, bool ALIGN_EPI = false, bool SP2 = false>
__device__ __forceinline__ void gemm_phase(PG8_LAS unsigned char* lds, const Gemm g, const Sched& S, const Epi& E, const int wave_) {
    const int wid = wave_, lane = pg8_lane_now(), tid = wid * 64 + lane, wr = wid >> 2, wc = wid & 3, fr = lane & 15, fq = lane >> 4;
    const int K = g.K, nt = K / BK;
    unsigned voffA[2], voffB[2];
#pragma unroll
    for (int i = 0; i < 2; ++i) { int R, C; stage_rc(tid * 16 + i * 8192, R, C); const int Rb = Epi::PERM ? ((R & ~31) + perm32(R & 31)) : R;
        voffA[i] = (unsigned)(R * K + C) * 2u; voffB[i] = (unsigned)(Rb * K + C) * 2u; }
    const size_t kstep = (size_t)(BK * 2);
    const size_t hstep = (size_t)HALF * K * 2;
    const size_t tstep = 2 * hstep;
    const unsigned ldsw = (unsigned)wid * 1024u;
    const int aoff = lds_byte(wr * 64 + fr, fq * 8), boff = lds_byte(wc * 32 + fr, fq * 8);
#define PG8_SA(b, h) (((b) * 2 + (h)) * HTB)
#define PG8_SB(b, h) ((4 + (b) * 2 + (h)) * HTB)
#define PG8_STAGE(bufoff, gbase, voff) do { _Pragma("unroll") for (int _i = 0; _i < 2; ++_i) \
        __builtin_amdgcn_global_load_lds((const unsigned*)((const char*)(gbase) + (voff)[_i]), (PG8_LAS unsigned*)(lds + (bufoff) + ldsw + _i * 8192), 16, 0, 0); } while (0)
#define PG8_LDA(dst, b, h) do { _Pragma("unroll") for (int m = 0; m < 4; ++m) _Pragma("unroll") for (int k = 0; k < 2; ++k) dst[m][k] = *(const PG8_LAS bf16x8*)(lds + PG8_SA(b, h) + aoff + m * 2048 + k * 1024); } while (0)
#define PG8_LDB(dst, b, h) do { _Pragma("unroll") for (int n = 0; n < 2; ++n) _Pragma("unroll") for (int k = 0; k < 2; ++k) dst[n][k] = *(const PG8_LAS bf16x8*)(lds + PG8_SB(b, h) + boff + n * 2048 + k * 1024); } while (0)
#define PG8_MMA(ai, bj, At, Bt) do { __builtin_amdgcn_s_setprio(1); _Pragma("unroll") for (int m = 0; m < 4; ++m) _Pragma("unroll") for (int n = 0; n < 2; ++n) _Pragma("unroll") for (int k = 0; k < 2; ++k) \
        acc[ai][bj][m][n] = __builtin_amdgcn_mfma_f32_16x16x32_bf16(Bt[n][k], At[m][k], acc[ai][bj][m][n], 0, 0, 0); __builtin_amdgcn_s_setprio(0); } while (0)
#define PG8_WAIT_V(n) asm volatile("s_waitcnt vmcnt(" #n ")" ::: "memory")
#define PG8_WAIT_L(n) asm volatile("s_waitcnt lgkmcnt(" #n ")" ::: "memory")
#define PG8_BAR __builtin_amdgcn_s_barrier()
#define PG8_SCHED __builtin_amdgcn_sched_barrier(0)
    Unit cur, nxt; int ui = 0;
    if (!S.next(0, cur)) return;
    f32x4 acc[2][2][4][2];
#pragma unroll
    for (int a = 0; a < 2; ++a)
#pragma unroll
        for (int b = 0; b < 2; ++b)
#pragma unroll
            for (int m = 0; m < 4; ++m)
#pragma unroll
                for (int n = 0; n < 2; ++n) acc[a][b][m][n] = (f32x4){0.f, 0.f, 0.f, 0.f};
    bf16x8 At[4][2], B0[2][2], B1[2][2];
    const char* cA = (const char*)g.A + (size_t)cur.pm * tstep; const char* cB = (const char*)g.Bt + (size_t)cur.pn * tstep;
    S.a_ready(cur);
    if constexpr (SP2) {
        PG8_STAGE(PG8_SB(0, 0), cB, voffB); PG8_STAGE(PG8_SB(0, 1), cB + hstep, voffB); PG8_STAGE(PG8_SA(0, 0), cA, voffA); PG8_STAGE(PG8_SA(0, 1), cA + hstep, voffA);
        if (wr == 1) PG8_BAR;
        PG8_WAIT_V(2); PG8_BAR;
        PG8_STAGE(PG8_SB(1, 0), cB + kstep, voffB); PG8_STAGE(PG8_SA(1, 0), cA + kstep, voffA); PG8_STAGE(PG8_SB(1, 1), cB + hstep + kstep, voffB);
        PG8_WAIT_V(6); PG8_BAR;
    } else {
        PG8_STAGE(PG8_SB(0, 0), cB, voffB); PG8_STAGE(PG8_SA(0, 0), cA, voffA); PG8_STAGE(PG8_SB(0, 1), cB + hstep, voffB); PG8_STAGE(PG8_SA(0, 1), cA + hstep, voffA);
        if (wr == 1) PG8_BAR;
        PG8_WAIT_V(4); PG8_BAR;
        PG8_STAGE(PG8_SB(1, 0), cB + kstep, voffB); PG8_STAGE(PG8_SA(1, 0), cA + kstep, voffA); PG8_STAGE(PG8_SB(1, 1), cB + hstep + kstep, voffB);
        PG8_WAIT_V(6); PG8_BAR;
    }
    for (;;) {
        const bool has_next = S.next(ui + 1, nxt);
        const char* nA = has_next ? (const char*)g.A + (size_t)nxt.pm * tstep : cA; const char* nB = has_next ? (const char*)g.Bt + (size_t)nxt.pn * tstep : cB;
        for (int t = 0; t < nt; t += 2) {
            const bool last = (t == nt - 2);
            const char* a1 = cA + (size_t)(t + 1) * kstep;
            const char* a2 = last ? nA : cA + (size_t)(t + 2) * kstep; const char* b2 = last ? nB : cB + (size_t)(t + 2) * kstep;
            const char* a3 = a2 + kstep; const char* b3 = b2 + kstep;
            if (last && has_next) S.a_ready(nxt);
            if constexpr (SP2) {
            PG8_LDB(B0, 0, 0); PG8_LDB(B1, 0, 1); PG8_SCHED; PG8_LDA(At, 0, 0); PG8_STAGE(PG8_SA(1, 1), a1 + hstep, voffA);
            PG8_WAIT_V(8); PG8_WAIT_L(0); PG8_BAR; PG8_MMA(0, 0, At, B0); PG8_MMA(0, 1, At, B1); PG8_BAR; PG8_SCHED;
            PG8_LDA(At, 0, 1); PG8_STAGE(PG8_SB(0, 0), b2, voffB); PG8_STAGE(PG8_SB(0, 1), b2 + hstep, voffB); PG8_STAGE(PG8_SA(0, 0), a2, voffA);
            PG8_WAIT_V(8); PG8_WAIT_L(0); PG8_BAR; PG8_MMA(1, 0, At, B0); PG8_MMA(1, 1, At, B1); PG8_BAR; PG8_SCHED;
            PG8_LDB(B0, 1, 0); PG8_LDB(B1, 1, 1); PG8_SCHED; PG8_LDA(At, 1, 0); PG8_STAGE(PG8_SA(0, 1), a2 + hstep, voffA);
            PG8_WAIT_V(8); PG8_WAIT_L(0); PG8_BAR; PG8_MMA(0, 0, At, B0); PG8_MMA(0, 1, At, B1); PG8_BAR; PG8_SCHED;
            PG8_LDA(At, 1, 1); PG8_STAGE(PG8_SB(1, 0), b3, voffB); PG8_STAGE(PG8_SB(1, 1), b3 + hstep, voffB); PG8_STAGE(PG8_SA(1, 0), a3, voffA);
            PG8_WAIT_V(8); PG8_WAIT_L(0); PG8_BAR; PG8_MMA(1, 0, At, B0); PG8_MMA(1, 1, At, B1); PG8_BAR; PG8_SCHED;
            } else {
            PG8_LDB(B0, 0, 0); PG8_SCHED; PG8_LDA(At, 0, 0); PG8_STAGE(PG8_SA(1, 1), a1 + hstep, voffA);
            PG8_WAIT_L(8); PG8_BAR; PG8_WAIT_L(0); PG8_MMA(0, 0, At, B0); PG8_BAR; PG8_SCHED;
            PG8_LDB(B1, 0, 1); PG8_STAGE(PG8_SB(0, 0), b2, voffB);
            PG8_BAR; PG8_WAIT_L(0); PG8_MMA(0, 1, At, B1); PG8_BAR;
            PG8_LDA(At, 0, 1); PG8_STAGE(PG8_SA(0, 0), a2, voffA);
            PG8_BAR; PG8_WAIT_L(0); PG8_MMA(1, 0, At, B0); PG8_BAR; PG8_SCHED;
            PG8_STAGE(PG8_SB(0, 1), b2 + hstep, voffB);
            PG8_WAIT_V(6); PG8_BAR; PG8_MMA(1, 1, At, B1); PG8_BAR;
            PG8_LDB(B0, 1, 0); PG8_SCHED; PG8_LDA(At, 1, 0); PG8_STAGE(PG8_SA(0, 1), a2 + hstep, voffA);
            PG8_WAIT_L(8); PG8_BAR; PG8_WAIT_L(0); PG8_MMA(0, 0, At, B0); PG8_BAR; PG8_SCHED;
            PG8_LDB(B1, 1, 1); PG8_STAGE(PG8_SB(1, 0), b3, voffB);
            PG8_BAR; PG8_WAIT_L(0); PG8_MMA(0, 1, At, B1); PG8_BAR;
            PG8_LDA(At, 1, 1); PG8_STAGE(PG8_SA(1, 0), a3, voffA);
            PG8_BAR; PG8_WAIT_L(0); PG8_MMA(1, 0, At, B0); PG8_BAR; PG8_SCHED;
            PG8_STAGE(PG8_SB(1, 1), b3 + hstep, voffB);
            PG8_WAIT_V(6); PG8_BAR; PG8_MMA(1, 1, At, B1); PG8_BAR;
            }
        }
        if constexpr (ALIGN_EPI) { if (wr == 0) PG8_BAR; }
        if constexpr (!Epi::AFTER_DRAIN) { E(acc, cur, wr, wc, fr, fq); S.done(cur); }
        if (!has_next) break;
#pragma unroll
        for (int a = 0; a < 2; ++a)
#pragma unroll
            for (int b = 0; b < 2; ++b)
#pragma unroll
                for (int m = 0; m < 4; ++m)
#pragma unroll
                    for (int n = 0; n < 2; ++n) acc[a][b][m][n] = (f32x4){0.f, 0.f, 0.f, 0.f};
        cur = nxt; cA = nA; cB = nB; ++ui;
        if constexpr (ALIGN_EPI) { if (wr == 1) PG8_BAR; }
    }
    PG8_WAIT_V(0);
    if constexpr (!ALIGN_EPI) { if (wr == 0) PG8_BAR; }
    PG8_BAR;
    if constexpr (Epi::AFTER_DRAIN) { E.fused(acc, cur, wr, wc, fr, fq, lds, wid, lane); S.done(cur); }
#undef PG8_SA
#undef PG8_SB
#undef PG8_STAGE
#undef PG8_LDA
#undef PG8_LDB
#undef PG8_MMA
#undef PG8_WAIT_V
#undef PG8_WAIT_L
#undef PG8_BAR
#undef PG8_SCHED
}
}

namespace att {
#define ATT_LAS __attribute__((address_space(3)))
typedef unsigned short bf16_t;
using bf16x8 = __attribute__((ext_vector_type(8))) short;
using s16x4  = __attribute__((ext_vector_type(4))) short;
using f32x16 = __attribute__((ext_vector_type(16))) float;
using u32x4  = __attribute__((ext_vector_type(4))) unsigned;
constexpr int   D = 128, NW = 8, QBLK = 32, KVBLK = 64;
constexpr float SCALE = 0.088388347648318440f;
constexpr float THR = 8.f;
constexpr float NEG = -1.0e30f;
constexpr int   LD = 12288;
constexpr int   META_ROW = 24576;
constexpr int   SHM_V = KVBLK * D * 2, SHM_K = KVBLK * D * 2, SHM_ATTN = 2 * SHM_V + 2 * SHM_K + NW * 64 * 4;
#define KSWZ(row, colB) ((row) * 256 + ((colB) ^ (((row) & 7) << 4)))
#define SBAR() __builtin_amdgcn_sched_barrier(0)
__device__ __forceinline__ int crow(int r, int hi) { return (r & 3) + 8 * (r >> 2) + 4 * hi; }
__device__ __forceinline__ int lane_of() { int l; asm volatile("v_mbcnt_lo_u32_b32 %0, -1, 0\n\tv_mbcnt_hi_u32_b32 %0, -1, %0" : "=v"(l)); return l; }
__device__ __forceinline__ unsigned cvtpk(float lo, float hi) { unsigned r; asm volatile("v_cvt_pk_bf16_f32 %0, %1, %2" : "=v"(r) : "v"(lo), "v"(hi)); return r; }

struct NaCtx { int qrow, r0, kr_first, c, c0; const ATT_LAS float* rpb; };

__device__ __forceinline__ void partialSM(f32x16& p0, f32x16& p1, float& m_reg, float& mn, float& alpha) {
  constexpr float C = SCALE * 1.4426950408889634f;
  float pmax = p0[0];
#pragma unroll
  for (int r = 1; r < 16; ++r) pmax = fmaxf(pmax, p0[r]);
#pragma unroll
  for (int r = 0; r < 16; ++r) pmax = fmaxf(pmax, p1[r]);
  { auto rr = __builtin_amdgcn_permlane32_swap(__float_as_uint(pmax), __float_as_uint(pmax), false, false);
    pmax = fmaxf(__uint_as_float(rr[0]), __uint_as_float(rr[1])); }
  if (__builtin_expect(__all(pmax - m_reg <= THR / SCALE), 1)) { mn = m_reg; alpha = 1.f; }
  else { mn = fmaxf(m_reg, pmax); alpha = __builtin_amdgcn_exp2f((m_reg - mn) * C); m_reg = mn; }
  float mnC = -mn * C;
#pragma unroll
  for (int r = 0; r < 16; ++r) p0[r] = fmaf(p0[r], C, mnC);
#pragma unroll
  for (int r = 0; r < 16; ++r) p1[r] = fmaf(p1[r], C, mnC);
#pragma unroll
  for (int r = 0; r < 16; ++r) p0[r] = __builtin_amdgcn_exp2f(p0[r]);
}
__device__ __forceinline__ void finishSM(f32x16& p0, f32x16& p1, float alpha, float& l_reg, bf16x8& pa0, bf16x8& pa1, bf16x8& pa2, bf16x8& pa3) {
#pragma unroll
  for (int r = 0; r < 16; ++r) p1[r] = __builtin_amdgcn_exp2f(p1[r]);
  float ps = 0;
#pragma unroll
  for (int r = 0; r < 16; ++r) ps += p0[r];
#pragma unroll
  for (int r = 0; r < 16; ++r) ps += p1[r];
  { auto rr = __builtin_amdgcn_permlane32_swap(__float_as_uint(ps), __float_as_uint(ps), false, false);
    ps = __uint_as_float(rr[0]) + __uint_as_float(rr[1]); }
  l_reg = l_reg * alpha + ps;
#define PK4(P, BASE, OUT) do { unsigned a0 = cvtpk(P[BASE + 0], P[BASE + 1]), a1 = cvtpk(P[BASE + 2], P[BASE + 3]);   \
    unsigned b0 = cvtpk(P[BASE + 4], P[BASE + 5]), b1 = cvtpk(P[BASE + 6], P[BASE + 7]);                              \
    auto r0 = __builtin_amdgcn_permlane32_swap(a0, b0, false, false); auto r1 = __builtin_amdgcn_permlane32_swap(a1, b1, false, false); \
    u32x4 w = {r0[0], r1[0], r0[1], r1[1]}; OUT = *reinterpret_cast<bf16x8*>(&w); } while (0)
  PK4(p0, 0, pa0); PK4(p0, 8, pa1); PK4(p1, 0, pa2); PK4(p1, 8, pa3);
#undef PK4
}
__device__ __forceinline__ void qkt(f32x16& p0, f32x16& p1, const ATT_LAS char* Ks, const bf16x8* qr, int r32, int hi) {
  p0 = f32x16{}; p1 = f32x16{};
#pragma unroll
  for (int d0 = 0; d0 < 8; ++d0) { int cb = (d0 * 16 + hi * 8) * 2;
    bf16x8 b0 = *reinterpret_cast<const ATT_LAS bf16x8*>(Ks + KSWZ(r32, cb));
    bf16x8 b1 = *reinterpret_cast<const ATT_LAS bf16x8*>(Ks + KSWZ(32 + r32, cb));
    p0 = __builtin_amdgcn_mfma_f32_32x32x16_bf16(b0, qr[d0], p0, 0, 0, 0);
    p1 = __builtin_amdgcn_mfma_f32_32x32x16_bf16(b1, qr[d0], p1, 0, 0, 0); }
}
__device__ __forceinline__ int v_st(int k, int c) { const int kk = (k & ~0xC) | ((k & 4) << 1) | ((k & 8) >> 1); return ((kk >> 3) * 4 + (c >> 5)) * 512 + ((kk & 7) * 32 + (c & 31)) * 2; }
__device__ __forceinline__ int v_rd_base(int lane) { return ((lane & 3) << 3) | (((lane >> 2) & 3) << 6) | (((lane >> 4) & 1) << 5) | (((lane >> 5) & 1) << 8); }
constexpr int v_rd_off(int d0, int ks, int half) { return d0 * 512 + ks * 4096 + half * 2048; }
template <int OFF> __device__ __forceinline__ s16x4 tr_read(int vb) {
  s16x4 r; asm volatile("ds_read_b64_tr_b16 %0, %1 offset:%2" : "=&v"(r) : "v"(vb), "i"(OFF) : "memory"); return r;
}
template <int D0> __device__ __forceinline__ void pv_one(f32x16& od, int vb, bf16x8 pa0, bf16x8 pa1, bf16x8 pa2, bf16x8 pa3) {
  const s16x4 l0 = tr_read<v_rd_off(D0, 0, 0)>(vb), h0 = tr_read<v_rd_off(D0, 0, 1)>(vb), l1 = tr_read<v_rd_off(D0, 1, 0)>(vb), h1 = tr_read<v_rd_off(D0, 1, 1)>(vb);
  const s16x4 l2 = tr_read<v_rd_off(D0, 2, 0)>(vb), h2 = tr_read<v_rd_off(D0, 2, 1)>(vb), l3 = tr_read<v_rd_off(D0, 3, 0)>(vb), h3 = tr_read<v_rd_off(D0, 3, 1)>(vb);
  asm volatile("s_waitcnt lgkmcnt(0)" ::: "memory"); SBAR();
#define PK(L, H) (bf16x8){L[0], L[1], L[2], L[3], H[0], H[1], H[2], H[3]}
  od = __builtin_amdgcn_mfma_f32_32x32x16_bf16(pa0, PK(l0, h0), od, 0, 0, 0);
  od = __builtin_amdgcn_mfma_f32_32x32x16_bf16(pa1, PK(l1, h1), od, 0, 0, 0);
  od = __builtin_amdgcn_mfma_f32_32x32x16_bf16(pa2, PK(l2, h2), od, 0, 0, 0);
  od = __builtin_amdgcn_mfma_f32_32x32x16_bf16(pa3, PK(l3, h3), od, 0, 0, 0);
#undef PK
}
__device__ __forceinline__ void pv_d0(f32x16* o, int vb, bf16x8 pa0, bf16x8 pa1, bf16x8 pa2, bf16x8 pa3) {
  pv_one<0>(o[0], vb, pa0, pa1, pa2, pa3); pv_one<1>(o[1], vb, pa0, pa1, pa2, pa3); pv_one<2>(o[2], vb, pa0, pa1, pa2, pa3); pv_one<3>(o[3], vb, pa0, pa1, pa2, pa3);
}
template <bool IS_NA> __device__ __forceinline__ void mask_tile(f32x16& p0, f32x16& p1, int j, const NaCtx& na, int hi) {
  if constexpr (IS_NA) {
    const int kr = na.kr_first + (j - 1);
    if ((unsigned)(kr - na.r0) >= 8u) {
#pragma unroll
      for (int r = 0; r < 16; ++r) { p0[r] = NEG; p1[r] = NEG; }
    } else {
      const ATT_LAS float* rb = na.rpb + (kr - na.qrow + 7) * 31 + 15 - na.c + 4 * hi;
      const int dbase = 4 * hi - na.c0;
#pragma unroll
      for (int r = 0; r < 16; ++r) { const int kc = (r & 3) + 8 * (r >> 2);
        const float b0 = rb[kc], b1 = rb[kc + 32];
        p0[r] = ((unsigned)(kc + dbase) < 16u) ? p0[r] + b0 : NEG;
        p1[r] = ((unsigned)(kc + 32 + dbase) < 16u) ? p1[r] + b1 : NEG; }
    }
  }
}

typedef __amdgpu_buffer_rsrc_t rsrc_t;
__device__ __forceinline__ bf16x8 bld(rsrc_t rs, unsigned voff, unsigned soff) { auto v = __builtin_amdgcn_raw_buffer_load_b128(rs, (int)voff, (int)soff, 0); return __builtin_bit_cast(bf16x8, v); }
template <bool IS_NA>
__device__ __forceinline__ void attn_run(const rsrc_t rs, const unsigned qoffB  , const unsigned kcolB, const unsigned vcolB  ,
                                         const int krow1, const int NT, ATT_LAS char* lds, const NaCtx na, f32x16 (&o)[4], const int wid  ) {
  const int lane = lane_of(), tid = wid * 64 + lane, r32 = lane & 31, hi = lane >> 5;
  ATT_LAS char* V_lds = lds; ATT_LAS char* K_lds = lds + 2 * SHM_V;
  ATT_LAS float* wsf = (ATT_LAS float*)(lds + 2 * SHM_V + 2 * SHM_K) + wid * 64; ATT_LAS float* li_l = wsf; ATT_LAS float* al_l = wsf + 32;
  float m_reg = NEG, l_reg = 0; bf16x8 qr[8];
#pragma unroll
  for (int d = 0; d < 4; ++d) o[d] = f32x16{};
  { const unsigned qv = (unsigned)((wid * QBLK + r32) * LD + hi * 8) * 2u;
#pragma unroll
    for (int d0 = 0; d0 < 8; ++d0) qr[d0] = bld(rs, qv + d0 * 32, qoffB); }
  const int sr = tid >> 4, sc = (tid & 15) * 8, vst0 = v_st(sr, sc), vst1 = v_st(32 + sr, sc);
  const int vb0 = (int)(unsigned)(uintptr_t)V_lds + v_rd_base(lane);
  struct { bf16x8 vs0, vs1, ks0, ks1; } sr_[2];
#define TROW(j) ((j) == 0 ? META_ROW : krow1 + ((j) - 1) * KVBLK)
  const unsigned stv = (unsigned)(sr * LD + sc) * 2u;
#define SLOAD(i, j) do { const unsigned t0_ = (unsigned)TROW(j) * (unsigned)(LD * 2); sr_[i].vs0 = bld(rs, stv, t0_ + vcolB); sr_[i].vs1 = bld(rs, stv, t0_ + vcolB + 32u * LD * 2u); \
    sr_[i].ks0 = bld(rs, stv, t0_ + kcolB); sr_[i].ks1 = bld(rs, stv, t0_ + kcolB + 32u * LD * 2u); } while (0)
#define SWRITE(b, i) do { *(ATT_LAS bf16x8*)(V_lds + (b) * SHM_V + vst0) = sr_[i].vs0;          \
    *(ATT_LAS bf16x8*)(V_lds + (b) * SHM_V + vst1) = sr_[i].vs1; const int kc_ = sc * 2;               \
    *(ATT_LAS bf16x8*)(K_lds + (b) * SHM_K + KSWZ(sr, kc_)) = sr_[i].ks0;                       \
    *(ATT_LAS bf16x8*)(K_lds + (b) * SHM_K + KSWZ(32 + sr, kc_)) = sr_[i].ks1; } while (0)
#define SWAIT() asm volatile("s_waitcnt vmcnt(4)" ::: "memory")
#define RESC(a) do { if (__any((a) < 1.f)) { if (hi == 0) al_l[r32] = (a); asm volatile("s_waitcnt lgkmcnt(0)" ::: "memory"); \
    _Pragma("unroll") for (int d = 0; d < 4; ++d) _Pragma("unroll") for (int r = 0; r < 16; ++r) o[d][r] *= al_l[crow(r, hi)]; } } while (0)
  f32x16 pA0, pA1, pB0, pB1; float mnA, mnB, alA, alB; bf16x8 pa0, pa1, pa2, pa3;
  constexpr int SE = 0, SO = 1;
  __syncthreads();
  SLOAD(SE, 0); asm volatile("s_waitcnt vmcnt(0)" ::: "memory"); SWRITE(0, SE); __syncthreads();
  qkt(pA0, pA1, K_lds, qr, r32, hi);
#pragma unroll
  for (int r = 8; r < 16; ++r) pA0[r] = NEG;
#pragma unroll
  for (int r = 0; r < 16; ++r) pA1[r] = NEG;
  partialSM(pA0, pA1, m_reg, mnA, alA);
  SLOAD(SO, 1); if (2 < NT) SLOAD(SE, 2);
  SWAIT(); SWRITE(1, SO); __syncthreads();
  for (int j = 1; j + 2 < NT; j += 2) {
    SBAR(); qkt(pB0, pB1, K_lds + SHM_K, qr, r32, hi);
    finishSM(pA0, pA1, alA, l_reg, pa0, pa1, pa2, pa3); SBAR();
    if (j + 2 < NT) SLOAD(SO, j + 2); SBAR();
    pv_d0(o, vb0, pa0, pa1, pa2, pa3); mask_tile<IS_NA>(pB0, pB1, j, na, hi); partialSM(pB0, pB1, m_reg, mnB, alB);
    __syncthreads(); SWAIT(); SWRITE(0, SE);
    RESC(alB); __syncthreads();
    SBAR(); qkt(pA0, pA1, K_lds, qr, r32, hi);
    finishSM(pB0, pB1, alB, l_reg, pa0, pa1, pa2, pa3); SBAR();
    if (j + 3 < NT) SLOAD(SE, j + 3); SBAR();
    pv_d0(o, vb0 + SHM_V, pa0, pa1, pa2, pa3); mask_tile<IS_NA>(pA0, pA1, j + 1, na, hi); partialSM(pA0, pA1, m_reg, mnA, alA);
    __syncthreads(); SWAIT(); if (j + 2 < NT) SWRITE(1, SO);
    RESC(alA); __syncthreads();
  }
  SBAR(); qkt(pB0, pB1, K_lds + SHM_K, qr, r32, hi);
  finishSM(pA0, pA1, alA, l_reg, pa0, pa1, pa2, pa3); SBAR();
  pv_d0(o, vb0, pa0, pa1, pa2, pa3); mask_tile<IS_NA>(pB0, pB1, NT - 1, na, hi); partialSM(pB0, pB1, m_reg, mnB, alB);
  RESC(alB);
  finishSM(pB0, pB1, alB, l_reg, pa0, pa1, pa2, pa3); SBAR();
  pv_d0(o, vb0 + SHM_V, pa0, pa1, pa2, pa3);
  if (hi == 0) li_l[r32] = l_reg; asm volatile("s_waitcnt lgkmcnt(0)" ::: "memory");
#pragma unroll
  for (int r = 0; r < 16; ++r) { const float rl = __builtin_amdgcn_rcpf(li_l[crow(r, hi)]);
#pragma unroll
    for (int d = 0; d < 4; ++d) o[d][r] *= rl; }
#undef TROW
#undef SLOAD
#undef SWRITE
#undef SWAIT
#undef RESC
}
__device__ __forceinline__ float half_sum(float v) {
#pragma unroll
  for (int o = 1; o < 32; o <<= 1) v += __shfl_xor(v, o);
  return v;
}
}


namespace att2 {
using namespace att;
constexpr int KB = 16384, VB = 32768;
constexpr int L_K = 0, L_V = 2 * KB, L_WS = 2 * KB + 2 * VB, SHM2 = L_WS + NW * 64 * 4;
__device__ __forceinline__ void dma16(const rsrc_t rs, ATT_LAS char* dst, unsigned voff, unsigned soff) { __builtin_amdgcn_raw_ptr_buffer_load_lds(rs, (ATT_LAS void*)dst, 16, (int)voff, (int)soff, 0, 0); }
#define WAITBAR(N) asm volatile("s_waitcnt vmcnt(" #N ") lgkmcnt(0)\n\ts_barrier" ::: "memory")
template <int D0, int VH> __device__ __forceinline__ void pv_one2(f32x16& od, int vb, bf16x8 pa0, bf16x8 pa1, bf16x8 pa2, bf16x8 pa3) {
  constexpr int B = VH * 16384;
  const s16x4 l0 = tr_read<B + v_rd_off(D0, 0, 0)>(vb), h0 = tr_read<B + v_rd_off(D0, 0, 1)>(vb), l1 = tr_read<B + v_rd_off(D0, 1, 0)>(vb), h1 = tr_read<B + v_rd_off(D0, 1, 1)>(vb);
  const s16x4 l2 = tr_read<B + v_rd_off(D0, 2, 0)>(vb), h2 = tr_read<B + v_rd_off(D0, 2, 1)>(vb), l3 = tr_read<B + v_rd_off(D0, 3, 0)>(vb), h3 = tr_read<B + v_rd_off(D0, 3, 1)>(vb);
  asm volatile("s_waitcnt lgkmcnt(0)" ::: "memory"); SBAR();
#define PK(L, H) (bf16x8){L[0], L[1], L[2], L[3], H[0], H[1], H[2], H[3]}
  od = __builtin_amdgcn_mfma_f32_32x32x16_bf16(pa0, PK(l0, h0), od, 0, 0, 0);
  od = __builtin_amdgcn_mfma_f32_32x32x16_bf16(pa1, PK(l1, h1), od, 0, 0, 0);
  od = __builtin_amdgcn_mfma_f32_32x32x16_bf16(pa2, PK(l2, h2), od, 0, 0, 0);
  od = __builtin_amdgcn_mfma_f32_32x32x16_bf16(pa3, PK(l3, h3), od, 0, 0, 0);
#undef PK
}
__device__ __forceinline__ void pv8(f32x16* o, int vb, bf16x8 pa0, bf16x8 pa1, bf16x8 pa2, bf16x8 pa3) {
  pv_one2<0, 0>(o[0], vb, pa0, pa1, pa2, pa3); pv_one2<1, 0>(o[1], vb, pa0, pa1, pa2, pa3); pv_one2<2, 0>(o[2], vb, pa0, pa1, pa2, pa3); pv_one2<3, 0>(o[3], vb, pa0, pa1, pa2, pa3);
  pv_one2<0, 1>(o[4], vb, pa0, pa1, pa2, pa3); pv_one2<1, 1>(o[5], vb, pa0, pa1, pa2, pa3); pv_one2<2, 1>(o[6], vb, pa0, pa1, pa2, pa3); pv_one2<3, 1>(o[7], vb, pa0, pa1, pa2, pa3);
}
template <int BASE> __device__ __forceinline__ bf16x8 pk4t(const f32x16& P) {
  unsigned a0 = cvtpk(P[BASE + 0], P[BASE + 1]), a1 = cvtpk(P[BASE + 2], P[BASE + 3]), b0 = cvtpk(P[BASE + 4], P[BASE + 5]), b1 = cvtpk(P[BASE + 6], P[BASE + 7]);
  auto r0 = __builtin_amdgcn_permlane32_swap(a0, b0, false, false); auto r1 = __builtin_amdgcn_permlane32_swap(a1, b1, false, false);
  u32x4 w = {r0[0], r1[0], r0[1], r1[1]}; return *reinterpret_cast<bf16x8*>(&w);
}
#define TRV(D, KS, HF) tr_read<((D) >> 2) * 16384 + v_rd_off((D) & 3, KS, HF)>(vb)
#define PKF(L, H) (bf16x8){L[0], L[1], L[2], L[3], H[0], H[1], H[2], H[3]}
#define RD2(S, KS, D) do { S##l0 = TRV((D), KS, 0); S##h0 = TRV((D), KS, 1); S##l1 = TRV((D) + 1, KS, 0); S##h1 = TRV((D) + 1, KS, 1); } while (0)
#define GAPV(OD, PA, L, H, STMT) do { OD = __builtin_amdgcn_mfma_f32_32x32x16_bf16(PA, PKF(L, H), OD, 0, 0, 0); STMT SBAR(); } while (0)
__device__ __forceinline__ void pv8_softmax(f32x16* o, const int vb, bf16x8& pa0, bf16x8& pa1, bf16x8& pa2, const bf16x8 pa3, f32x16& p0, f32x16& p1, float& m_reg, float& al, float& ps) {
  constexpr float CSM = SCALE * 1.4426950408889634f;
  s16x4 Al0, Ah0, Al1, Ah1, Bl0, Bh0, Bl1, Bh1; float pm, mn, mnC;
  RD2(A, 0, 0); SBAR();
  asm volatile("s_waitcnt lgkmcnt(0)" ::: "memory"); SBAR();
  RD2(B, 0, 2); SBAR();
  GAPV(o[0], pa0, Al0, Ah0, pm = fmaxf(p0[0], p0[1]); pm = fmaxf(pm, p0[2]); pm = fmaxf(pm, p0[3]); pm = fmaxf(pm, p0[4]); pm = fmaxf(pm, p0[5]); asm volatile("" : "+v"(pm)););
  GAPV(o[1], pa0, Al1, Ah1, pm = fmaxf(pm, p0[6]); pm = fmaxf(pm, p0[7]); pm = fmaxf(pm, p0[8]); pm = fmaxf(pm, p0[9]); pm = fmaxf(pm, p0[10]); pm = fmaxf(pm, p0[11]); asm volatile("" : "+v"(pm)););
  asm volatile("s_waitcnt lgkmcnt(0)" ::: "memory"); SBAR();
  RD2(A, 0, 4); SBAR();
  GAPV(o[2], pa0, Bl0, Bh0, pm = fmaxf(pm, p0[12]); pm = fmaxf(pm, p0[13]); pm = fmaxf(pm, p0[14]); pm = fmaxf(pm, p0[15]); pm = fmaxf(pm, p1[0]); pm = fmaxf(pm, p1[1]); asm volatile("" : "+v"(pm)););
  GAPV(o[3], pa0, Bl1, Bh1, pm = fmaxf(pm, p1[2]); pm = fmaxf(pm, p1[3]); pm = fmaxf(pm, p1[4]); pm = fmaxf(pm, p1[5]); pm = fmaxf(pm, p1[6]); pm = fmaxf(pm, p1[7]); asm volatile("" : "+v"(pm)););
  asm volatile("s_waitcnt lgkmcnt(0)" ::: "memory"); SBAR();
  RD2(B, 0, 6); SBAR();
  GAPV(o[4], pa0, Al0, Ah0, pm = fmaxf(pm, p1[8]); pm = fmaxf(pm, p1[9]); pm = fmaxf(pm, p1[10]); pm = fmaxf(pm, p1[11]); pm = fmaxf(pm, p1[12]); pm = fmaxf(pm, p1[13]); asm volatile("" : "+v"(pm)););
  GAPV(o[5], pa0, Al1, Ah1, pm = fmaxf(pm, p1[14]); pm = fmaxf(pm, p1[15]); { auto rr_ = __builtin_amdgcn_permlane32_swap(__float_as_uint(pm), __float_as_uint(pm), false, false); pm = fmaxf(__uint_as_float(rr_[0]), __uint_as_float(rr_[1])); } asm volatile("" : "+v"(pm)););
  asm volatile("s_waitcnt lgkmcnt(0)" ::: "memory"); SBAR();
  RD2(A, 1, 0); SBAR();
  GAPV(o[6], pa0, Bl0, Bh0, if (__builtin_expect(__all(pm - m_reg <= THR / SCALE), 1)) { mn = m_reg; al = 1.f; } else { mn = fmaxf(m_reg, pm); al = __builtin_amdgcn_exp2f((m_reg - mn) * CSM); m_reg = mn; } mnC = -mn * CSM; asm volatile("" : "+v"(mnC)); asm volatile("" : "+v"(al)););
  GAPV(o[7], pa0, Bl1, Bh1, p0[0] = fmaf(p0[0], CSM, mnC); p0[1] = fmaf(p0[1], CSM, mnC); p0[2] = fmaf(p0[2], CSM, mnC); p0[3] = fmaf(p0[3], CSM, mnC); p0[4] = fmaf(p0[4], CSM, mnC); p0[5] = fmaf(p0[5], CSM, mnC); asm volatile("" : "+v"(p0)););
  asm volatile("s_waitcnt lgkmcnt(0)" ::: "memory"); SBAR();
  RD2(B, 1, 2); SBAR();
  GAPV(o[0], pa1, Al0, Ah0, p0[6] = fmaf(p0[6], CSM, mnC); p0[7] = fmaf(p0[7], CSM, mnC); p0[8] = fmaf(p0[8], CSM, mnC); p0[9] = fmaf(p0[9], CSM, mnC); p0[10] = fmaf(p0[10], CSM, mnC); p0[11] = fmaf(p0[11], CSM, mnC); asm volatile("" : "+v"(p0)););
  GAPV(o[1], pa1, Al1, Ah1, p0[12] = fmaf(p0[12], CSM, mnC); p0[13] = fmaf(p0[13], CSM, mnC); p0[14] = fmaf(p0[14], CSM, mnC); p0[15] = fmaf(p0[15], CSM, mnC); p1[0] = fmaf(p1[0], CSM, mnC); p1[1] = fmaf(p1[1], CSM, mnC); asm volatile("" : "+v"(p0)); asm volatile("" : "+v"(p1)););
  asm volatile("s_waitcnt lgkmcnt(0)" ::: "memory"); SBAR();
  RD2(A, 1, 4); SBAR();
  GAPV(o[2], pa1, Bl0, Bh0, p1[2] = fmaf(p1[2], CSM, mnC); p1[3] = fmaf(p1[3], CSM, mnC); p1[4] = fmaf(p1[4], CSM, mnC); p1[5] = fmaf(p1[5], CSM, mnC); p1[6] = fmaf(p1[6], CSM, mnC); p1[7] = fmaf(p1[7], CSM, mnC); asm volatile("" : "+v"(p1)););
  GAPV(o[3], pa1, Bl1, Bh1, p1[8] = fmaf(p1[8], CSM, mnC); p1[9] = fmaf(p1[9], CSM, mnC); p1[10] = fmaf(p1[10], CSM, mnC); p1[11] = fmaf(p1[11], CSM, mnC); p1[12] = fmaf(p1[12], CSM, mnC); p1[13] = fmaf(p1[13], CSM, mnC); asm volatile("" : "+v"(p1)););
  asm volatile("s_waitcnt lgkmcnt(0)" ::: "memory"); SBAR();
  RD2(B, 1, 6); SBAR();
  GAPV(o[4], pa1, Al0, Ah0, p1[14] = fmaf(p1[14], CSM, mnC); p1[15] = fmaf(p1[15], CSM, mnC); asm volatile("" : "+v"(p1)););
  GAPV(o[5], pa1, Al1, Ah1, p0[0] = __builtin_amdgcn_exp2f(p0[0]); p0[1] = __builtin_amdgcn_exp2f(p0[1]); p0[2] = __builtin_amdgcn_exp2f(p0[2]); asm volatile("" : "+v"(p0)););
  asm volatile("s_waitcnt lgkmcnt(0)" ::: "memory"); SBAR();
  RD2(A, 2, 0); SBAR();
  GAPV(o[6], pa1, Bl0, Bh0, p0[3] = __builtin_amdgcn_exp2f(p0[3]); p0[4] = __builtin_amdgcn_exp2f(p0[4]); p0[5] = __builtin_amdgcn_exp2f(p0[5]); asm volatile("" : "+v"(p0)););
  GAPV(o[7], pa1, Bl1, Bh1, p0[6] = __builtin_amdgcn_exp2f(p0[6]); p0[7] = __builtin_amdgcn_exp2f(p0[7]); p0[8] = __builtin_amdgcn_exp2f(p0[8]); asm volatile("" : "+v"(p0)););
  asm volatile("s_waitcnt lgkmcnt(0)" ::: "memory"); SBAR();
  RD2(B, 2, 2); SBAR();
  GAPV(o[0], pa2, Al0, Ah0, p0[9] = __builtin_amdgcn_exp2f(p0[9]); p0[10] = __builtin_amdgcn_exp2f(p0[10]); p0[11] = __builtin_amdgcn_exp2f(p0[11]); asm volatile("" : "+v"(p0)););
  GAPV(o[1], pa2, Al1, Ah1, p0[12] = __builtin_amdgcn_exp2f(p0[12]); p0[13] = __builtin_amdgcn_exp2f(p0[13]); p0[14] = __builtin_amdgcn_exp2f(p0[14]); asm volatile("" : "+v"(p0)););
  asm volatile("s_waitcnt lgkmcnt(0)" ::: "memory"); SBAR();
  RD2(A, 2, 4); SBAR();
  GAPV(o[2], pa2, Bl0, Bh0, p0[15] = __builtin_amdgcn_exp2f(p0[15]); p1[0] = __builtin_amdgcn_exp2f(p1[0]); p1[1] = __builtin_amdgcn_exp2f(p1[1]); asm volatile("" : "+v"(p0)); asm volatile("" : "+v"(p1)););
  GAPV(o[3], pa2, Bl1, Bh1, p1[2] = __builtin_amdgcn_exp2f(p1[2]); p1[3] = __builtin_amdgcn_exp2f(p1[3]); p1[4] = __builtin_amdgcn_exp2f(p1[4]); asm volatile("" : "+v"(p1)););
  asm volatile("s_waitcnt lgkmcnt(0)" ::: "memory"); SBAR();
  RD2(B, 2, 6); SBAR();
  GAPV(o[4], pa2, Al0, Ah0, p1[5] = __builtin_amdgcn_exp2f(p1[5]); p1[6] = __builtin_amdgcn_exp2f(p1[6]); p1[7] = __builtin_amdgcn_exp2f(p1[7]); asm volatile("" : "+v"(p1)););
  GAPV(o[5], pa2, Al1, Ah1, p1[8] = __builtin_amdgcn_exp2f(p1[8]); p1[9] = __builtin_amdgcn_exp2f(p1[9]); p1[10] = __builtin_amdgcn_exp2f(p1[10]); asm volatile("" : "+v"(p1)););
  asm volatile("s_waitcnt lgkmcnt(0)" ::: "memory"); SBAR();
  RD2(A, 3, 0); SBAR();
  GAPV(o[6], pa2, Bl0, Bh0, p1[11] = __builtin_amdgcn_exp2f(p1[11]); p1[12] = __builtin_amdgcn_exp2f(p1[12]); p1[13] = __builtin_amdgcn_exp2f(p1[13]); asm volatile("" : "+v"(p1)););
  GAPV(o[7], pa2, Bl1, Bh1, p1[14] = __builtin_amdgcn_exp2f(p1[14]); p1[15] = __builtin_amdgcn_exp2f(p1[15]); asm volatile("" : "+v"(p1)););
  asm volatile("s_waitcnt lgkmcnt(0)" ::: "memory"); SBAR();
  RD2(B, 3, 2); SBAR();
  GAPV(o[0], pa3, Al0, Ah0, ps = p0[0] + p0[1]; ps += p0[2]; ps += p0[3]; ps += p0[4]; ps += p0[5]; ps += p0[6]; ps += p0[7]; asm volatile("" : "+v"(ps)););
  GAPV(o[1], pa3, Al1, Ah1, ps += p0[8]; ps += p0[9]; ps += p0[10]; ps += p0[11]; ps += p0[12]; ps += p0[13]; ps += p0[14]; ps += p0[15]; asm volatile("" : "+v"(ps)););
  asm volatile("s_waitcnt lgkmcnt(0)" ::: "memory"); SBAR();
  RD2(A, 3, 4); SBAR();
  GAPV(o[2], pa3, Bl0, Bh0, ps += p1[0]; ps += p1[1]; ps += p1[2]; ps += p1[3]; ps += p1[4]; ps += p1[5]; ps += p1[6]; ps += p1[7]; asm volatile("" : "+v"(ps)););
  GAPV(o[3], pa3, Bl1, Bh1, ps += p1[8]; ps += p1[9]; ps += p1[10]; ps += p1[11]; ps += p1[12]; ps += p1[13]; ps += p1[14]; ps += p1[15]; asm volatile("" : "+v"(ps)););
  asm volatile("s_waitcnt lgkmcnt(0)" ::: "memory"); SBAR();
  RD2(B, 3, 6); SBAR();
  GAPV(o[4], pa3, Al0, Ah0, pa0 = pk4t<0>(p0); asm volatile("" : "+v"(pa0)););
  GAPV(o[5], pa3, Al1, Ah1, pa1 = pk4t<8>(p0); asm volatile("" : "+v"(pa1)););
  asm volatile("s_waitcnt lgkmcnt(0)" ::: "memory"); SBAR();
  GAPV(o[6], pa3, Bl0, Bh0, pa2 = pk4t<0>(p1); asm volatile("" : "+v"(pa2)););
  GAPV(o[7], pa3, Bl1, Bh1, );
}
#undef TRV
#undef RD2
#undef GAPV
#undef PKF
__device__ __forceinline__ void finish_tail(const f32x16& p1, float ps, float alpha, float& l_reg, bf16x8& pa3) {
  { auto rr = __builtin_amdgcn_permlane32_swap(__float_as_uint(ps), __float_as_uint(ps), false, false); ps = __uint_as_float(rr[0]) + __uint_as_float(rr[1]); }
  l_reg = l_reg * alpha + ps;
  pa3 = pk4t<8>(p1);
}
__device__ __forceinline__ void diff_run(const rsrc_t rs, const unsigned qoffB, const unsigned kcolB, const unsigned vcolB  ,
                                         const int krow1, const int NT, ATT_LAS char* lds, f32x16 (&o)[8], float (&rli)[16], const int wid  ) {
  int lane = lane_of(); asm volatile("" : "+v"(lane));
  const int tid = wid * 64 + lane, r32 = lane & 31, hi = lane >> 5;
  ATT_LAS float* wsf = (ATT_LAS float*)(lds + L_WS) + wid * 64; ATT_LAS float* li_l = wsf; ATT_LAS float* al_l = wsf + 32;
  float m_reg = NEG, l_reg = 0; bf16x8 qr[8];
#pragma unroll
  for (int d = 0; d < 8; ++d) o[d] = f32x16{};
  { const unsigned qv = (unsigned)((wid * QBLK + r32) * LD + hi * 8) * 2u;
#pragma unroll
    for (int d0 = 0; d0 < 8; ++d0) qr[d0] = bld(rs, qv + d0 * 32, qoffB); }
  const unsigned kvo = (unsigned)((tid >> 4) * LD * 2 + (((tid & 15) ^ ((tid >> 4) & 7)) << 4));
  const int kkb = (tid >> 7) * 8 + ((tid & 31) >> 2), kbr = (kkb & ~0xC) | ((kkb & 4) << 1) | ((kkb & 8) >> 1);
  const unsigned vvo = (unsigned)(kbr * LD * 2 + ((((tid >> 5) & 3) * 32 + (tid & 3) * 8) << 1));
  ATT_LAS char* kd = lds + L_K + wid * 1024; ATT_LAS char* vd = lds + L_V + wid * 1024;
  constexpr unsigned R32 = 32u * LD * 2u;
#define TROW(j) ((j) == 0 ? META_ROW : krow1 + ((j) - 1) * KVBLK)
#define DMA_K(j, b) do { const unsigned t0_ = (unsigned)TROW(j) * (unsigned)(LD * 2) + kcolB; dma16(rs, kd + (b) * KB, kvo, t0_); dma16(rs, kd + (b) * KB + 8192, kvo, t0_ + R32); } while (0)
#define DMA_V(j, b) do { const unsigned t0_ = (unsigned)TROW(j) * (unsigned)(LD * 2) + vcolB; dma16(rs, vd + (b) * VB, vvo, t0_); dma16(rs, vd + (b) * VB + 8192, vvo, t0_ + R32); \
    dma16(rs, vd + (b) * VB + 16384, vvo, t0_ + 256u); dma16(rs, vd + (b) * VB + 24576, vvo, t0_ + R32 + 256u); } while (0)
#define RESC(a) do { if (__any((a) < 1.f)) { if (hi == 0) al_l[r32] = (a); asm volatile("s_waitcnt lgkmcnt(0)" ::: "memory"); \
    _Pragma("unroll") for (int d = 0; d < 8; ++d) _Pragma("unroll") for (int r = 0; r < 16; ++r) o[d][r] *= al_l[crow(r, hi)]; } } while (0)
  const int vb0 = (int)(unsigned)(uintptr_t)(lds + L_V) + v_rd_base(lane);
  f32x16 p0, p1; float mn, al; bf16x8 pa0, pa1, pa2, pa3;
  asm volatile("s_waitcnt vmcnt(0) lgkmcnt(0)" ::: "memory"); __builtin_amdgcn_s_barrier();
  DMA_K(0, 0); DMA_K(1, 1); DMA_V(0, 0);
  WAITBAR(6);
  {
    SBAR(); qkt(p0, p1, lds + L_K, qr, r32, hi);
#pragma unroll
    for (int r = 8; r < 16; ++r) p0[r] = NEG;
#pragma unroll
    for (int r = 0; r < 16; ++r) p1[r] = NEG;
    WAITBAR(6);
    { const int jn = 2 < NT ? 2 : NT - 1; DMA_K(jn, 0); }
    partialSM(p0, p1, m_reg, mn, al); finishSM(p0, p1, al, l_reg, pa0, pa1, pa2, pa3);
    WAITBAR(6);
    { const int jn = 1 < NT ? 1 : NT - 1; DMA_V(jn, 1); }
  }
  for (int j = 1; j < NT; ++j) {
    const int jb = j & 1;
    int r32o = r32; asm volatile("" : "+v"(r32o));
    SBAR(); qkt(p0, p1, lds + L_K + jb * KB, qr, r32o, hi);
    WAITBAR(6);
    { const int jn = j + 2 < NT ? j + 2 : NT - 1; DMA_K(jn, jb); }
    float ps; pv8_softmax(o, vb0 + (jb ^ 1) * VB, pa0, pa1, pa2, pa3, p0, p1, m_reg, al, ps);
    RESC(al);
    finish_tail(p1, ps, al, l_reg, pa3);
    WAITBAR(6);
    { const int jn = j + 1 < NT ? j + 1 : NT - 1; DMA_V(jn, jb ^ 1); }
  }
  WAITBAR(0);
  pv8(o, vb0 + ((NT - 1) & 1) * VB, pa0, pa1, pa2, pa3);
  if (hi == 0) li_l[r32] = l_reg; asm volatile("s_waitcnt lgkmcnt(0)" ::: "memory");
#pragma unroll
  for (int r = 0; r < 16; ++r) rli[r] = __builtin_amdgcn_rcpf(li_l[crow(r, hi)]);
#undef TROW
#undef DMA_K
#undef DMA_V
#undef RESC
}
#undef WAITBAR
}


#ifndef PROBE_FOLD
#define PROBE_FOLD 0
#endif
#ifndef MK_N_LAUNCHES
#define MK_N_LAUNCHES 1
#endif
constexpr int NWAVES = 8;
constexpr int N_PHASES = 12;
constexpr int N_LAUNCHES = MK_N_LAUNCHES;

constexpr int DM = 4096, DFF = 11008, NMETA = 16;
constexpr int S_P = 8192, S_S = 4096, NB_S = 4;
constexpr int NTOK = S_P + NB_S * S_S;
constexpr int MP = NTOK + 256;
constexpr int NA_W = 2048, DF_W = 2048, IN_W = 12288;
constexpr int C_QNA = 0, C_KNA = 2048, C_VNA = 4096, C_QD = 6144, C_KD = 8192, C_VD = 10240;
constexpr float EPS = 1e-6f, SUBLN_EPS = 1e-5f, LAM_INIT = 0.2f;

constexpr size_t MiB = 1u << 20;
constexpr size_t WS_CTL = 0, CTL_ZERO_BYTES = 1 * MiB;
constexpr size_t SZ_WA = (size_t)2 * DFF * DM * 2, SZ_WD = (size_t)DM * DFF * 2, SZ_WIN = (size_t)IN_W * DM * 2, SZ_WOUT = (size_t)DM * DM * 2;
constexpr size_t WS_WA = 1 * MiB, WS_WD = WS_WA + SZ_WA, WS_WIN = WS_WD + SZ_WD, WS_WOUT = WS_WIN + SZ_WIN;
constexpr size_t WS_HMETA = WS_WOUT + SZ_WOUT;
constexpr size_t WS_RSTD = WS_HMETA + (size_t)NMETA * DM * 4;
constexpr size_t WS_SSQP = WS_RSTD + (size_t)MP * 4 + 3072;
constexpr size_t WS_HN = WS_SSQP + (size_t)NTOK * 64 * 4;
constexpr size_t WS_HB = WS_HN + (size_t)MP * DM * 2;
constexpr size_t WS_BIG = WS_HB + (size_t)MP * DM * 2;
constexpr size_t WS_SCR = WS_BIG + (size_t)MP * IN_W * 2;
constexpr size_t WS_END = WS_SCR + (size_t)256 * 2 * 64 * 512 * 4;
static_assert(WS_SSQP % 256 == 0 && WS_HN % 256 == 0, "alignment");
constexpr size_t WS_H3 = WS_HN;
constexpr int CW_BAR = 4096;

constexpr int RING_OFF = 0, RING_BYTES = 131072;
constexpr int ATT_RPB_OFF = 69632, ATT_SSQ_OFF = ATT_RPB_OFF + 2048;
constexpr int TR_BYTES = 64 * 65 * 4;
constexpr int LDSCTL_OFF = 143360, MISC_OFF = LDSCTL_OFF + 320;
constexpr int LDS_BYTES = 147456;
static_assert(att2::SHM2 <= RING_BYTES && NWAVES * TR_BYTES <= LDSCTL_OFF && att::SHM_ATTN <= ATT_RPB_OFF && ATT_SSQ_OFF + 1024 <= LDSCTL_OFF && MISC_OFF + 128 <= LDS_BYTES, "LDS map");

#define GAS __attribute__((address_space(1)))
#define LAS __attribute__((address_space(3)))
typedef unsigned short bf16;
typedef unsigned v4u __attribute__((ext_vector_type(4)));
typedef float f32x4 __attribute__((ext_vector_type(4)));
typedef short bf16x8 __attribute__((ext_vector_type(8)));
typedef GAS unsigned gu32;
typedef GAS unsigned long long gu64;
#define RLX_AGENT __ATOMIC_RELAXED, __HIP_MEMORY_SCOPE_AGENT
#define LDS_WAIT() asm volatile("s_waitcnt lgkmcnt(0)" ::: "memory")
#define VM_WAIT() asm volatile("s_waitcnt vmcnt(0)" ::: "memory")
__device__ __forceinline__ unsigned long long rt() { return __builtin_amdgcn_s_memrealtime(); }
__device__ __forceinline__ unsigned f2bf(float f) { unsigned u = __builtin_bit_cast(unsigned, f); return (u + 0x7fffu + ((u >> 16) & 1u)) >> 16; }
__device__ __forceinline__ unsigned pk2(float lo, float hi) { return f2bf(lo) | (f2bf(hi) << 16); }

#define XB_TMO      128
#define XB_XCNT(j)  (256  + 64 * (j))
#define XB_XSUB(j)  (1280 + 64 * (j))
#define XB_XGEN(j)  (2304 + 64 * (j))
#define XB_TOP      3328
#define XB_TOPGEN   3392
#define XCD_BAR_WORDS 3456
#define XB_SPIN_CAP (1u << 18)

__device__ __forceinline__ unsigned xb_ld(unsigned* p)              { return __hip_atomic_load(p, __ATOMIC_RELAXED, __HIP_MEMORY_SCOPE_AGENT); }
__device__ __forceinline__ unsigned xb_add(unsigned* p, unsigned v) { return __hip_atomic_fetch_add(p, v, __ATOMIC_RELAXED, __HIP_MEMORY_SCOPE_AGENT); }
__device__ __forceinline__ unsigned xb_xcc_id() { return (unsigned)__builtin_amdgcn_s_getreg((3 << 11) | 20) & 0xFu; }
#define XB_SPIN(cond, bar) do { unsigned _sp = 0; while (cond) { __builtin_amdgcn_s_sleep(1); \
    if ((++_sp & 255u) == 0u) { if (xb_ld(&(bar)[XB_TMO])) break; if (_sp > XB_SPIN_CAP) { atomicAdd(&(bar)[XB_TMO], 1u); break; } } } } while (0)

struct XcdBarrier {
    unsigned* bar; unsigned x;
    volatile LAS unsigned* st;
};

__device__ __forceinline__ XcdBarrier xcd_barrier_post(unsigned* bar, volatile LAS unsigned* st, const int tid_) {
    XcdBarrier b; b.bar = bar; b.x = xb_xcc_id(); b.st = st;
    if (tid_ == 0) (void)xb_add(&bar[XB_XCNT(b.x)], 1u);
    return b;
}
__device__ __forceinline__ void xcd_barrier_complete(unsigned* bar, unsigned x, unsigned& nloc, unsigned& nx) {
    const unsigned G = gridDim.x * gridDim.y * gridDim.z;
    unsigned sum, cnt, mine, sp = 0u;
    for (;;) {
        sum = 0u; cnt = 0u; mine = 0u;
#pragma unroll
        for (unsigned j = 0; j < 16; ++j) { const unsigned c = xb_ld(&bar[XB_XCNT(j)]); sum += c; cnt += (c > 0u) ? 1u : 0u; mine = (j == x) ? c : mine; }
        if (sum == G) break;
        __builtin_amdgcn_s_sleep(1);
        if ((++sp & 255u) == 0u) { if (xb_ld(&bar[XB_TMO])) break; if (sp > XB_SPIN_CAP) { atomicAdd(&bar[XB_TMO], 1u); break; } }
    }
    nloc = mine > 0u ? mine : 1u; nx = cnt > 0u ? cnt : 1u;
}

__device__ __forceinline__ void xcd_barrier(const XcdBarrier& b, const int tid_) {
    asm volatile("s_waitcnt vmcnt(0)" ::: "memory");
    __syncthreads();
    if (tid_ == 0) {
        unsigned* bar = b.bar;
        __builtin_amdgcn_s_waitcnt(0);
        unsigned nloc = b.st[0], nx = b.st[1];
        if (nloc == 0u) { xcd_barrier_complete(bar, b.x, nloc, nx); b.st[0] = nloc; b.st[1] = nx; }
        const unsigned old = xb_add(&bar[XB_XSUB(b.x)], 1u);
        const unsigned gen = old / nloc;
        if (old + 1u == (gen + 1u) * nloc) {
            __builtin_amdgcn_fence(__ATOMIC_RELEASE, "agent");
            asm volatile("s_waitcnt vmcnt(0)" ::: "memory");
            const unsigned og = xb_add(&bar[XB_TOP], 1u);
            const unsigned tg = og / nx;
            if (og + 1u == (tg + 1u) * nx) xb_add(&bar[XB_TOPGEN], 1u);
            else XB_SPIN(xb_ld(&bar[XB_TOPGEN]) == tg, bar);
            __builtin_amdgcn_fence(__ATOMIC_ACQUIRE, "agent");
            xb_add(&bar[XB_XGEN(b.x)], 1u);
            asm volatile("s_waitcnt vmcnt(0)" ::: "memory");
        } else {
            XB_SPIN(xb_ld(&bar[XB_XGEN(b.x)]) == gen, bar);
            __builtin_amdgcn_fence(__ATOMIC_ACQUIRE, "agent");
            asm volatile("s_waitcnt vmcnt(0)" ::: "memory");
        }
    }
    __syncthreads();
}


struct Frame {
    LAS unsigned char* lds;
    volatile LAS unsigned* MISC;
    gu32* ctl;
    int wave;
    __device__ __forceinline__ int lane_now() const { return att::lane_of(); }
    int vcu, G;
};
__device__ __forceinline__ float wave_sum(float v) {
#pragma unroll
    for (int o = 1; o < 64; o <<= 1) v += __shfl_xor(v, o);
    return v;
}
__device__ __forceinline__ unsigned short f2bf_s(float f) { return (unsigned short)f2bf(f); }

__device__ __forceinline__ void transpose_item(const float* __restrict__ W, int K, int N, bf16* __restrict__ WT, int mode, LAS float* scr, int item, int lane, const float* __restrict__ gk = nullptr) {
    const int nblk = N / 64, kb = item / nblk, nb = item - kb * nblk, k0 = 64 * kb, n0 = 64 * nb;
    const int q = lane & 15, kr = lane >> 4;
    f32x4 v[16];
#pragma unroll
    for (int i = 0; i < 16; ++i) v[i] = *(const f32x4*)(W + (size_t)(k0 + 4 * i + kr) * N + n0 + 4 * q);
    if (gk) {
#pragma unroll
        for (int i = 0; i < 16; ++i) v[i] = v[i] * gk[k0 + 4 * i + kr]; }
#pragma unroll
    for (int i = 0; i < 16; ++i) { LAS float* s = scr + (4 * i + kr) * 65 + 4 * q; s[0] = v[i].x; s[1] = v[i].y; s[2] = v[i].z; s[3] = v[i].w; }
    LDS_WAIT(); asm volatile("" ::: "memory");
    const int c = lane & 7;
#pragma unroll
    for (int j = 0; j < 8; ++j) { const int n = 8 * j + (lane >> 3); const LAS float* s = scr + (8 * c) * 65 + n;
        v4u o; o.x = pk2(s[0 * 65], s[1 * 65]); o.y = pk2(s[2 * 65], s[3 * 65]); o.z = pk2(s[4 * 65], s[5 * 65]); o.w = pk2(s[6 * 65], s[7 * 65]);
        const int ng = n0 + n; const int row = mode == 0 ? ng : 256 * (ng >> 7) + 128 * (mode - 1) + (ng & 127);
        *(v4u*)(WT + (size_t)row * K + k0 + 8 * c) = o; }
    LDS_WAIT(); asm volatile("" ::: "memory");
}
template <bool OUT_F32>
__device__ __forceinline__ void rms_row(const float* __restrict__ xrow, const float* __restrict__ g, void* orow, int lane) {
    const f32x4* xr = (const f32x4*)xrow + lane; const f32x4* gr = (const f32x4*)g + lane;
    f32x4 v[16]; float s = 0.f;
#pragma unroll
    for (int j = 0; j < 16; ++j) { v[j] = xr[64 * j]; s += (v[j].x * v[j].x + v[j].y * v[j].y) + (v[j].z * v[j].z + v[j].w * v[j].w); }
    const float rstd = 1.f / sqrtf(wave_sum(s) * (1.f / DM) + EPS);
    if constexpr (OUT_F32) { f32x4* o = (f32x4*)orow + lane;
#pragma unroll
        for (int j = 0; j < 16; ++j) { const f32x4 gg = gr[64 * j]; o[64 * j] = v[j] * rstd * gg; } }
    else { unsigned long long* o8 = (unsigned long long*)orow + lane;
#pragma unroll
        for (int j = 0; j < 16; ++j) { const f32x4 gg = gr[64 * j]; const f32x4 y = v[j] * rstd * gg;
            o8[64 * j] = (unsigned long long)pk2(y.x, y.y) | ((unsigned long long)pk2(y.z, y.w) << 32); } }
}
__device__ __forceinline__ void zero_row_bf16(bf16* orow, int lane) {
    unsigned long long* o8 = (unsigned long long*)orow + lane;
#pragma unroll
    for (int j = 0; j < 16; ++j) o8[64 * j] = 0ull;
}

struct Args { const float* in[22]; float* out; unsigned char* ws; int ph_lo, ph_hi, probe, pad; };
typedef const Args __attribute__((address_space(4)))* ArgsP;
#define ARGS_HERE(name) ArgsP name = (ArgsP)__builtin_amdgcn_kernarg_segment_ptr(); asm volatile("" : "+s"(name))

__device__ __forceinline__ void p_weights(Frame& F, ArgsP a, const int set, const int wrank, const int nwaves) {
    LAS float* scr = (LAS float*)(F.lds + RING_OFF + F.wave * TR_BYTES);
    const int lane = F.lane_now();
    unsigned char* ws = a->ws;
    constexpr int I_G = (DM / 64) * (DFF / 64), I_D = (DFF / 64) * (DM / 64), I_IN = (DM / 64) * (IN_W / 64), I_OUT = (DM / 64) * (DM / 64);
    if (set == 0) {
        for (int it = wrank; it < 2 * I_G + I_D + I_OUT; it += nwaves) {
            int r = it;
            if (r < I_G) { transpose_item(a->in[4], DM, DFF, (bf16*)(ws + WS_WA), 1, scr, r, lane); continue; } r -= I_G;
            if (r < I_G) { transpose_item(a->in[5], DM, DFF, (bf16*)(ws + WS_WA), 2, scr, r, lane); continue; } r -= I_G;
            if (r < I_D) { transpose_item(a->in[6], DFF, DM, (bf16*)(ws + WS_WD), 0, scr, r, lane); continue; } r -= I_D;
            transpose_item(a->in[16], DM, DM, (bf16*)(ws + WS_WOUT), 0, scr, r, lane);
        }
    } else if (set == 1) {
        for (int it = wrank; it < I_IN; it += nwaves) transpose_item(a->in[8], DM, IN_W, (bf16*)(ws + WS_WIN), 0, scr, it, lane, a->in[7]);
    } else if (set == 2) {
        for (int it = wrank; it < 2 * I_G; it += nwaves) {
            if (it < I_G) transpose_item(a->in[18], DM, DFF, (bf16*)(ws + WS_WA), 1, scr, it, lane, a->in[17]);
            else transpose_item(a->in[19], DM, DFF, (bf16*)(ws + WS_WA), 2, scr, it - I_G, lane, a->in[17]);
        }
    } else {
        for (int it = wrank; it < I_D; it += nwaves) transpose_item(a->in[20], DFF, DM, (bf16*)(ws + WS_WD), 0, scr, it, lane);
    }
}
__device__ __forceinline__ int idle_rank(const int nwg, const int G, const int c, int& nidle) {
    const int last = (nwg + G - 1) / G - 1, first_idle = nwg - last * G;
    nidle = G - first_idle; return c >= first_idle ? c - first_idle : -1;
}
__device__ __forceinline__ void p0_prologue(Frame& F, ArgsP a) {
    p_weights(F, a, 0, F.vcu * NWAVES + F.wave, F.G * NWAVES);
    const int gw = F.vcu * NWAVES + F.wave, NGW = F.G * NWAVES, lane = F.lane_now();
    bf16* HN = (bf16*)(a->ws + WS_HN); bf16* PR = (bf16*)(a->ws + WS_BIG);
    for (int m = gw; m < MP; m += NGW) {
        if (m < NTOK) { const float* x = m < S_P ? a->in[0] + (size_t)m * DM : a->in[1] + (size_t)(m - S_P) * DM; rms_row<false>(x, a->in[3], HN + (size_t)m * DM, lane); }
        else if (m < NTOK + NMETA) rms_row<false>(a->in[2] + (size_t)(m - NTOK) * DM, a->in[3], HN + (size_t)m * DM, lane);
        else zero_row_bf16(HN + (size_t)m * DM, lane);
    }
}
__device__ __forceinline__ void p_stats(Frame& F, ArgsP a, const int which) {
    const int gw = F.vcu * NWAVES + F.wave, NGW = F.G * NWAVES, lane = F.lane_now();
    const float* SSQP = (const float*)(a->ws + WS_SSQP); float* RSTD = (float*)(a->ws + WS_RSTD);
    for (int m = gw; m < NTOK; m += NGW) { const float s = wave_sum(SSQP[(size_t)m * 64 + lane]); if (lane == 0) RSTD[m] = 1.f / sqrtf(s * (1.f / DM) + EPS); }
    if (which == 1) { const float* HM = (const float*)(a->ws + WS_HMETA);
        for (int i = gw; i < NMETA; i += NGW) { const f32x4* xr = (const f32x4*)(HM + (size_t)i * DM) + lane; float s = 0.f;
#pragma unroll
            for (int j = 0; j < 16; ++j) { const f32x4 v = xr[64 * j]; s += (v.x * v.x + v.y * v.y) + (v.z * v.z + v.w * v.w); }
            s = wave_sum(s); if (lane == 0) RSTD[NTOK + i] = 1.f / sqrtf(s * (1.f / DM) + EPS); } }
}
template <class Epi> __device__ __forceinline__ void meta_gemm(Frame& F, const bf16* __restrict__ A16, const int lda, const bf16* __restrict__ Bt, const int K, const int nblk, const Epi& E) {
    LAS f32x4* red = (LAS f32x4*)(F.lds + RING_OFF);
    const int lane = F.lane_now(), row = lane & 15, quad = lane >> 4, kw = K / NWAVES;
    for (int cb = F.vcu; cb < nblk; cb += F.G) {
        const bf16* ap = A16 + (size_t)row * lda + F.wave * kw + quad * 8;
        const bf16* bp = Bt + (size_t)(E.brow(cb) + row) * K + F.wave * kw + quad * 8;
        f32x4 acc = {0.f, 0.f, 0.f, 0.f};
#pragma unroll 4
        for (int k = 0; k < kw; k += 32) { const bf16x8 av = *(const bf16x8*)(ap + k), bv = *(const bf16x8*)(bp + k); acc = __builtin_amdgcn_mfma_f32_16x16x32_bf16(bv, av, acc, 0, 0, 0); }
        __syncthreads();
        red[F.wave * 64 + lane] = acc;
        __syncthreads();
        if (F.wave == 0) { f32x4 s = red[lane];
#pragma unroll
            for (int w = 1; w < NWAVES; ++w) s = s + red[w * 64 + lane];
            E(cb, row, 4 * quad, s); }
    }
    __syncthreads();
}
struct MetaEpiDown {
    const float* xm; float* hm; bf16* hb;
    __device__ __forceinline__ int brow(int cb) const { return 16 * cb; }
    __device__ __forceinline__ void operator()(int cb, int r, int c4, f32x4 s) const { const int col = 16 * cb + c4;
        const f32x4 h = *(const f32x4*)(xm + (size_t)r * DM + col) + s * 0.5f; *(f32x4*)(hm + (size_t)r * DM + col) = h;
        *(unsigned long long*)(hb + (size_t)(NTOK + r) * DM + col) = (unsigned long long)pk2(h.x, h.y) | ((unsigned long long)pk2(h.z, h.w) << 32); }
};
struct MetaEpiKV {
    const float* rstd; bf16* pr;
    __device__ __forceinline__ int brow(int cb) const { const int c16 = 16 * cb, seg = c16 >> 11; return (seg == 0 ? C_KNA : seg == 1 ? C_VNA : seg == 2 ? C_KD : C_VD) + (c16 & 2047); }
    __device__ __forceinline__ void operator()(int cb, int r, int c4, f32x4 s) const { const f32x4 v = s * rstd[NTOK + r]; const int col = brow(cb) + c4;
        *(unsigned long long*)(pr + (size_t)(NTOK + r) * IN_W + col) = (unsigned long long)pk2(v.x, v.y) | ((unsigned long long)pk2(v.z, v.w) << 32);
#pragma unroll
        for (int z = 1; z < 4; ++z) *(unsigned long long*)(pr + (size_t)(NTOK + 16 * z + r) * IN_W + col) = 0ull; }
};
__device__ __forceinline__ void rope_consts(int i, float& rh, float& rl) {
    constexpr float RH[16] = {0x1.45c0000000000p-3f, 0x1.1f00000000000p-4f, 0x1.f980000000000p-6f, 0x1.bd40000000000p-7f, 0x1.8800000000000p-8f, 0x1.5940000000000p-9f, 0x1.3040000000000p-10f, 0x1.0bc0000000000p-11f, 0x1.d800000000000p-13f, 0x1.9f80000000000p-14f, 0x1.6e00000000000p-15f, 0x1.4240000000000p-16f, 0x1.1c00000000000p-17f, 0x1.f440000000000p-19f, 0x1.b880000000000p-20f, 0x1.8400000000000p-21f};
    constexpr float RL[16] = {0x1.9836e40000000p-14f, 0x1.30b61c0000000p-16f, 0x1.600ce80000000p-17f, 0x1.cae3200000000p-19f, 0x1.f6072c0000000p-19f, 0x1.b4dc9a0000000p-20f, 0x1.68c2f60000000p-25f, 0x1.c83dda0000000p-22f, 0x1.9a44960000000p-27f, 0x1.d334540000000p-25f, 0x1.2a1e800000000p-26f, 0x1.cffd9e0000000p-27f, 0x1.0312900000000p-31f, 0x1.19196a0000000p-32f, 0x1.df43180000000p-32f, 0x1.0e74a40000000p-33f};
    rh = RH[0]; rl = RL[0];
#pragma unroll
    for (int k = 1; k < 16; ++k) if (i == k) { rh = RH[k]; rl = RL[k]; }
}
__device__ __forceinline__ void p_rope(Frame& F, ArgsP a) {
    const int gw = F.vcu * NWAVES + F.wave, NGW = F.G * NWAVES;
    bf16* PR = (bf16*)(a->ws + WS_BIG);
    const int lane = F.lane_now(), g = lane >> 1, ah = lane & 1;
    const int col = (g < 16 ? C_QD : C_KD) + (g & 15) * 128 + 8 * ah;
    float rh[8], rl[8];
#pragma unroll
    for (int e = 0; e < 8; ++e) rope_consts(8 * ah + e, rh[e], rl[e]);
    const float sgn = a->probe ? -1.f : 1.f;
    for (int m = gw; m < NTOK + NMETA; m += NGW) {
        const int pos = m < S_P ? NMETA + m : (m < NTOK ? NMETA + ((m - S_P) & (S_S - 1)) : m - NTOK);
        const float pf = (float)pos;
        bf16* p = PR + (size_t)m * IN_W + col;
        const v4u x1 = *(const v4u*)p, x2 = *(const v4u*)(p + 16);
        unsigned y1[4], y2[4];
#pragma unroll
        for (int e = 0; e < 4; ++e) {
            const unsigned w1 = x1[e], w2 = x2[e];
            const float a0 = __uint_as_float(w1 << 16), a1 = __uint_as_float(w1 & 0xffff0000u), b0 = __uint_as_float(w2 << 16), b1 = __uint_as_float(w2 & 0xffff0000u);
            const float t0 = fmaf(pf, rl[2 * e], __builtin_amdgcn_fractf(pf * rh[2 * e])), t1 = fmaf(pf, rl[2 * e + 1], __builtin_amdgcn_fractf(pf * rh[2 * e + 1]));
            const float c0 = __builtin_amdgcn_cosf(t0), s0 = sgn * __builtin_amdgcn_sinf(t0), c1 = __builtin_amdgcn_cosf(t1), s1 = sgn * __builtin_amdgcn_sinf(t1);
            y1[e] = pk2(a0 * c0 - b0 * s0, a1 * c1 - b1 * s1); y2[e] = pk2(a0 * s0 + b0 * c0, a1 * s1 + b1 * c1);
        }
        *(v4u*)p = (v4u){y1[0], y1[1], y1[2], y1[3]}; *(v4u*)(p + 16) = (v4u){y2[0], y2[1], y2[2], y2[3]};
    }
}
__device__ __forceinline__ void p_final(Frame& F, ArgsP a) {
    const int gw = F.vcu * NWAVES + F.wave, NGW = F.G * NWAVES, lane = F.lane_now();
    const bf16* H3 = (const bf16*)(a->ws + WS_H3); const float* SSQP = (const float*)(a->ws + WS_SSQP); const f32x4* gr = (const f32x4*)a->in[21] + lane;
    for (int m = gw; m < NTOK; m += NGW) {
        const float rstd = 1.f / sqrtf(wave_sum(SSQP[(size_t)m * 64 + lane]) * (1.f / DM) + EPS);
        const unsigned long long* hr = (const unsigned long long*)(H3 + (size_t)m * DM) + lane;
        f32x4* o = (f32x4*)(a->out + (size_t)m * DM) + lane;
        unsigned long long w[16];
#pragma unroll
        for (int j = 0; j < 16; ++j) w[j] = hr[64 * j];
#pragma unroll
        for (int j = 0; j < 16; ++j) { const unsigned lo = (unsigned)w[j], hi = (unsigned)(w[j] >> 32); const f32x4 gg = gr[64 * j];
            o[64 * j] = (f32x4){__uint_as_float(lo << 16), __uint_as_float(lo & 0xffff0000u), __uint_as_float(hi << 16), __uint_as_float(hi & 0xffff0000u)} * rstd * gg; }
    }
}

__device__ __forceinline__ void diff_unit(Frame& F, ArgsP a, int seq_row0, int S, int h, int qb) {
    using namespace att;
    const att::rsrc_t rs = __builtin_amdgcn_make_buffer_rsrc((void*)(a->ws + WS_BIG), 0, (int)((size_t)MP * IN_W * 2), 0x00020000);
    ATT_LAS char* lds = (ATT_LAS char*)(F.lds + RING_OFF);
    const int qrow0 = seq_row0 + qb * 256, NT = 1 + S / 64;
    for (int map = 0; map < 2; ++map) {
        f32x16 o[8]; float rli[16];
        att2::diff_run(rs, ((unsigned)qrow0 * LD + C_QD + (h * 2 + map) * 128) * 2u, (unsigned)(C_KD + (h * 2 + map) * 128) * 2u, (unsigned)(C_VD + h * 256) * 2u, seq_row0, NT, lds, o, rli, F.wave);
        int ln_ = att::lane_of(); asm volatile("" : "+v"(ln_));
        const int tt = F.wave * 64 + ln_, r32 = ln_ & 31, hi = ln_ >> 5, wv = F.wave;
        float* scrw = (float*)(a->ws + WS_SCR) + (size_t)blockIdx.x * 512 * 128;
        const unsigned so = (unsigned)tt * 128u;
        if (map == 0) {
#pragma unroll
            for (int d = 0; d < 8; ++d)
#pragma unroll
                for (int q = 0; q < 4; ++q) *(f32x4*)(scrw + so + d * 16 + q * 4) = (f32x4){o[d][4 * q] * rli[4 * q], o[d][4 * q + 1] * rli[4 * q + 1], o[d][4 * q + 2] * rli[4 * q + 2], o[d][4 * q + 3] * rli[4 * q + 3]};
        } else {
            float lam; { const int ln = tt & 63; const float* lq1 = a->in[11]; const float* lk1 = a->in[12]; const float* lq2 = a->in[13]; const float* lk2 = a->in[14];
                const float d1 = wave_sum(lq1[ln] * lk1[ln] + lq1[ln + 64] * lk1[ln + 64]), d2 = wave_sum(lq2[ln] * lk2[ln] + lq2[ln + 64] * lk2[ln + 64]);
                lam = expf(d1) - expf(d2) + LAM_INIT; }
#pragma unroll
            for (int r = 0; r < 16; ++r) rli[r] *= -lam;
            float ssq[16];
#pragma unroll
            for (int r = 0; r < 16; ++r) ssq[r] = 0.f;
#pragma unroll
            for (int d = 0; d < 8; ++d) {
#pragma unroll
                for (int q = 0; q < 4; ++q) { const f32x4 t = *(const f32x4*)(scrw + so + d * 16 + q * 4);
#pragma unroll
                    for (int e = 0; e < 4; ++e) { const float v = fmaf(o[d][4 * q + e], rli[4 * q + e], t[e]); ssq[4 * q + e] = fmaf(v, v, ssq[4 * q + e]); } }
                asm volatile("" ::: "memory"); }
#pragma unroll
            for (int r = 0; r < 16; ++r) ssq[r] = (1.0f - LAM_INIT) / sqrtf(half_sum(ssq[r]) * (1.0f / 256.0f) + SUBLN_EPS);
            const float* gn = a->in[15];
            bf16* obase = (bf16*)(a->ws + WS_HN) + (size_t)qrow0 * DM + NA_W + h * 256;
            const unsigned oo = (unsigned)((wv * 32 + 4 * hi) * DM + r32);
#pragma unroll
            for (int d = 0; d < 8; ++d) { const float g = gn[d * 32 + r32];
#pragma unroll
                for (int q = 0; q < 4; ++q) { const f32x4 t = *(const f32x4*)(scrw + so + d * 16 + q * 4);
#pragma unroll
                    for (int e = 0; e < 4; ++e) { const int r = 4 * q + e; const float v = fmaf(o[d][r], rli[r], t[e]);
                        obase[oo + (unsigned)(((r & 3) + 8 * (r >> 2)) * DM + d * 32)] = f2bf_s(v * ssq[r] * g); } }
                asm volatile("" ::: "memory"); }
        }
    }
}
__device__ __forceinline__ void na_unit(Frame& F, ArgsP a, int seq_row0, int nrows, int h, int qb) {
    using namespace att;
    const att::rsrc_t rs = __builtin_amdgcn_make_buffer_rsrc((void*)(a->ws + WS_BIG), 0, (int)((size_t)MP * IN_W * 2), 0x00020000); bf16* MIX = (bf16*)(a->ws + WS_HN);
    ATT_LAS char* lds = (ATT_LAS char*)(F.lds + RING_OFF);
    ATT_LAS float* rpb = (ATT_LAS float*)(F.lds + ATT_RPB_OFF);
    const int lane = F.lane_now(), r32 = lane & 31, hi = lane >> 5;
    __syncthreads();
    for (int i = F.wave * 64 + lane; i < 15 * 31; i += NWAVES * 64) rpb[i] = a->in[9][h * 465 + i] * (1.0f / SCALE);
    const int qrow0 = seq_row0 + qb * 256;
    NaCtx na; na.qrow = 4 * qb + (F.wave >> 1); na.r0 = min(max(na.qrow - 4, 0), nrows - 8); na.kr_first = min(max(4 * qb - 4, 0), nrows - 11);
    na.c = 32 * (F.wave & 1) + r32; na.c0 = min(max(na.c - 8, 0), 48); na.rpb = rpb;
    f32x16 o[4];
    attn_run<true>(rs, ((unsigned)qrow0 * LD + C_QNA + h * 128) * 2u, (unsigned)(C_KNA + h * 128) * 2u, (unsigned)(C_VNA + h * 128) * 2u, seq_row0 + na.kr_first * 64, 12, lds, na, o, F.wave);
    int ln_ = att::lane_of(); asm volatile("" : "+v"(ln_));
    const int e32 = ln_ & 31, ehi = ln_ >> 5, wv = F.wave;
    const float* gn = a->in[10] + h * 128;
    float g[4];
#pragma unroll
    for (int d = 0; d < 4; ++d) g[d] = gn[d * 32 + e32];
    bf16* ob = MIX + (size_t)(qrow0 + wv * 32 + 4 * ehi) * DM + h * 128 + e32;
#pragma unroll
    for (int r = 0; r < 16; ++r) { float s = 0.f;
#pragma unroll
        for (int d = 0; d < 4; ++d) s += o[d][r] * o[d][r];
        const float rs = 1.0f / sqrtf(half_sum(s) * (1.0f / 128.0f) + EPS);
        bf16* op = ob + (size_t)((r & 3) + 8 * (r >> 2)) * DM;
#pragma unroll
        for (int d = 0; d < 4; ++d) op[d * 32] = f2bf_s(o[d][r] * rs * g[d]); }
}
__device__ __forceinline__ void p_attention(Frame& F, ArgsP a) {
    if (F.wave >= 4) __builtin_amdgcn_s_setprio(1);
    const int v = F.vcu;
    for (int u = v; u < 256 + 512; u += F.G) {
        int seq_row0, S, h, qb;
        if (u < 256) { seq_row0 = 0; S = S_P; h = u >> 5; qb = u & 31; }
        else { const int t = u - 256, pair = t >> 4; seq_row0 = S_P + (pair >> 3) * S_S; S = S_S; h = pair & 7; qb = t & 15; }
#ifndef ATT_NO_DIFF
        diff_unit(F, a, seq_row0, S, h, qb);
#endif
    }
    for (int n = v; n < 16 * 96; n += F.G) { const int h = n / 96, q = n - h * 96; int seq_row0, nrows, qb;
        if (q < 32) { seq_row0 = 0; nrows = S_P / 64; qb = q; }
        else { const int t = q - 32; seq_row0 = S_P + (t >> 4) * S_S; nrows = S_S / 64; qb = t & 15; }
#ifndef ATT_NO_NA
        na_unit(F, a, seq_row0, nrows, h, qb);
#endif
    }
    __builtin_amdgcn_s_setprio(0);
}

__global__ void __launch_bounds__(NWAVES * 64, 2) mk_fwd(Args args) {
    extern __shared__ __attribute__((aligned(16))) unsigned char lds[];
    Frame F;
    F.lds = (LAS unsigned char*)lds;
    F.MISC = (volatile LAS unsigned*)(F.lds + MISC_OFF);
    F.wave = __builtin_amdgcn_readfirstlane((int)threadIdx.x >> 6);
    F.G = gridDim.x; { const int bx = blockIdx.x; F.vcu = (F.G % 8 == 0) ? (bx % 8) * (F.G / 8) + bx / 8 : bx; }
    int lo, hi;
    { ARGS_HERE(a0); F.ctl = (gu32*)(a0->ws + WS_CTL); lo = a0->ph_lo; hi = a0->ph_hi; }
    for (int u = F.wave * 64 + F.lane_now(); u < (LDS_BYTES - LDSCTL_OFF) / 4; u += NWAVES * 64) ((LAS unsigned*)(F.lds + LDSCTL_OFF))[u] = 0u;
    __syncthreads();
    XcdBarrier bar; bar.bar = (unsigned*)(F.ctl + CW_BAR); bar.x = 0; bar.st = nullptr;
    if (N_LAUNCHES == 1) bar = xcd_barrier_post((unsigned*)(F.ctl + CW_BAR), F.MISC + 8, F.wave * 64 + att::lane_of());
#ifndef PH_MASK
#define PH_MASK 0xFFF
#endif
#define IN(k) ((((PH_MASK) >> (k)) & 1) && lo <= (k) && (k) < hi)
#define SEAM(k) do { if (IN(k) && IN((k) + 1)) xcd_barrier(bar, F.wave * 64 + att::lane_of()); } while (0)
#define WSP(T, off) ((T*)(a->ws + (off)))

#define PHASE(k) if (IN(k))

    PHASE(0) { ARGS_HERE(a); p0_prologue(F, a); } SEAM(0);
    PHASE(1) {
        ARGS_HERE(a);
        pg8::Gemm g{WSP(bf16, WS_HN), WSP(bf16, WS_WA), MP, 2 * DFF, DM}; pg8::StaticOrder S; S.init(MP, 2 * DFF, F.G, (int)blockIdx.x);
        pg8::EpiSwiglu E{WSP(bf16, WS_BIG), DFF, nullptr};
        pg8::gemm_phase<pg8::EpiSwiglu, pg8::StaticOrder, true, true>(F.lds + RING_OFF, g, S, E, F.wave);
        { int nidle; const int r = idle_rank(S.nwg, F.G, (int)blockIdx.x, nidle);
          if (nidle == 0) p_weights(F, a, 1, F.vcu * NWAVES + F.wave, F.G * NWAVES); else if (r >= 0) p_weights(F, a, 1, r * NWAVES + F.wave, nidle * NWAVES); } } SEAM(1);
    PHASE(2) {
        ARGS_HERE(a);
        { MetaEpiDown ME{a->in[2], WSP(float, WS_HMETA), WSP(bf16, WS_HB)}; meta_gemm(F, WSP(bf16, WS_BIG) + (size_t)NTOK * DFF, DFF, WSP(bf16, WS_WD), DFF, DM / 16, ME); }
        pg8::Gemm g{WSP(bf16, WS_BIG), WSP(bf16, WS_WD), NTOK, DM, DFF}; pg8::StaticOrder S; S.init(NTOK, DM, F.G, (int)blockIdx.x);
        pg8::EpiRes<0, 1> E{a->in[0], a->in[1], nullptr, nullptr, WSP(bf16, WS_HB), WSP(float, WS_SSQP), 0.5f, DM};
        pg8::gemm_phase<pg8::EpiRes<0, 1>, pg8::StaticOrder, false, true>(F.lds + RING_OFF, g, S, E, F.wave); } SEAM(2);
    PHASE(3) { ARGS_HERE(a); p_stats(F, a, 1); } SEAM(3);
    PHASE(4) {
        ARGS_HERE(a);
        { MetaEpiKV ME{WSP(float, WS_RSTD), WSP(bf16, WS_BIG)}; meta_gemm(F, WSP(bf16, WS_HB) + (size_t)NTOK * DM, DM, WSP(bf16, WS_WIN), DM, 8192 / 16, ME); }
        pg8::Gemm g{WSP(bf16, WS_HB), WSP(bf16, WS_WIN), NTOK, IN_W, DM}; pg8::StaticOrder S; S.init(NTOK, IN_W, F.G, (int)blockIdx.x);
        pg8::EpiProj E{WSP(bf16, WS_BIG), IN_W, WSP(float, WS_RSTD)};
        pg8::gemm_phase<pg8::EpiProj, pg8::StaticOrder, true, true>(F.lds + RING_OFF, g, S, E, F.wave); } SEAM(4);
    PHASE(5) { ARGS_HERE(a); p_rope(F, a); } SEAM(5);
    PHASE(6) { ARGS_HERE(a); p_attention(F, a); } SEAM(6);
    PHASE(7) {
        ARGS_HERE(a);
        pg8::Gemm g{WSP(bf16, WS_HN), WSP(bf16, WS_WOUT), NTOK, DM, DM}; pg8::StaticOrder S; S.init(NTOK, DM, F.G, (int)blockIdx.x);
        pg8::EpiRes<1, 1> E{nullptr, nullptr, WSP(bf16, WS_HB), nullptr, WSP(bf16, WS_HB), WSP(float, WS_SSQP), 1.0f, DM};
        pg8::gemm_phase<pg8::EpiRes<1, 1>, pg8::StaticOrder, false, true>(F.lds + RING_OFF, g, S, E, F.wave); } SEAM(7);
    PHASE(8) { ARGS_HERE(a); p_stats(F, a, 2); p_weights(F, a, 2, F.vcu * NWAVES + F.wave, F.G * NWAVES); } SEAM(8);
    PHASE(9) {
        ARGS_HERE(a);
        pg8::Gemm g{WSP(bf16, WS_HB), WSP(bf16, WS_WA), NTOK, 2 * DFF, DM}; pg8::StaticOrder S; S.init(NTOK, 2 * DFF, F.G, (int)blockIdx.x);
        pg8::EpiSwiglu E{WSP(bf16, WS_BIG), DFF, WSP(float, WS_RSTD)};
        pg8::gemm_phase<pg8::EpiSwiglu, pg8::StaticOrder, true, true>(F.lds + RING_OFF, g, S, E, F.wave);
        { int nidle; const int r = idle_rank(S.nwg, F.G, (int)blockIdx.x, nidle);
          if (nidle == 0) p_weights(F, a, 3, F.vcu * NWAVES + F.wave, F.G * NWAVES); else if (r >= 0) p_weights(F, a, 3, r * NWAVES + F.wave, nidle * NWAVES); } } SEAM(9);
    PHASE(10) {
        ARGS_HERE(a);
        pg8::Gemm g{WSP(bf16, WS_BIG), WSP(bf16, WS_WD), NTOK, DM, DFF}; pg8::StaticOrder S; S.init(NTOK, DM, F.G, (int)blockIdx.x);
        pg8::EpiRes<1, 1> E{nullptr, nullptr, WSP(bf16, WS_HB), nullptr, WSP(bf16, WS_H3), WSP(float, WS_SSQP), 0.5f, DM};
        pg8::gemm_phase<pg8::EpiRes<1, 1>, pg8::StaticOrder, false, true>(F.lds + RING_OFF, g, S, E, F.wave); } SEAM(10);
    PHASE(11) { ARGS_HERE(a); p_final(F, a); }
#undef PHASE
#undef IN
#undef SEAM
#undef WSP
}

extern "C" void kernel_launch(void* const* d_in, const int* in_sizes, int n_in, void* d_out, int out_size, void* d_ws, size_t ws_size, hipStream_t stream) {
    static int grid = 0;
    if (grid == 0) {
        if (n_in != 22 || in_sizes[0] != S_P * DM || in_sizes[1] != NB_S * S_S * DM || out_size != NTOK * DM || ws_size < WS_END) {
            fprintf(stderr, "kernel_launch: shape mismatch: n_in %d in0 %d in1 %d out %d ws %zu (need %zu)\n", n_in, n_in > 0 ? in_sizes[0] : -1, n_in > 1 ? in_sizes[1] : -1, out_size, ws_size, (size_t)WS_END); grid = -1; return; }
        int dev = 0, cus = 0, per_cu = 0;
        if (hipGetDevice(&dev) != hipSuccess || hipDeviceGetAttribute(&cus, hipDeviceAttributeMultiprocessorCount, dev) != hipSuccess) { grid = -1; return; }
        if (hipFuncSetAttribute((const void*)mk_fwd, hipFuncAttributeMaxDynamicSharedMemorySize, LDS_BYTES) != hipSuccess) { fprintf(stderr, "kernel_launch: hipFuncSetAttribute failed\n"); grid = -1; return; }
        if (hipOccupancyMaxActiveBlocksPerMultiprocessor(&per_cu, (const void*)mk_fwd, NWAVES * 64, LDS_BYTES) != hipSuccess || per_cu < 1)
            fprintf(stderr, "kernel_launch: note: occupancy query reports %d workgroups per CU\n", per_cu);
        (void)hipGetLastError();
        grid = cus;
    }
    if (grid < 0) return;
    if (hipMemsetAsync((char*)d_ws + WS_CTL, 0, CTL_ZERO_BYTES, stream) != hipSuccess) { fprintf(stderr, "kernel_launch: memset failed\n"); return; }
    Args a{};
    for (int i = 0; i < 22; ++i) a.in[i] = (const float*)d_in[i];
    a.out = (float*)d_out; a.ws = (unsigned char*)d_ws;
#if defined(PROBE_TWICE)
    for (int pass_ = 0; pass_ < 2; ++pass_)
#endif
    for (int li = 0; li < N_LAUNCHES; ++li) {
        a.ph_lo = (N_LAUNCHES == 1) ? 0 : li; a.ph_hi = (N_LAUNCHES == 1) ? N_PHASES : li + 1;
        hipLaunchKernelGGL(mk_fwd, dim3(grid), dim3(NWAVES * 64), LDS_BYTES, stream, a);
#if defined(PROBE_REPEAT)
#ifndef PROBE_TIMES
#define PROBE_TIMES 1
#endif
        if (N_LAUNCHES > 1 && (((PROBE_REPEAT) >> li) & 1)) for (int rp_ = 0; rp_ < PROBE_TIMES; ++rp_) hipLaunchKernelGGL(mk_fwd, dim3(grid), dim3(NWAVES * 64), LDS_BYTES, stream, a);
#endif
#if defined(PROBE_SEQ01)
        if (N_LAUNCHES > 1 && li == 1) { Args b = a; b.ph_lo = 0; b.ph_hi = 1; hipLaunchKernelGGL(mk_fwd, dim3(grid), dim3(NWAVES * 64), LDS_BYTES, stream, b); hipLaunchKernelGGL(mk_fwd, dim3(grid), dim3(NWAVES * 64), LDS_BYTES, stream, a); }
#endif
#if defined(PROBE_ROPE)
        if (N_LAUNCHES > 1 && li == 5) { Args b = a; b.probe = 1; hipLaunchKernelGGL(mk_fwd, dim3(grid), dim3(NWAVES * 64), LDS_BYTES, stream, b); hipLaunchKernelGGL(mk_fwd, dim3(grid), dim3(NWAVES * 64), LDS_BYTES, stream, a); }
#endif
#if defined(PROBE_REPEAT_ALT)
        if (N_LAUNCHES > 1 && (((PROBE_REPEAT_ALT) >> li) & 1)) { Args b = a; b.out = (float*)((unsigned char*)d_ws + WS_BIG); b.probe = PROBE_FOLD;
            hipLaunchKernelGGL(mk_fwd, dim3(grid), dim3(NWAVES * 64), LDS_BYTES, stream, b); }
#endif
        const hipError_t le = hipPeekAtLastError();
        if (le != hipSuccess) { fprintf(stderr, "kernel_launch: launch %d failed: %s\n", li, hipGetErrorName(le)); break; }
    }
}
```

```cpp
#include <hip/hip_runtime.h>
#include <cstdio>
#include <cstdint>
#include <cmath>
namespace pg8 {
#define PG8_LAS __attribute__((address_space(3)))
typedef unsigned short bf16_t;
typedef short bf16x8 __attribute__((ext_vector_type(8)));
typedef float f32x4 __attribute__((ext_vector_type(4)));
typedef unsigned u32x4 __attribute__((ext_vector_type(4)));
constexpr int BM = 256, BK = 64, HALF = 128, HTB = HALF * BK * 2  , STAGE_BYTES = 8 * HTB, NXCD = 8, WGM = 8;

__host__ __device__ __forceinline__ int lds_byte(int r, int c) { const int st = (r >> 4) * 2 + (c >> 5), rr = r & 15, cc = c & 31, ob = rr * 64 + cc * 2; return st * 1024 + (ob ^ (((ob >> 9) & 1) << 5)); }
__host__ __device__ __forceinline__ void stage_rc(int b, int& R, int& C) { const int st = b / 1024, sb = b % 1024, swz = sb ^ (((sb >> 9) & 1) << 5); R = (st >> 1) * 16 + swz / 64; C = (st & 1) * 32 + (swz % 64) / 2; }
__host__ __device__ __forceinline__ int perm32(int rho) { const int n = rho >> 4, i = rho & 15; return 8 * (i >> 2) + 4 * n + (i & 3); }

struct Unit { int pm, pn; };
struct Gemm { const bf16_t* A; const bf16_t* Bt; int M, N, K; };

struct StaticOrder {
    int nM, nN, nwg, G, c, fold;
    __host__ __device__ void init(int M, int N, int G_, int c_) { nM = M / BM; nN = N / BM; nwg = nM * nN; G = G_; c = c_; fold = 0; }
    __host__ __device__ bool next(int i, Unit& u) const {
        const long L = (long)i * G + c; if (L >= nwg) return false;
        int wgid = (int)L; { const int q = nwg / NXCD, r = nwg % NXCD, xcd = wgid % NXCD, off = wgid / NXCD; wgid = (xcd < r ? xcd * (q + 1) : r * (q + 1) + (xcd - r) * q) + off; }
        const int nig = WGM * nN, gid = wgid / nig, fm = gid * WGM, gsz = (nM - fm) < WGM ? (nM - fm) : WGM;
        u.pm = fm + ((wgid % nig) % gsz); u.pn = (wgid % nig) / gsz; if (fold) { u.pm &= 1; u.pn &= 1; } return true;
    }
    __device__ __forceinline__ void a_ready(const Unit&) const {}
    __device__ __forceinline__ void done(const Unit&) const {}
};

__device__ __forceinline__ unsigned cvt_pk_bf16(float lo, float hi) { unsigned r; asm volatile("v_cvt_pk_bf16_f32 %0, %1, %2" : "=v"(r) : "v"(lo), "v"(hi)); return r; }
typedef float f32x2 __attribute__((ext_vector_type(2)));

__device__ __forceinline__ int pg8_lane_now() { int l; asm volatile("v_mbcnt_lo_u32_b32 %0, -1, 0\n\tv_mbcnt_hi_u32_b32 %0, -1, %0" : "=v"(l)); return l; }
__device__ __forceinline__ float silu_mul(float g, float up) { const float e = __builtin_amdgcn_exp2f(g * -1.4426950408889634f); return g * __builtin_amdgcn_rcpf(1.0f + e) * up; }
__device__ __forceinline__ float bf_lo(unsigned w) { return __uint_as_float(w << 16); }
__device__ __forceinline__ float bf_hi(unsigned w) { return __uint_as_float(w & 0xffff0000u); }
struct EpiSwiglu {
    static constexpr bool PERM = true, AFTER_DRAIN = false;
    bf16_t* O; int ldc; const float* rs;
    __device__ __forceinline__ void operator()(const f32x4 (&acc)[2][2][4][2], const Unit& u, int wr, int wc, int fr, int fq) const {
        const int row0 = u.pm * BM + wr * 64 + fr, col0 = u.pn * HALF + wc * 32 + 8 * fq;
#pragma unroll
        for (int ai = 0; ai < 2; ++ai)
#pragma unroll
            for (int m = 0; m < 4; ++m) { const int row = row0 + ai * HALF + m * 16; bf16_t* rowp = O + (size_t)row * ldc + col0;
                const float sc = rs ? rs[row] : 1.0f;
                float v[8];
#pragma unroll
                for (int n = 0; n < 2; ++n)
#pragma unroll
                    for (int j = 0; j < 4; ++j) v[n * 4 + j] = silu_mul(acc[ai][0][m][n][j] * sc, acc[ai][1][m][n][j] * sc);
                u32x4 w; w.x = cvt_pk_bf16(v[0], v[1]); w.y = cvt_pk_bf16(v[2], v[3]); w.z = cvt_pk_bf16(v[4], v[5]); w.w = cvt_pk_bf16(v[6], v[7]);
                *(u32x4*)rowp = w; }
    }
};
struct EpiProj {
    static constexpr bool PERM = true, AFTER_DRAIN = false;
    bf16_t* O; int ldc; const float* rs; const float* tab; int pn_lo, pn_hi;
    __device__ __forceinline__ void operator()(const f32x4 (&acc)[2][2][4][2], const Unit& u, int wr, int wc, int fr, int fq) const {
        const int row0 = u.pm * BM + wr * 64 + fr, col0 = u.pn * BM + wc * 32 + 8 * fq;
        const bool rope = wc == 0 && u.pn >= pn_lo && u.pn < pn_hi;
        const float sg = fq < 2 ? -1.f : 1.f;
#pragma unroll
        for (int ai = 0; ai < 2; ++ai)
#pragma unroll
            for (int m = 0; m < 4; ++m) { const int row = row0 + ai * HALF + m * 16; bf16_t* rowp = O + (size_t)row * ldc + col0;
                const float sc = rs ? rs[row] : 1.0f;
                f32x4 c0, c1, s0, s1;
                if (rope) { const int pos = row < 8192 ? 16 + row : 16 + ((row - 8192) & 4095); const float* tb = tab + pos * 32 + 8 * (fq & 1);
                    c0 = *(const f32x4*)tb; c1 = *(const f32x4*)(tb + 4); s0 = *(const f32x4*)(tb + 16) * sg; s1 = *(const f32x4*)(tb + 20) * sg; }
#pragma unroll
                for (int bj = 0; bj < 2; ++bj) { f32x4 v0 = acc[ai][bj][m][0] * sc, v1 = acc[ai][bj][m][1] * sc;
                    if (rope) { f32x4 q0, q1;
#pragma unroll
                        for (int e2 = 0; e2 < 4; ++e2) { q0[e2] = __shfl_xor(v0[e2], 32); q1[e2] = __shfl_xor(v1[e2], 32); }
                        v0 = v0 * c0 + q0 * s0; v1 = v1 * c1 + q1 * s1; }
                    u32x4 w; w.x = cvt_pk_bf16(v0[0], v0[1]); w.y = cvt_pk_bf16(v0[2], v0[3]); w.z = cvt_pk_bf16(v1[0], v1[1]); w.w = cvt_pk_bf16(v1[2], v1[3]);
                    *(u32x4*)(rowp + bj * HALF) = w; } }
    }
};
template <int SRC, int DST> struct EpiRes {
    static constexpr bool PERM = true, AFTER_DRAIN = false;
    const float* s0; const float* s1; const bf16_t* sb; float* df; bf16_t* db; float* ssq; float alpha; int ldc;
    __device__ __forceinline__ void operator()(const f32x4 (&acc)[2][2][4][2], const Unit& u, int wr, int wc, int fr, int fq) const {
        const int pm = u.pm;
        const char* sfb = (const char*)(pm < 32 ? s0 + (size_t)pm * BM * ldc : s1 + (size_t)(pm - 32) * BM * ldc);
        const char* sbb = (const char*)(sb + (size_t)pm * BM * ldc); char* dbb = (char*)(db + (size_t)pm * BM * ldc); char* dfb = (char*)(df + (size_t)pm * BM * ldc);
        float* sqb = ssq + (size_t)pm * BM * 64 + 4 * u.pn + wc;
        const int rloc0 = wr * 64 + fr; const unsigned col0 = (unsigned)(u.pn * BM + wc * 32 + 8 * fq);
#pragma unroll
        for (int ai = 0; ai < 2; ++ai) {
            f32x4 hf[SRC == 0 ? 4 : 1][2][2]; u32x4 hw[SRC == 1 ? 4 : 1][2];
            if constexpr (SRC != 2)
#pragma unroll
            for (int m = 0; m < 4; ++m) { const unsigned eoff = (unsigned)(rloc0 + ai * HALF + m * 16) * (unsigned)ldc + col0;
#pragma unroll
                for (int bj = 0; bj < 2; ++bj) {
                    if constexpr (SRC == 0) { hf[m][bj][0] = *(const f32x4*)(sfb + (eoff + bj * HALF) * 4u); hf[m][bj][1] = *(const f32x4*)(sfb + (eoff + bj * HALF + 4) * 4u); }
                    else hw[m][bj] = *(const u32x4*)(sbb + (eoff + bj * HALF) * 2u); } }
#pragma unroll
            for (int m = 0; m < 4; ++m) { const int rloc = rloc0 + ai * HALF + m * 16; const unsigned eoff = (unsigned)rloc * (unsigned)ldc + col0;
                float sq = 0.f;
#pragma unroll
                for (int bj = 0; bj < 2; ++bj) { f32x4 h0, h1;
                    if constexpr (SRC == 0) { h0 = hf[m][bj][0]; h1 = hf[m][bj][1]; }
                    else if constexpr (SRC == 2) { h0 = (f32x4){0.f, 0.f, 0.f, 0.f}; h1 = h0; }
                    else { const u32x4 w = hw[m][bj]; h0 = (f32x4){bf_lo(w.x), bf_hi(w.x), bf_lo(w.y), bf_hi(w.y)}; h1 = (f32x4){bf_lo(w.z), bf_hi(w.z), bf_lo(w.w), bf_hi(w.w)}; }
                    h0 = h0 + acc[ai][bj][m][0] * alpha; h1 = h1 + acc[ai][bj][m][1] * alpha;
                    if constexpr (DST == 1) sq += ((h0[0] * h0[0] + h0[1] * h0[1]) + (h0[2] * h0[2] + h0[3] * h0[3])) + ((h1[0] * h1[0] + h1[1] * h1[1]) + (h1[2] * h1[2] + h1[3] * h1[3]));
                    if constexpr (DST == 0) { *(f32x4*)(dfb + (eoff + bj * HALF) * 4u) = h0; *(f32x4*)(dfb + (eoff + bj * HALF + 4) * 4u) = h1; }
                    else { u32x4 w; w.x = cvt_pk_bf16(h0[0], h0[1]); w.y = cvt_pk_bf16(h0[2], h0[3]); w.z = cvt_pk_bf16(h1[0], h1[1]); w.w = cvt_pk_bf16(h1[2], h1[3]);
                        *(u32x4*)(dbb + (eoff + bj * HALF) * 2u) = w; } }
                if constexpr (DST == 1) { sq += __shfl_xor(sq, 16); sq += __shfl_xor(sq, 32);
                    if (fq == 0) sqb[(unsigned)rloc * 64u] = sq; } }
            asm volatile("" ::: "memory"); }
    }
};

template <class Epi, class Sched, bool ALIGN_EPI = false, bool SP2 = false>
__device__ __forceinline__ void gemm_phase(PG8_LAS unsigned char* lds, const Gemm g, const Sched& S, const Epi& E, const int wave_) {
    const int wid = wave_, lane = pg8_lane_now(), tid = wid * 64 + lane, wr = wid >> 2, wc = wid & 3, fr = lane & 15, fq = lane >> 4;
    const int K = g.K, nt = K / BK;
    unsigned voffA[2], voffB[2];
#pragma unroll
    for (int i = 0; i < 2; ++i) { int R, C; stage_rc(tid * 16 + i * 8192, R, C); const int Rb = Epi::PERM ? ((R & ~31) + perm32(R & 31)) : R;
        voffA[i] = (unsigned)(R * K + C) * 2u; voffB[i] = (unsigned)(Rb * K + C) * 2u; }
    const size_t kstep = (size_t)(BK * 2);
    const size_t hstep = (size_t)HALF * K * 2;
    const size_t tstep = 2 * hstep;
    const unsigned ldsw = (unsigned)wid * 1024u;
    const int aoff = lds_byte(wr * 64 + fr, fq * 8), boff = lds_byte(wc * 32 + fr, fq * 8);
#define PG8_SA(b, h) (((b) * 2 + (h)) * HTB)
#define PG8_SB(b, h) ((4 + (b) * 2 + (h)) * HTB)
#define PG8_STAGE(bufoff, gbase, voff) do { _Pragma("unroll") for (int _i = 0; _i < 2; ++_i) \
        __builtin_amdgcn_global_load_lds((const unsigned*)((const char*)(gbase) + (voff)[_i]), (PG8_LAS unsigned*)(lds + (bufoff) + ldsw + _i * 8192), 16, 0, 0); } while (0)
#define PG8_LDA(dst, b, h) do { _Pragma("unroll") for (int m = 0; m < 4; ++m) _Pragma("unroll") for (int k = 0; k < 2; ++k) dst[m][k] = *(const PG8_LAS bf16x8*)(lds + PG8_SA(b, h) + aoff + m * 2048 + k * 1024); } while (0)
#define PG8_LDB(dst, b, h) do { _Pragma("unroll") for (int n = 0; n < 2; ++n) _Pragma("unroll") for (int k = 0; k < 2; ++k) dst[n][k] = *(const PG8_LAS bf16x8*)(lds + PG8_SB(b, h) + boff + n * 2048 + k * 1024); } while (0)
#define PG8_MMA(ai, bj, At, Bt) do { __builtin_amdgcn_s_setprio(1); _Pragma("unroll") for (int m = 0; m < 4; ++m) _Pragma("unroll") for (int n = 0; n < 2; ++n) _Pragma("unroll") for (int k = 0; k < 2; ++k) \
        acc[ai][bj][m][n] = __builtin_amdgcn_mfma_f32_16x16x32_bf16(Bt[n][k], At[m][k], acc[ai][bj][m][n], 0, 0, 0); __builtin_amdgcn_s_setprio(0); } while (0)
#define PG8_WAIT_V(n) asm volatile("s_waitcnt vmcnt(" #n ")" ::: "memory")
#define PG8_WAIT_L(n) asm volatile("s_waitcnt lgkmcnt(" #n ")" ::: "memory")
#define PG8_BAR __builtin_amdgcn_s_barrier()
#define PG8_SCHED __builtin_amdgcn_sched_barrier(0)
    Unit cur, nxt; int ui = 0;
    if (!S.next(0, cur)) return;
    f32x4 acc[2][2][4][2];
#pragma unroll
    for (int a = 0; a < 2; ++a)
#pragma unroll
        for (int b = 0; b < 2; ++b)
#pragma unroll
            for (int m = 0; m < 4; ++m)
#pragma unroll
                for (int n = 0; n < 2; ++n) acc[a][b][m][n] = (f32x4){0.f, 0.f, 0.f, 0.f};
    bf16x8 At[4][2], B0[2][2], B1[2][2];
    const char* cA = (const char*)g.A + (size_t)cur.pm * tstep; const char* cB = (const char*)g.Bt + (size_t)cur.pn * tstep;
    S.a_ready(cur);
    if constexpr (SP2) {
        PG8_STAGE(PG8_SB(0, 0), cB, voffB); PG8_STAGE(PG8_SB(0, 1), cB + hstep, voffB); PG8_STAGE(PG8_SA(0, 0), cA, voffA); PG8_STAGE(PG8_SA(0, 1), cA + hstep, voffA);
        if (wr == 1) PG8_BAR;
        PG8_WAIT_V(2); PG8_BAR;
        PG8_STAGE(PG8_SB(1, 0), cB + kstep, voffB); PG8_STAGE(PG8_SA(1, 0), cA + kstep, voffA); PG8_STAGE(PG8_SB(1, 1), cB + hstep + kstep, voffB);
        PG8_WAIT_V(6); PG8_BAR;
    } else {
        PG8_STAGE(PG8_SB(0, 0), cB, voffB); PG8_STAGE(PG8_SA(0, 0), cA, voffA); PG8_STAGE(PG8_SB(0, 1), cB + hstep, voffB); PG8_STAGE(PG8_SA(0, 1), cA + hstep, voffA);
        if (wr == 1) PG8_BAR;
        PG8_WAIT_V(4); PG8_BAR;
        PG8_STAGE(PG8_SB(1, 0), cB + kstep, voffB); PG8_STAGE(PG8_SA(1, 0), cA + kstep, voffA); PG8_STAGE(PG8_SB(1, 1), cB + hstep + kstep, voffB);
        PG8_WAIT_V(6); PG8_BAR;
    }
    for (;;) {
        const bool has_next = S.next(ui + 1, nxt);
        const char* nA = has_next ? (const char*)g.A + (size_t)nxt.pm * tstep : cA; const char* nB = has_next ? (const char*)g.Bt + (size_t)nxt.pn * tstep : cB;
        for (int t = 0; t < nt; t += 2) {
            const bool last = (t == nt - 2);
            const char* a1 = cA + (size_t)(t + 1) * kstep;
            const char* a2 = last ? nA : cA + (size_t)(t + 2) * kstep; const char* b2 = last ? nB : cB + (size_t)(t + 2) * kstep;
            const char* a3 = a2 + kstep; const char* b3 = b2 + kstep;
            if (last && has_next) S.a_ready(nxt);
            if constexpr (SP2) {
            PG8_LDB(B0, 0, 0); PG8_LDB(B1, 0, 1); PG8_SCHED; PG8_LDA(At, 0, 0); PG8_STAGE(PG8_SA(1, 1), a1 + hstep, voffA);
            PG8_WAIT_V(8); PG8_WAIT_L(0); PG8_BAR; PG8_MMA(0, 0, At, B0); PG8_MMA(0, 1, At, B1); PG8_BAR; PG8_SCHED;
            PG8_LDA(At, 0, 1); PG8_STAGE(PG8_SB(0, 0), b2, voffB); PG8_STAGE(PG8_SB(0, 1), b2 + hstep, voffB); PG8_STAGE(PG8_SA(0, 0), a2, voffA);
            PG8_WAIT_V(8); PG8_WAIT_L(0); PG8_BAR; PG8_MMA(1, 0, At, B0); PG8_MMA(1, 1, At, B1); PG8_BAR; PG8_SCHED;
            PG8_LDB(B0, 1, 0); PG8_LDB(B1, 1, 1); PG8_SCHED; PG8_LDA(At, 1, 0); PG8_STAGE(PG8_SA(0, 1), a2 + hstep, voffA);
            PG8_WAIT_V(8); PG8_WAIT_L(0); PG8_BAR; PG8_MMA(0, 0, At, B0); PG8_MMA(0, 1, At, B1); PG8_BAR; PG8_SCHED;
            PG8_LDA(At, 1, 1); PG8_STAGE(PG8_SB(1, 0), b3, voffB); PG8_STAGE(PG8_SB(1, 1), b3 + hstep, voffB); PG8_STAGE(PG8_SA(1, 0), a3, voffA);
            PG8_WAIT_V(8); PG8_WAIT_L(0); PG8_BAR; PG8_MMA(1, 0, At, B0); PG8_MMA(1, 1, At, B1); PG8_BAR; PG8_SCHED;
            } else {
            PG8_LDB(B0, 0, 0); PG8_SCHED; PG8_LDA(At, 0, 0); PG8_STAGE(PG8_SA(1, 1), a1 + hstep, voffA);
            PG8_WAIT_L(8); PG8_BAR; PG8_WAIT_L(0); PG8_MMA(0, 0, At, B0); PG8_BAR; PG8_SCHED;
            PG8_LDB(B1, 0, 1); PG8_STAGE(PG8_SB(0, 0), b2, voffB);
            PG8_BAR; PG8_WAIT_L(0); PG8_MMA(0, 1, At, B1); PG8_BAR;
            PG8_LDA(At, 0, 1); PG8_STAGE(PG8_SA(0, 0), a2, voffA);
            PG8_BAR; PG8_WAIT_L(0); PG8_MMA(1, 0, At, B0); PG8_BAR; PG8_SCHED;
            PG8_STAGE(PG8_SB(0, 1), b2 + hstep, voffB);
            PG8_WAIT_V(6); PG8_BAR; PG8_MMA(1, 1, At, B1); PG8_BAR;
            PG8_LDB(B0, 1, 0); PG8_SCHED; PG8_LDA(At, 1, 0); PG8_STAGE(PG8_SA(0, 1), a2 + hstep, voffA);
            PG8_WAIT_L(8); PG8_BAR; PG8_WAIT_L(0); PG8_MMA(0, 0, At, B0); PG8_BAR; PG8_SCHED;
            PG8_LDB(B1, 1, 1); PG8_STAGE(PG8_SB(1, 0), b3, voffB);
            PG8_BAR; PG8_WAIT_L(0); PG8_MMA(0, 1, At, B1); PG8_BAR;
            PG8_LDA(At, 1, 1); PG8_STAGE(PG8_SA(1, 0), a3, voffA);
            PG8_BAR; PG8_WAIT_L(0); PG8_MMA(1, 0, At, B0); PG8_BAR; PG8_SCHED;
            PG8_STAGE(PG8_SB(1, 1), b3 + hstep, voffB);
            PG8_WAIT_V(6); PG8_BAR; PG8_MMA(1, 1, At, B1); PG8_BAR;
            }
        }
        if constexpr (ALIGN_EPI) { if (wr == 0) PG8_BAR; }
        if constexpr (!Epi::AFTER_DRAIN) { E(acc, cur, wr, wc, fr, fq); S.done(cur); }
        if (!has_next) break;
#pragma unroll
        for (int a = 0; a < 2; ++a)
#pragma unroll
            for (int b = 0; b < 2; ++b)
#pragma unroll
                for (int m = 0; m < 4; ++m)
#pragma unroll
                    for (int n = 0; n < 2; ++n) acc[a][b][m][n] = (f32x4){0.f, 0.f, 0.f, 0.f};
        cur = nxt; cA = nA; cB = nB; ++ui;
        if constexpr (ALIGN_EPI) { if (wr == 1) PG8_BAR; }
    }
    PG8_WAIT_V(0);
    if constexpr (!ALIGN_EPI) { if (wr == 0) PG8_BAR; }
    PG8_BAR;
    if constexpr (Epi::AFTER_DRAIN) { E.fused(acc, cur, wr, wc, fr, fq, lds, wid, lane); S.done(cur); }
#undef PG8_SA
#undef PG8_SB
#undef PG8_STAGE
#undef PG8_LDA
#undef PG8_LDB
#undef PG8_MMA
#undef PG8_WAIT_V
#undef PG8_WAIT_L
#undef PG8_BAR
#undef PG8_SCHED
}
}

namespace att {
#define ATT_LAS __attribute__((address_space(3)))
typedef unsigned short bf16_t;
using bf16x8 = __attribute__((ext_vector_type(8))) short;
using s16x4  = __attribute__((ext_vector_type(4))) short;
using f32x16 = __attribute__((ext_vector_type(16))) float;
using u32x4  = __attribute__((ext_vector_type(4))) unsigned;
constexpr int   D = 128, NW = 8, QBLK = 32, KVBLK = 64;
constexpr float SCALE = 0.088388347648318440f;
constexpr float THR = 8.f;
constexpr float NEG = -1.0e30f;
constexpr int   LD = 12288;
constexpr int   META_ROW = 24576;
constexpr int   SHM_V = KVBLK * D * 2, SHM_K = KVBLK * D * 2, SHM_ATTN = 2 * SHM_V + 2 * SHM_K + NW * 64 * 4;
#define KSWZ(row, colB) ((row) * 256 + ((colB) ^ (((row) & 7) << 4)))
#define SBAR() __builtin_amdgcn_sched_barrier(0)
__device__ __forceinline__ int crow(int r, int hi) { return (r & 3) + 8 * (r >> 2) + 4 * hi; }
__device__ __forceinline__ int lane_of() { int l; asm volatile("v_mbcnt_lo_u32_b32 %0, -1, 0\n\tv_mbcnt_hi_u32_b32 %0, -1, %0" : "=v"(l)); return l; }
__device__ __forceinline__ unsigned cvtpk(float lo, float hi) { unsigned r; asm volatile("v_cvt_pk_bf16_f32 %0, %1, %2" : "=v"(r) : "v"(lo), "v"(hi)); return r; }

struct NaCtx { int qrow, r0, kr_first, c, c0; const ATT_LAS float* rpb; };

__device__ __forceinline__ void partialSM(f32x16& p0, f32x16& p1, float& m_reg, float& mn, float& alpha) {
  constexpr float C = SCALE * 1.4426950408889634f;
  float pmax = p0[0];
#pragma unroll
  for (int r = 1; r < 16; ++r) pmax = fmaxf(pmax, p0[r]);
#pragma unroll
  for (int r = 0; r < 16; ++r) pmax = fmaxf(pmax, p1[r]);
  { auto rr = __builtin_amdgcn_permlane32_swap(__float_as_uint(pmax), __float_as_uint(pmax), false, false);
    pmax = fmaxf(__uint_as_float(rr[0]), __uint_as_float(rr[1])); }
  if (__builtin_expect(__all(pmax - m_reg <= THR / SCALE), 1)) { mn = m_reg; alpha = 1.f; }
  else { mn = fmaxf(m_reg, pmax); alpha = __builtin_amdgcn_exp2f((m_reg - mn) * C); m_reg = mn; }
  float mnC = -mn * C;
#pragma unroll
  for (int r = 0; r < 16; ++r) p0[r] = fmaf(p0[r], C, mnC);
#pragma unroll
  for (int r = 0; r < 16; ++r) p1[r] = fmaf(p1[r], C, mnC);
#pragma unroll
  for (int r = 0; r < 16; ++r) p0[r] = __builtin_amdgcn_exp2f(p0[r]);
}
__device__ __forceinline__ void finishSM(f32x16& p0, f32x16& p1, float alpha, float& l_reg, bf16x8& pa0, bf16x8& pa1, bf16x8& pa2, bf16x8& pa3) {
#pragma unroll
  for (int r = 0; r < 16; ++r) p1[r] = __builtin_amdgcn_exp2f(p1[r]);
  float ps = 0;
#pragma unroll
  for (int r = 0; r < 16; ++r) ps += p0[r];
#pragma unroll
  for (int r = 0; r < 16; ++r) ps += p1[r];
  { auto rr = __builtin_amdgcn_permlane32_swap(__float_as_uint(ps), __float_as_uint(ps), false, false);
    ps = __uint_as_float(rr[0]) + __uint_as_float(rr[1]); }
  l_reg = l_reg * alpha + ps;
#define PK4(P, BASE, OUT) do { unsigned a0 = cvtpk(P[BASE + 0], P[BASE + 1]), a1 = cvtpk(P[BASE + 2], P[BASE + 3]);   \
    unsigned b0 = cvtpk(P[BASE + 4], P[BASE + 5]), b1 = cvtpk(P[BASE + 6], P[BASE + 7]);                              \
    auto r0 = __builtin_amdgcn_permlane32_swap(a0, b0, false, false); auto r1 = __builtin_amdgcn_permlane32_swap(a1, b1, false, false); \
    u32x4 w = {r0[0], r1[0], r0[1], r1[1]}; OUT = *reinterpret_cast<bf16x8*>(&w); } while (0)
  PK4(p0, 0, pa0); PK4(p0, 8, pa1); PK4(p1, 0, pa2); PK4(p1, 8, pa3);
#undef PK4
}
__device__ __forceinline__ void qkt(f32x16& p0, f32x16& p1, const ATT_LAS char* Ks, const bf16x8* qr, int r32, int hi) {
  p0 = f32x16{}; p1 = f32x16{};
#pragma unroll
  for (int d0 = 0; d0 < 8; ++d0) { int cb = (d0 * 16 + hi * 8) * 2;
    bf16x8 b0 = *reinterpret_cast<const ATT_LAS bf16x8*>(Ks + KSWZ(r32, cb));
    bf16x8 b1 = *reinterpret_cast<const ATT_LAS bf16x8*>(Ks + KSWZ(32 + r32, cb));
    p0 = __builtin_amdgcn_mfma_f32_32x32x16_bf16(b0, qr[d0], p0, 0, 0, 0);
    p1 = __builtin_amdgcn_mfma_f32_32x32x16_bf16(b1, qr[d0], p1, 0, 0, 0); }
}
__device__ __forceinline__ int v_st(int k, int c) { const int kk = (k & ~0xC) | ((k & 4) << 1) | ((k & 8) >> 1); return ((kk >> 3) * 4 + (c >> 5)) * 512 + ((kk & 7) * 32 + (c & 31)) * 2; }
__device__ __forceinline__ int v_rd_base(int lane) { return ((lane & 3) << 3) | (((lane >> 2) & 3) << 6) | (((lane >> 4) & 1) << 5) | (((lane >> 5) & 1) << 8); }
constexpr int v_rd_off(int d0, int ks, int half) { return d0 * 512 + ks * 4096 + half * 2048; }
template <int OFF> __device__ __forceinline__ s16x4 tr_read(int vb) {
  s16x4 r; asm volatile("ds_read_b64_tr_b16 %0, %1 offset:%2" : "=&v"(r) : "v"(vb), "i"(OFF) : "memory"); return r;
}
template <int D0> __device__ __forceinline__ void pv_one(f32x16& od, int vb, bf16x8 pa0, bf16x8 pa1, bf16x8 pa2, bf16x8 pa3) {
  const s16x4 l0 = tr_read<v_rd_off(D0, 0, 0)>(vb), h0 = tr_read<v_rd_off(D0, 0, 1)>(vb), l1 = tr_read<v_rd_off(D0, 1, 0)>(vb), h1 = tr_read<v_rd_off(D0, 1, 1)>(vb);
  const s16x4 l2 = tr_read<v_rd_off(D0, 2, 0)>(vb), h2 = tr_read<v_rd_off(D0, 2, 1)>(vb), l3 = tr_read<v_rd_off(D0, 3, 0)>(vb), h3 = tr_read<v_rd_off(D0, 3, 1)>(vb);
  asm volatile("s_waitcnt lgkmcnt(0)" ::: "memory"); SBAR();
#define PK(L, H) (bf16x8){L[0], L[1], L[2], L[3], H[0], H[1], H[2], H[3]}
  od = __builtin_amdgcn_mfma_f32_32x32x16_bf16(pa0, PK(l0, h0), od, 0, 0, 0);
  od = __builtin_amdgcn_mfma_f32_32x32x16_bf16(pa1, PK(l1, h1), od, 0, 0, 0);
  od = __builtin_amdgcn_mfma_f32_32x32x16_bf16(pa2, PK(l2, h2), od, 0, 0, 0);
  od = __builtin_amdgcn_mfma_f32_32x32x16_bf16(pa3, PK(l3, h3), od, 0, 0, 0);
#undef PK
}
__device__ __forceinline__ void pv_d0(f32x16* o, int vb, bf16x8 pa0, bf16x8 pa1, bf16x8 pa2, bf16x8 pa3) {
  pv_one<0>(o[0], vb, pa0, pa1, pa2, pa3); pv_one<1>(o[1], vb, pa0, pa1, pa2, pa3); pv_one<2>(o[2], vb, pa0, pa1, pa2, pa3); pv_one<3>(o[3], vb, pa0, pa1, pa2, pa3);
}
template <bool IS_NA> __device__ __forceinline__ void mask_tile(f32x16& p0, f32x16& p1, int j, const NaCtx& na, int hi) {
  if constexpr (IS_NA) {
    const int kr = na.kr_first + (j - 1);
    if ((unsigned)(kr - na.r0) >= 8u) {
#pragma unroll
      for (int r = 0; r < 16; ++r) { p0[r] = NEG; p1[r] = NEG; }
    } else {
      const ATT_LAS float* rb = na.rpb + (kr - na.qrow + 7) * 31 + 15 - na.c + 4 * hi;
      const int dbase = 4 * hi - na.c0;
#pragma unroll
      for (int r = 0; r < 16; ++r) { const int kc = (r & 3) + 8 * (r >> 2);
        const float b0 = rb[kc], b1 = rb[kc + 32];
        p0[r] = ((unsigned)(kc + dbase) < 16u) ? p0[r] + b0 : NEG;
        p1[r] = ((unsigned)(kc + 32 + dbase) < 16u) ? p1[r] + b1 : NEG; }
    }
  }
}

typedef __amdgpu_buffer_rsrc_t rsrc_t;
__device__ __forceinline__ bf16x8 bld(rsrc_t rs, unsigned voff, unsigned soff) { auto v = __builtin_amdgcn_raw_buffer_load_b128(rs, (int)voff, (int)soff, 0); return __builtin_bit_cast(bf16x8, v); }
template <bool IS_NA>
__device__ __forceinline__ void attn_run(const rsrc_t rs, const unsigned qoffB  , const unsigned kcolB, const unsigned vcolB  ,
                                         const int krow1, const int NT, ATT_LAS char* lds, const NaCtx na, f32x16 (&o)[4], const int wid  ) {
  const int lane = lane_of(), tid = wid * 64 + lane, r32 = lane & 31, hi = lane >> 5;
  ATT_LAS char* V_lds = lds; ATT_LAS char* K_lds = lds + 2 * SHM_V;
  ATT_LAS float* wsf = (ATT_LAS float*)(lds + 2 * SHM_V + 2 * SHM_K) + wid * 64; ATT_LAS float* li_l = wsf; ATT_LAS float* al_l = wsf + 32;
  float m_reg = NEG, l_reg = 0; bf16x8 qr[8];
#pragma unroll
  for (int d = 0; d < 4; ++d) o[d] = f32x16{};
  { const unsigned qv = (unsigned)((wid * QBLK + r32) * LD + hi * 8) * 2u;
#pragma unroll
    for (int d0 = 0; d0 < 8; ++d0) qr[d0] = bld(rs, qv + d0 * 32, qoffB); }
  const int sr = tid >> 4, sc = (tid & 15) * 8, vst0 = v_st(sr, sc), vst1 = v_st(32 + sr, sc);
  const int vb0 = (int)(unsigned)(uintptr_t)V_lds + v_rd_base(lane);
  struct { bf16x8 vs0, vs1, ks0, ks1; } sr_[2];
#define TROW(j) ((j) == 0 ? META_ROW : krow1 + ((j) - 1) * KVBLK)
  const unsigned stv = (unsigned)(sr * LD + sc) * 2u;
#define SLOAD(i, j) do { const unsigned t0_ = (unsigned)TROW(j) * (unsigned)(LD * 2); sr_[i].vs0 = bld(rs, stv, t0_ + vcolB); sr_[i].vs1 = bld(rs, stv, t0_ + vcolB + 32u * LD * 2u); \
    sr_[i].ks0 = bld(rs, stv, t0_ + kcolB); sr_[i].ks1 = bld(rs, stv, t0_ + kcolB + 32u * LD * 2u); } while (0)
#define SWRITE(b, i) do { *(ATT_LAS bf16x8*)(V_lds + (b) * SHM_V + vst0) = sr_[i].vs0;          \
    *(ATT_LAS bf16x8*)(V_lds + (b) * SHM_V + vst1) = sr_[i].vs1; const int kc_ = sc * 2;               \
    *(ATT_LAS bf16x8*)(K_lds + (b) * SHM_K + KSWZ(sr, kc_)) = sr_[i].ks0;                       \
    *(ATT_LAS bf16x8*)(K_lds + (b) * SHM_K + KSWZ(32 + sr, kc_)) = sr_[i].ks1; } while (0)
#define SWAIT() asm volatile("s_waitcnt vmcnt(4)" ::: "memory")
#define RESC(a) do { if (__any((a) < 1.f)) { if (hi == 0) al_l[r32] = (a); asm volatile("s_waitcnt lgkmcnt(0)" ::: "memory"); \
    _Pragma("unroll") for (int d = 0; d < 4; ++d) _Pragma("unroll") for (int r = 0; r < 16; ++r) o[d][r] *= al_l[crow(r, hi)]; } } while (0)
  f32x16 pA0, pA1, pB0, pB1; float mnA, mnB, alA, alB; bf16x8 pa0, pa1, pa2, pa3;
  constexpr int SE = 0, SO = 1;
  __syncthreads();
  SLOAD(SE, 0); asm volatile("s_waitcnt vmcnt(0)" ::: "memory"); SWRITE(0, SE); __syncthreads();
  qkt(pA0, pA1, K_lds, qr, r32, hi);
#pragma unroll
  for (int r = 8; r < 16; ++r) pA0[r] = NEG;
#pragma unroll
  for (int r = 0; r < 16; ++r) pA1[r] = NEG;
  partialSM(pA0, pA1, m_reg, mnA, alA);
  SLOAD(SO, 1); if (2 < NT) SLOAD(SE, 2);
  SWAIT(); SWRITE(1, SO); __syncthreads();
  for (int j = 1; j + 2 < NT; j += 2) {
    SBAR(); qkt(pB0, pB1, K_lds + SHM_K, qr, r32, hi);
    finishSM(pA0, pA1, alA, l_reg, pa0, pa1, pa2, pa3); SBAR();
    if (j + 2 < NT) SLOAD(SO, j + 2); SBAR();
    pv_d0(o, vb0, pa0, pa1, pa2, pa3); mask_tile<IS_NA>(pB0, pB1, j, na, hi); partialSM(pB0, pB1, m_reg, mnB, alB);
    __syncthreads(); SWAIT(); SWRITE(0, SE);
    RESC(alB); __syncthreads();
    SBAR(); qkt(pA0, pA1, K_lds, qr, r32, hi);
    finishSM(pB0, pB1, alB, l_reg, pa0, pa1, pa2, pa3); SBAR();
    if (j + 3 < NT) SLOAD(SE, j + 3); SBAR();
    pv_d0(o, vb0 + SHM_V, pa0, pa1, pa2, pa3); mask_tile<IS_NA>(pA0, pA1, j + 1, na, hi); partialSM(pA0, pA1, m_reg, mnA, alA);
    __syncthreads(); SWAIT(); if (j + 2 < NT) SWRITE(1, SO);
    RESC(alA); __syncthreads();
  }
  SBAR(); qkt(pB0, pB1, K_lds + SHM_K, qr, r32, hi);
  finishSM(pA0, pA1, alA, l_reg, pa0, pa1, pa2, pa3); SBAR();
  pv_d0(o, vb0, pa0, pa1, pa2, pa3); mask_tile<IS_NA>(pB0, pB1, NT - 1, na, hi); partialSM(pB0, pB1, m_reg, mnB, alB);
  RESC(alB);
  finishSM(pB0, pB1, alB, l_reg, pa0, pa1, pa2, pa3); SBAR();
  pv_d0(o, vb0 + SHM_V, pa0, pa1, pa2, pa3);
  if (hi == 0) li_l[r32] = l_reg; asm volatile("s_waitcnt lgkmcnt(0)" ::: "memory");
#pragma unroll
  for (int r = 0; r < 16; ++r) { const float rl = __builtin_amdgcn_rcpf(li_l[crow(r, hi)]);
#pragma unroll
    for (int d = 0; d < 4; ++d) o[d][r] *= rl; }
#undef TROW
#undef SLOAD
#undef SWRITE
#undef SWAIT
#undef RESC
}
__device__ __forceinline__ float half_sum(float v) {
#pragma unroll
  for (int o = 1; o < 32; o <<= 1) v += __shfl_xor(v, o);
  return v;
}
}


namespace att2 {
using namespace att;
constexpr int KB = 16384, VB = 32768;
constexpr int L_K = 0, L_V = 2 * KB, L_WS = 2 * KB + 2 * VB, SHM2 = L_WS + NW * 64 * 4;
__device__ __forceinline__ void dma16(const rsrc_t rs, ATT_LAS char* dst, unsigned voff, unsigned soff) { __builtin_amdgcn_raw_ptr_buffer_load_lds(rs, (ATT_LAS void*)dst, 16, (int)voff, (int)soff, 0, 0); }
#define WAITBAR(N) asm volatile("s_waitcnt vmcnt(" #N ") lgkmcnt(0)\n\ts_barrier" ::: "memory")
template <int D0, int VH> __device__ __forceinline__ void pv_one2(f32x16& od, int vb, bf16x8 pa0, bf16x8 pa1, bf16x8 pa2, bf16x8 pa3) {
  constexpr int B = VH * 16384;
  const s16x4 l0 = tr_read<B + v_rd_off(D0, 0, 0)>(vb), h0 = tr_read<B + v_rd_off(D0, 0, 1)>(vb), l1 = tr_read<B + v_rd_off(D0, 1, 0)>(vb), h1 = tr_read<B + v_rd_off(D0, 1, 1)>(vb);
  const s16x4 l2 = tr_read<B + v_rd_off(D0, 2, 0)>(vb), h2 = tr_read<B + v_rd_off(D0, 2, 1)>(vb), l3 = tr_read<B + v_rd_off(D0, 3, 0)>(vb), h3 = tr_read<B + v_rd_off(D0, 3, 1)>(vb);
  asm volatile("s_waitcnt lgkmcnt(0)" ::: "memory"); SBAR();
#define PK(L, H) (bf16x8){L[0], L[1], L[2], L[3], H[0], H[1], H[2], H[3]}
  od = __builtin_amdgcn_mfma_f32_32x32x16_bf16(pa0, PK(l0, h0), od, 0, 0, 0);
  od = __builtin_amdgcn_mfma_f32_32x32x16_bf16(pa1, PK(l1, h1), od, 0, 0, 0);
  od = __builtin_amdgcn_mfma_f32_32x32x16_bf16(pa2, PK(l2, h2), od, 0, 0, 0);
  od = __builtin_amdgcn_mfma_f32_32x32x16_bf16(pa3, PK(l3, h3), od, 0, 0, 0);
#undef PK
}
__device__ __forceinline__ void pv8(f32x16* o, int vb, bf16x8 pa0, bf16x8 pa1, bf16x8 pa2, bf16x8 pa3) {
  pv_one2<0, 0>(o[0], vb, pa0, pa1, pa2, pa3); pv_one2<1, 0>(o[1], vb, pa0, pa1, pa2, pa3); pv_one2<2, 0>(o[2], vb, pa0, pa1, pa2, pa3); pv_one2<3, 0>(o[3], vb, pa0, pa1, pa2, pa3);
  pv_one2<0, 1>(o[4], vb, pa0, pa1, pa2, pa3); pv_one2<1, 1>(o[5], vb, pa0, pa1, pa2, pa3); pv_one2<2, 1>(o[6], vb, pa0, pa1, pa2, pa3); pv_one2<3, 1>(o[7], vb, pa0, pa1, pa2, pa3);
}
template <int BASE> __device__ __forceinline__ bf16x8 pk4t(const f32x16& P) {
  unsigned a0 = cvtpk(P[BASE + 0], P[BASE + 1]), a1 = cvtpk(P[BASE + 2], P[BASE + 3]), b0 = cvtpk(P[BASE + 4], P[BASE + 5]), b1 = cvtpk(P[BASE + 6], P[BASE + 7]);
  auto r0 = __builtin_amdgcn_permlane32_swap(a0, b0, false, false); auto r1 = __builtin_amdgcn_permlane32_swap(a1, b1, false, false);
  u32x4 w = {r0[0], r1[0], r0[1], r1[1]}; return *reinterpret_cast<bf16x8*>(&w);
}
#define TRV(D, KS, HF) tr_read<((D) >> 2) * 16384 + v_rd_off((D) & 3, KS, HF)>(vb)
#define PKF(L, H) (bf16x8){L[0], L[1], L[2], L[3], H[0], H[1], H[2], H[3]}
#define RD2(S, KS, D) do { S##l0 = TRV((D), KS, 0); S##h0 = TRV((D), KS, 1); S##l1 = TRV((D) + 1, KS, 0); S##h1 = TRV((D) + 1, KS, 1); } while (0)
#define GAPV(OD, PA, L, H, STMT) do { OD = __builtin_amdgcn_mfma_f32_32x32x16_bf16(PA, PKF(L, H), OD, 0, 0, 0); STMT SBAR(); } while (0)
__device__ __forceinline__ void pv8_softmax(f32x16* o, const int vb, bf16x8& pa0, bf16x8& pa1, bf16x8& pa2, const bf16x8 pa3, f32x16& p0, f32x16& p1, float& m_reg, float& al, float& ps) {
  constexpr float CSM = SCALE * 1.4426950408889634f;
  s16x4 Al0, Ah0, Al1, Ah1, Bl0, Bh0, Bl1, Bh1; float pm, mn, mnC;
  RD2(A, 0, 0); SBAR();
  asm volatile("s_waitcnt lgkmcnt(0)" ::: "memory"); SBAR();
  RD2(B, 0, 2); SBAR();
  GAPV(o[0], pa0, Al0, Ah0, pm = fmaxf(p0[0], p0[1]); pm = fmaxf(pm, p0[2]); pm = fmaxf(pm, p0[3]); pm = fmaxf(pm, p0[4]); pm = fmaxf(pm, p0[5]); asm volatile("" : "+v"(pm)););
  GAPV(o[1], pa0, Al1, Ah1, pm = fmaxf(pm, p0[6]); pm = fmaxf(pm, p0[7]); pm = fmaxf(pm, p0[8]); pm = fmaxf(pm, p0[9]); pm = fmaxf(pm, p0[10]); pm = fmaxf(pm, p0[11]); asm volatile("" : "+v"(pm)););
  asm volatile("s_waitcnt lgkmcnt(0)" ::: "memory"); SBAR();
  RD2(A, 0, 4); SBAR();
  GAPV(o[2], pa0, Bl0, Bh0, pm = fmaxf(pm, p0[12]); pm = fmaxf(pm, p0[13]); pm = fmaxf(pm, p0[14]); pm = fmaxf(pm, p0[15]); pm = fmaxf(pm, p1[0]); pm = fmaxf(pm, p1[1]); asm volatile("" : "+v"(pm)););
  GAPV(o[3], pa0, Bl1, Bh1, pm = fmaxf(pm, p1[2]); pm = fmaxf(pm, p1[3]); pm = fmaxf(pm, p1[4]); pm = fmaxf(pm, p1[5]); pm = fmaxf(pm, p1[6]); pm = fmaxf(pm, p1[7]); asm volatile("" : "+v"(pm)););
  asm volatile("s_waitcnt lgkmcnt(0)" ::: "memory"); SBAR();
  RD2(B, 0, 6); SBAR();
  GAPV(o[4], pa0, Al0, Ah0, pm = fmaxf(pm, p1[8]); pm = fmaxf(pm, p1[9]); pm = fmaxf(pm, p1[10]); pm = fmaxf(pm, p1[11]); pm = fmaxf(pm, p1[12]); pm = fmaxf(pm, p1[13]); asm volatile("" : "+v"(pm)););
  GAPV(o[5], pa0, Al1, Ah1, pm = fmaxf(pm, p1[14]); pm = fmaxf(pm, p1[15]); { auto rr_ = __builtin_amdgcn_permlane32_swap(__float_as_uint(pm), __float_as_uint(pm), false, false); pm = fmaxf(__uint_as_float(rr_[0]), __uint_as_float(rr_[1])); } asm volatile("" : "+v"(pm)););
  asm volatile("s_waitcnt lgkmcnt(0)" ::: "memory"); SBAR();
  RD2(A, 1, 0); SBAR();
  GAPV(o[6], pa0, Bl0, Bh0, if (__builtin_expect(__all(pm - m_reg <= THR / SCALE), 1)) { mn = m_reg; al = 1.f; } else { mn = fmaxf(m_reg, pm); al = __builtin_amdgcn_exp2f((m_reg - mn) * CSM); m_reg = mn; } mnC = -mn * CSM; asm volatile("" : "+v"(mnC)); asm volatile("" : "+v"(al)););
  GAPV(o[7], pa0, Bl1, Bh1, p0[0] = fmaf(p0[0], CSM, mnC); p0[1] = fmaf(p0[1], CSM, mnC); p0[2] = fmaf(p0[2], CSM, mnC); p0[3] = fmaf(p0[3], CSM, mnC); p0[4] = fmaf(p0[4], CSM, mnC); p0[5] = fmaf(p0[5], CSM, mnC); asm volatile("" : "+v"(p0)););
  asm volatile("s_waitcnt lgkmcnt(0)" ::: "memory"); SBAR();
  RD2(B, 1, 2); SBAR();
  GAPV(o[0], pa1, Al0, Ah0, p0[6] = fmaf(p0[6], CSM, mnC); p0[7] = fmaf(p0[7], CSM, mnC); p0[8] = fmaf(p0[8], CSM, mnC); p0[9] = fmaf(p0[9], CSM, mnC); p0[10] = fmaf(p0[10], CSM, mnC); p0[11] = fmaf(p0[11], CSM, mnC); asm volatile("" : "+v"(p0)););
  GAPV(o[1], pa1, Al1, Ah1, p0[12] = fmaf(p0[12], CSM, mnC); p0[13] = fmaf(p0[13], CSM, mnC); p0[14] = fmaf(p0[14], CSM, mnC); p0[15] = fmaf(p0[15], CSM, mnC); p1[0] = fmaf(p1[0], CSM, mnC); p1[1] = fmaf(p1[1], CSM, mnC); asm volatile("" : "+v"(p0)); asm volatile("" : "+v"(p1)););
  asm volatile("s_waitcnt lgkmcnt(0)" ::: "memory"); SBAR();
  RD2(A, 1, 4); SBAR();
  GAPV(o[2], pa1, Bl0, Bh0, p1[2] = fmaf(p1[2], CSM, mnC); p1[3] = fmaf(p1[3], CSM, mnC); p1[4] = fmaf(p1[4], CSM, mnC); p1[5] = fmaf(p1[5], CSM, mnC); p1[6] = fmaf(p1[6], CSM, mnC); p1[7] = fmaf(p1[7], CSM, mnC); asm volatile("" : "+v"(p1)););
  GAPV(o[3], pa1, Bl1, Bh1, p1[8] = fmaf(p1[8], CSM, mnC); p1[9] = fmaf(p1[9], CSM, mnC); p1[10] = fmaf(p1[10], CSM, mnC); p1[11] = fmaf(p1[11], CSM, mnC); p1[12] = fmaf(p1[12], CSM, mnC); p1[13] = fmaf(p1[13], CSM, mnC); asm volatile("" : "+v"(p1)););
  asm volatile("s_waitcnt lgkmcnt(0)" ::: "memory"); SBAR();
  RD2(B, 1, 6); SBAR();
  GAPV(o[4], pa1, Al0, Ah0, p1[14] = fmaf(p1[14], CSM, mnC); p1[15] = fmaf(p1[15], CSM, mnC); asm volatile("" : "+v"(p1)););
  GAPV(o[5], pa1, Al1, Ah1, p0[0] = __builtin_amdgcn_exp2f(p0[0]); p0[1] = __builtin_amdgcn_exp2f(p0[1]); p0[2] = __builtin_amdgcn_exp2f(p0[2]); asm volatile("" : "+v"(p0)););
  asm volatile("s_waitcnt lgkmcnt(0)" ::: "memory"); SBAR();
  RD2(A, 2, 0); SBAR();
  GAPV(o[6], pa1, Bl0, Bh0, p0[3] = __builtin_amdgcn_exp2f(p0[3]); p0[4] = __builtin_amdgcn_exp2f(p0[4]); p0[5] = __builtin_amdgcn_exp2f(p0[5]); asm volatile("" : "+v"(p0)););
  GAPV(o[7], pa1, Bl1, Bh1, p0[6] = __builtin_amdgcn_exp2f(p0[6]); p0[7] = __builtin_amdgcn_exp2f(p0[7]); p0[8] = __builtin_amdgcn_exp2f(p0[8]); asm volatile("" : "+v"(p0)););
  asm volatile("s_waitcnt lgkmcnt(0)" ::: "memory"); SBAR();
  RD2(B, 2, 2); SBAR();
  GAPV(o[0], pa2, Al0, Ah0, p0[9] = __builtin_amdgcn_exp2f(p0[9]); p0[10] = __builtin_amdgcn_exp2f(p0[10]); p0[11] = __builtin_amdgcn_exp2f(p0[11]); asm volatile("" : "+v"(p0)););
  GAPV(o[1], pa2, Al1, Ah1, p0[12] = __builtin_amdgcn_exp2f(p0[12]); p0[13] = __builtin_amdgcn_exp2f(p0[13]); p0[14] = __builtin_amdgcn_exp2f(p0[14]); asm volatile("" : "+v"(p0)););
  asm volatile("s_waitcnt lgkmcnt(0)" ::: "memory"); SBAR();
  RD2(A, 2, 4); SBAR();
  GAPV(o[2], pa2, Bl0, Bh0, p0[15] = __builtin_amdgcn_exp2f(p0[15]); p1[0] = __builtin_amdgcn_exp2f(p1[0]); p1[1] = __builtin_amdgcn_exp2f(p1[1]); asm volatile("" : "+v"(p0)); asm volatile("" : "+v"(p1)););
  GAPV(o[3], pa2, Bl1, Bh1, p1[2] = __builtin_amdgcn_exp2f(p1[2]); p1[3] = __builtin_amdgcn_exp2f(p1[3]); p1[4] = __builtin_amdgcn_exp2f(p1[4]); asm volatile("" : "+v"(p1)););
  asm volatile("s_waitcnt lgkmcnt(0)" ::: "memory"); SBAR();
  RD2(B, 2, 6); SBAR();
  GAPV(o[4], pa2, Al0, Ah0, p1[5] = __builtin_amdgcn_exp2f(p1[5]); p1[6] = __builtin_amdgcn_exp2f(p1[6]); p1[7] = __builtin_amdgcn_exp2f(p1[7]); asm volatile("" : "+v"(p1)););
  GAPV(o[5], pa2, Al1, Ah1, p1[8] = __builtin_amdgcn_exp2f(p1[8]); p1[9] = __builtin_amdgcn_exp2f(p1[9]); p1[10] = __builtin_amdgcn_exp2f(p1[10]); asm volatile("" : "+v"(p1)););
  asm volatile("s_waitcnt lgkmcnt(0)" ::: "memory"); SBAR();
  RD2(A, 3, 0); SBAR();
  GAPV(o[6], pa2, Bl0, Bh0, p1[11] = __builtin_amdgcn_exp2f(p1[11]); p1[12] = __builtin_amdgcn_exp2f(p1[12]); p1[13] = __builtin_amdgcn_exp2f(p1[13]); asm volatile("" : "+v"(p1)););
  GAPV(o[7], pa2, Bl1, Bh1, p1[14] = __builtin_amdgcn_exp2f(p1[14]); p1[15] = __builtin_amdgcn_exp2f(p1[15]); asm volatile("" : "+v"(p1)););
  asm volatile("s_waitcnt lgkmcnt(0)" ::: "memory"); SBAR();
  RD2(B, 3, 2); SBAR();
  GAPV(o[0], pa3, Al0, Ah0, ps = p0[0] + p0[1]; ps += p0[2]; ps += p0[3]; ps += p0[4]; ps += p0[5]; ps += p0[6]; ps += p0[7]; asm volatile("" : "+v"(ps)););
  GAPV(o[1], pa3, Al1, Ah1, ps += p0[8]; ps += p0[9]; ps += p0[10]; ps += p0[11]; ps += p0[12]; ps += p0[13]; ps += p0[14]; ps += p0[15]; asm volatile("" : "+v"(ps)););
  asm volatile("s_waitcnt lgkmcnt(0)" ::: "memory"); SBAR();
  RD2(A, 3, 4); SBAR();
  GAPV(o[2], pa3, Bl0, Bh0, ps += p1[0]; ps += p1[1]; ps += p1[2]; ps += p1[3]; ps += p1[4]; ps += p1[5]; ps += p1[6]; ps += p1[7]; asm volatile("" : "+v"(ps)););
  GAPV(o[3], pa3, Bl1, Bh1, ps += p1[8]; ps += p1[9]; ps += p1[10]; ps += p1[11]; ps += p1[12]; ps += p1[13]; ps += p1[14]; ps += p1[15]; asm volatile("" : "+v"(ps)););
  asm volatile("s_waitcnt lgkmcnt(0)" ::: "memory"); SBAR();
  RD2(B, 3, 6); SBAR();
  GAPV(o[4], pa3, Al0, Ah0, pa0 = pk4t<0>(p0); asm volatile("" : "+v"(pa0)););
  GAPV(o[5], pa3, Al1, Ah1, pa1 = pk4t<8>(p0); asm volatile("" : "+v"(pa1)););
  asm volatile("s_waitcnt lgkmcnt(0)" ::: "memory"); SBAR();
  GAPV(o[6], pa3, Bl0, Bh0, pa2 = pk4t<0>(p1); asm volatile("" : "+v"(pa2)););
  GAPV(o[7], pa3, Bl1, Bh1, );
}
#undef TRV
#undef RD2
#undef GAPV
#undef PKF
__device__ __forceinline__ void finish_tail(const f32x16& p1, float ps, float alpha, float& l_reg, bf16x8& pa3) {
  { auto rr = __builtin_amdgcn_permlane32_swap(__float_as_uint(ps), __float_as_uint(ps), false, false); ps = __uint_as_float(rr[0]) + __uint_as_float(rr[1]); }
  l_reg = l_reg * alpha + ps;
  pa3 = pk4t<8>(p1);
}
__device__ __forceinline__ void diff_run(const rsrc_t rs, const unsigned qoffB, const unsigned kcolB, const unsigned vcolB  ,
                                         const int krow1, const int NT, ATT_LAS char* lds, f32x16 (&o)[8], float (&rli)[16], const int wid  ) {
  int lane = lane_of(); asm volatile("" : "+v"(lane));
  const int tid = wid * 64 + lane, r32 = lane & 31, hi = lane >> 5;
  ATT_LAS float* wsf = (ATT_LAS float*)(lds + L_WS) + wid * 64; ATT_LAS float* li_l = wsf; ATT_LAS float* al_l = wsf + 32;
  float m_reg = NEG, l_reg = 0; bf16x8 qr[8];
#pragma unroll
  for (int d = 0; d < 8; ++d) o[d] = f32x16{};
  { const unsigned qv = (unsigned)((wid * QBLK + r32) * LD + hi * 8) * 2u;
#pragma unroll
    for (int d0 = 0; d0 < 8; ++d0) qr[d0] = bld(rs, qv + d0 * 32, qoffB); }
  const unsigned kvo = (unsigned)((tid >> 4) * LD * 2 + (((tid & 15) ^ ((tid >> 4) & 7)) << 4));
  const int kkb = (tid >> 7) * 8 + ((tid & 31) >> 2), kbr = (kkb & ~0xC) | ((kkb & 4) << 1) | ((kkb & 8) >> 1);
  const unsigned vvo = (unsigned)(kbr * LD * 2 + ((((tid >> 5) & 3) * 32 + (tid & 3) * 8) << 1));
  ATT_LAS char* kd = lds + L_K + wid * 1024; ATT_LAS char* vd = lds + L_V + wid * 1024;
  constexpr unsigned R32 = 32u * LD * 2u;
#define TROW(j) ((j) == 0 ? META_ROW : krow1 + ((j) - 1) * KVBLK)
#define DMA_K(j, b) do { const unsigned t0_ = (unsigned)TROW(j) * (unsigned)(LD * 2) + kcolB; dma16(rs, kd + (b) * KB, kvo, t0_); dma16(rs, kd + (b) * KB + 8192, kvo, t0_ + R32); } while (0)
#define DMA_V(j, b) do { const unsigned t0_ = (unsigned)TROW(j) * (unsigned)(LD * 2) + vcolB; dma16(rs, vd + (b) * VB, vvo, t0_); dma16(rs, vd + (b) * VB + 8192, vvo, t0_ + R32); \
    dma16(rs, vd + (b) * VB + 16384, vvo, t0_ + 256u); dma16(rs, vd + (b) * VB + 24576, vvo, t0_ + R32 + 256u); } while (0)
#define RESC(a) do { if (__any((a) < 1.f)) { if (hi == 0) al_l[r32] = (a); asm volatile("s_waitcnt lgkmcnt(0)" ::: "memory"); \
    _Pragma("unroll") for (int d = 0; d < 8; ++d) _Pragma("unroll") for (int r = 0; r < 16; ++r) o[d][r] *= al_l[crow(r, hi)]; } } while (0)
  const int vb0 = (int)(unsigned)(uintptr_t)(lds + L_V) + v_rd_base(lane);
  f32x16 p0, p1; float mn, al; bf16x8 pa0, pa1, pa2, pa3;
  asm volatile("s_waitcnt vmcnt(0) lgkmcnt(0)" ::: "memory"); __builtin_amdgcn_s_barrier();
  DMA_K(0, 0); DMA_K(1, 1); DMA_V(0, 0);
  WAITBAR(6);
  {
    SBAR(); qkt(p0, p1, lds + L_K, qr, r32, hi);
#pragma unroll
    for (int r = 8; r < 16; ++r) p0[r] = NEG;
#pragma unroll
    for (int r = 0; r < 16; ++r) p1[r] = NEG;
    WAITBAR(6);
    { const int jn = 2 < NT ? 2 : NT - 1; DMA_K(jn, 0); }
    partialSM(p0, p1, m_reg, mn, al); finishSM(p0, p1, al, l_reg, pa0, pa1, pa2, pa3);
    WAITBAR(6);
    { const int jn = 1 < NT ? 1 : NT - 1; DMA_V(jn, 1); }
  }
  for (int j = 1; j < NT; ++j) {
    const int jb = j & 1;
    int r32o = r32; asm volatile("" : "+v"(r32o));
    SBAR(); qkt(p0, p1, lds + L_K + jb * KB, qr, r32o, hi);
    WAITBAR(6);
    { const int jn = j + 2 < NT ? j + 2 : NT - 1; DMA_K(jn, jb); }
    float ps; pv8_softmax(o, vb0 + (jb ^ 1) * VB, pa0, pa1, pa2, pa3, p0, p1, m_reg, al, ps);
    RESC(al);
    finish_tail(p1, ps, al, l_reg, pa3);
    WAITBAR(6);
    { const int jn = j + 1 < NT ? j + 1 : NT - 1; DMA_V(jn, jb ^ 1); }
  }
  WAITBAR(0);
  pv8(o, vb0 + ((NT - 1) & 1) * VB, pa0, pa1, pa2, pa3);
  if (hi == 0) li_l[r32] = l_reg; asm volatile("s_waitcnt lgkmcnt(0)" ::: "memory");
#pragma unroll
  for (int r = 0; r < 16; ++r) rli[r] = __builtin_amdgcn_rcpf(li_l[crow(r, hi)]);
#undef TROW
#undef DMA_K
#undef DMA_V
#undef RESC
}
#undef WAITBAR
}


#ifndef PROBE_FOLD
#define PROBE_FOLD 0
#endif
#ifndef MK_N_LAUNCHES
#define MK_N_LAUNCHES 1
#endif
constexpr int NWAVES = 8;
constexpr int N_PHASES = 12;
constexpr int N_LAUNCHES = MK_N_LAUNCHES;

constexpr int DM = 4096, DFF = 11008, NMETA = 16;
constexpr int S_P = 8192, S_S = 4096, NB_S = 4;
constexpr int NTOK = S_P + NB_S * S_S;
constexpr int MP = NTOK + 256;
constexpr int NA_W = 2048, DF_W = 2048, IN_W = 12288;
constexpr int C_QNA = 0, C_KNA = 2048, C_VNA = 4096, C_QD = 6144, C_KD = 8192, C_VD = 10240;
constexpr float EPS = 1e-6f, SUBLN_EPS = 1e-5f, LAM_INIT = 0.2f;

constexpr size_t MiB = 1u << 20;
constexpr size_t WS_CTL = 0, CTL_ZERO_BYTES = 1 * MiB;
constexpr size_t SZ_WA = (size_t)2 * DFF * DM * 2, SZ_WD = (size_t)DM * DFF * 2, SZ_WIN = (size_t)IN_W * DM * 2, SZ_WOUT = (size_t)DM * DM * 2;
constexpr size_t WS_WA = 1 * MiB, WS_WD = WS_WA + SZ_WA, WS_WIN = WS_WD + SZ_WD, WS_WOUT = WS_WIN + SZ_WIN;
constexpr size_t WS_HMETA = WS_WOUT + SZ_WOUT;
constexpr size_t WS_RSTD = WS_HMETA + (size_t)NMETA * DM * 4;
constexpr size_t WS_SSQP = WS_RSTD + (size_t)MP * 4 + 3072;
constexpr size_t WS_HN = WS_SSQP + (size_t)NTOK * 64 * 4;
constexpr size_t WS_HB = WS_HN + (size_t)MP * DM * 2;
constexpr size_t WS_BIG = WS_HB + (size_t)MP * DM * 2;
constexpr size_t WS_SCR = WS_BIG + (size_t)MP * IN_W * 2;
constexpr int L_MAX = NMETA + S_P;
constexpr size_t WS_ROPE = WS_SCR + (size_t)256 * 2 * 64 * 512 * 4;
constexpr size_t WS_END = WS_ROPE + (size_t)L_MAX * 32 * 4;
static_assert(WS_SSQP % 256 == 0 && WS_HN % 256 == 0, "alignment");
constexpr size_t WS_H3 = WS_HN;
constexpr int CW_BAR = 4096;

constexpr int RING_OFF = 0, RING_BYTES = 131072;
constexpr int ATT_RPB_OFF = 69632, ATT_SSQ_OFF = ATT_RPB_OFF + 2048;
constexpr int TR_BYTES = 64 * 65 * 4;
constexpr int LDSCTL_OFF = 143360, MISC_OFF = LDSCTL_OFF + 320;
constexpr int LDS_BYTES = 147456;
static_assert(att2::SHM2 <= RING_BYTES && NWAVES * TR_BYTES <= LDSCTL_OFF && att::SHM_ATTN <= ATT_RPB_OFF && ATT_SSQ_OFF + 1024 <= LDSCTL_OFF && MISC_OFF + 128 <= LDS_BYTES, "LDS map");

#define GAS __attribute__((address_space(1)))
#define LAS __attribute__((address_space(3)))
typedef unsigned short bf16;
typedef unsigned v4u __attribute__((ext_vector_type(4)));
typedef float f32x4 __attribute__((ext_vector_type(4)));
typedef short bf16x8 __attribute__((ext_vector_type(8)));
typedef GAS unsigned gu32;
typedef GAS unsigned long long gu64;
#define RLX_AGENT __ATOMIC_RELAXED, __HIP_MEMORY_SCOPE_AGENT
#define LDS_WAIT() asm volatile("s_waitcnt lgkmcnt(0)" ::: "memory")
#define VM_WAIT() asm volatile("s_waitcnt vmcnt(0)" ::: "memory")
__device__ __forceinline__ unsigned long long rt() { return __builtin_amdgcn_s_memrealtime(); }
__device__ __forceinline__ unsigned f2bf(float f) { unsigned u = __builtin_bit_cast(unsigned, f); return (u + 0x7fffu + ((u >> 16) & 1u)) >> 16; }
__device__ __forceinline__ unsigned pk2(float lo, float hi) { return f2bf(lo) | (f2bf(hi) << 16); }

#define XB_TMO      128
#define XB_XCNT(j)  (256  + 64 * (j))
#define XB_XSUB(j)  (1280 + 64 * (j))
#define XB_XGEN(j)  (2304 + 64 * (j))
#define XB_TOP      3328
#define XB_TOPGEN   3392
#define XCD_BAR_WORDS 3456
#define XB_SPIN_CAP (1u << 18)

__device__ __forceinline__ unsigned xb_ld(unsigned* p)              { return __hip_atomic_load(p, __ATOMIC_RELAXED, __HIP_MEMORY_SCOPE_AGENT); }
__device__ __forceinline__ unsigned xb_add(unsigned* p, unsigned v) { return __hip_atomic_fetch_add(p, v, __ATOMIC_RELAXED, __HIP_MEMORY_SCOPE_AGENT); }
__device__ __forceinline__ unsigned xb_xcc_id() { return (unsigned)__builtin_amdgcn_s_getreg((3 << 11) | 20) & 0xFu; }
#define XB_SPIN(cond, bar) do { unsigned _sp = 0; while (cond) { __builtin_amdgcn_s_sleep(1); \
    if ((++_sp & 255u) == 0u) { if (xb_ld(&(bar)[XB_TMO])) break; if (_sp > XB_SPIN_CAP) { atomicAdd(&(bar)[XB_TMO], 1u); break; } } } } while (0)

struct XcdBarrier {
    unsigned* bar; unsigned x;
    volatile LAS unsigned* st;
};

__device__ __forceinline__ XcdBarrier xcd_barrier_post(unsigned* bar, volatile LAS unsigned* st, const int tid_) {
    XcdBarrier b; b.bar = bar; b.x = xb_xcc_id(); b.st = st;
    if (tid_ == 0) (void)xb_add(&bar[XB_XCNT(b.x)], 1u);
    return b;
}
__device__ __forceinline__ void xcd_barrier_complete(unsigned* bar, unsigned x, unsigned& nloc, unsigned& nx) {
    const unsigned G = gridDim.x * gridDim.y * gridDim.z;
    unsigned sum, cnt, mine, sp = 0u;
    for (;;) {
        sum = 0u; cnt = 0u; mine = 0u;
#pragma unroll
        for (unsigned j = 0; j < 16; ++j) { const unsigned c = xb_ld(&bar[XB_XCNT(j)]); sum += c; cnt += (c > 0u) ? 1u : 0u; mine = (j == x) ? c : mine; }
        if (sum == G) break;
        __builtin_amdgcn_s_sleep(1);
        if ((++sp & 255u) == 0u) { if (xb_ld(&bar[XB_TMO])) break; if (sp > XB_SPIN_CAP) { atomicAdd(&bar[XB_TMO], 1u); break; } }
    }
    nloc = mine > 0u ? mine : 1u; nx = cnt > 0u ? cnt : 1u;
}

__device__ __forceinline__ void xcd_barrier(const XcdBarrier& b, const int tid_) {
    asm volatile("s_waitcnt vmcnt(0)" ::: "memory");
    __syncthreads();
    if (tid_ == 0) {
        unsigned* bar = b.bar;
        __builtin_amdgcn_s_waitcnt(0);
        unsigned nloc = b.st[0], nx = b.st[1];
        if (nloc == 0u) { xcd_barrier_complete(bar, b.x, nloc, nx); b.st[0] = nloc; b.st[1] = nx; }
        const unsigned old = xb_add(&bar[XB_XSUB(b.x)], 1u);
        const unsigned gen = old / nloc;
        if (old + 1u == (gen + 1u) * nloc) {
            __builtin_amdgcn_fence(__ATOMIC_RELEASE, "agent");
            asm volatile("s_waitcnt vmcnt(0)" ::: "memory");
            const unsigned og = xb_add(&bar[XB_TOP], 1u);
            const unsigned tg = og / nx;
            if (og + 1u == (tg + 1u) * nx) xb_add(&bar[XB_TOPGEN], 1u);
            else XB_SPIN(xb_ld(&bar[XB_TOPGEN]) == tg, bar);
            __builtin_amdgcn_fence(__ATOMIC_ACQUIRE, "agent");
            xb_add(&bar[XB_XGEN(b.x)], 1u);
            asm volatile("s_waitcnt vmcnt(0)" ::: "memory");
        } else {
            XB_SPIN(xb_ld(&bar[XB_XGEN(b.x)]) == gen, bar);
            __builtin_amdgcn_fence(__ATOMIC_ACQUIRE, "agent");
            asm volatile("s_waitcnt vmcnt(0)" ::: "memory");
        }
    }
    __syncthreads();
}


struct Frame {
    LAS unsigned char* lds;
    volatile LAS unsigned* MISC;
    gu32* ctl;
    int wave;
    __device__ __forceinline__ int lane_now() const { return att::lane_of(); }
    int vcu, G;
};
__device__ __forceinline__ float wave_sum(float v) {
#pragma unroll
    for (int o = 1; o < 64; o <<= 1) v += __shfl_xor(v, o);
    return v;
}
__device__ __forceinline__ unsigned short f2bf_s(float f) { return (unsigned short)f2bf(f); }

__device__ __forceinline__ void transpose_item(const float* __restrict__ W, int K, int N, bf16* __restrict__ WT, int mode, LAS float* scr, int item, int lane, const float* __restrict__ gk = nullptr) {
    const int nblk = N / 64, kb = item / nblk, nb = item - kb * nblk, k0 = 64 * kb, n0 = 64 * nb;
    const int q = lane & 15, kr = lane >> 4;
    f32x4 v[16];
#pragma unroll
    for (int i = 0; i < 16; ++i) v[i] = *(const f32x4*)(W + (size_t)(k0 + 4 * i + kr) * N + n0 + 4 * q);
    if (gk) {
#pragma unroll
        for (int i = 0; i < 16; ++i) v[i] = v[i] * gk[k0 + 4 * i + kr]; }
#pragma unroll
    for (int i = 0; i < 16; ++i) { LAS float* s = scr + (4 * i + kr) * 65 + 4 * q; s[0] = v[i].x; s[1] = v[i].y; s[2] = v[i].z; s[3] = v[i].w; }
    LDS_WAIT(); asm volatile("" ::: "memory");
    const int c = lane & 7;
#pragma unroll
    for (int j = 0; j < 8; ++j) { const int n = 8 * j + (lane >> 3); const LAS float* s = scr + (8 * c) * 65 + n;
        v4u o; o.x = pk2(s[0 * 65], s[1 * 65]); o.y = pk2(s[2 * 65], s[3 * 65]); o.z = pk2(s[4 * 65], s[5 * 65]); o.w = pk2(s[6 * 65], s[7 * 65]);
        const int ng = n0 + n; const int row = mode == 0 ? ng : 256 * (ng >> 7) + 128 * (mode - 1) + (ng & 127);
        *(v4u*)(WT + (size_t)row * K + k0 + 8 * c) = o; }
    LDS_WAIT(); asm volatile("" ::: "memory");
}
template <bool OUT_F32>
__device__ __forceinline__ void rms_row(const float* __restrict__ xrow, const float* __restrict__ g, void* orow, int lane) {
    const f32x4* xr = (const f32x4*)xrow + lane; const f32x4* gr = (const f32x4*)g + lane;
    f32x4 v[16]; float s = 0.f;
#pragma unroll
    for (int j = 0; j < 16; ++j) { v[j] = xr[64 * j]; s += (v[j].x * v[j].x + v[j].y * v[j].y) + (v[j].z * v[j].z + v[j].w * v[j].w); }
    const float rstd = 1.f / sqrtf(wave_sum(s) * (1.f / DM) + EPS);
    if constexpr (OUT_F32) { f32x4* o = (f32x4*)orow + lane;
#pragma unroll
        for (int j = 0; j < 16; ++j) { const f32x4 gg = gr[64 * j]; o[64 * j] = v[j] * rstd * gg; } }
    else { unsigned long long* o8 = (unsigned long long*)orow + lane;
#pragma unroll
        for (int j = 0; j < 16; ++j) { const f32x4 gg = gr[64 * j]; const f32x4 y = v[j] * rstd * gg;
            o8[64 * j] = (unsigned long long)pk2(y.x, y.y) | ((unsigned long long)pk2(y.z, y.w) << 32); } }
}
__device__ __forceinline__ void zero_row_bf16(bf16* orow, int lane) {
    unsigned long long* o8 = (unsigned long long*)orow + lane;
#pragma unroll
    for (int j = 0; j < 16; ++j) o8[64 * j] = 0ull;
}

struct Args { const float* in[22]; float* out; unsigned char* ws; int ph_lo, ph_hi, probe, pad; };
typedef const Args __attribute__((address_space(4)))* ArgsP;
#define ARGS_HERE(name) ArgsP name = (ArgsP)__builtin_amdgcn_kernarg_segment_ptr(); asm volatile("" : "+s"(name))

__device__ __forceinline__ void rope_consts(int i, float& rh, float& rl) {
    constexpr float RH[16] = {0x1.45c0000000000p-3f, 0x1.1f00000000000p-4f, 0x1.f980000000000p-6f, 0x1.bd40000000000p-7f, 0x1.8800000000000p-8f, 0x1.5940000000000p-9f, 0x1.3040000000000p-10f, 0x1.0bc0000000000p-11f, 0x1.d800000000000p-13f, 0x1.9f80000000000p-14f, 0x1.6e00000000000p-15f, 0x1.4240000000000p-16f, 0x1.1c00000000000p-17f, 0x1.f440000000000p-19f, 0x1.b880000000000p-20f, 0x1.8400000000000p-21f};
    constexpr float RL[16] = {0x1.9836e40000000p-14f, 0x1.30b61c0000000p-16f, 0x1.600ce80000000p-17f, 0x1.cae3200000000p-19f, 0x1.f6072c0000000p-19f, 0x1.b4dc9a0000000p-20f, 0x1.68c2f60000000p-25f, 0x1.c83dda0000000p-22f, 0x1.9a44960000000p-27f, 0x1.d334540000000p-25f, 0x1.2a1e800000000p-26f, 0x1.cffd9e0000000p-27f, 0x1.0312900000000p-31f, 0x1.19196a0000000p-32f, 0x1.df43180000000p-32f, 0x1.0e74a40000000p-33f};
    rh = RH[0]; rl = RL[0];
#pragma unroll
    for (int k = 1; k < 16; ++k) if (i == k) { rh = RH[k]; rl = RL[k]; }
}
__device__ __forceinline__ void p_weights(Frame& F, ArgsP a, const int set, const int wrank, const int nwaves) {
    LAS float* scr = (LAS float*)(F.lds + RING_OFF + F.wave * TR_BYTES);
    const int lane = F.lane_now();
    unsigned char* ws = a->ws;
    constexpr int I_G = (DM / 64) * (DFF / 64), I_D = (DFF / 64) * (DM / 64), I_IN = (DM / 64) * (IN_W / 64), I_OUT = (DM / 64) * (DM / 64);
    if (set == 0) {
        for (int it = wrank; it < 2 * I_G + I_D + I_OUT; it += nwaves) {
            int r = it;
            if (r < I_G) { transpose_item(a->in[4], DM, DFF, (bf16*)(ws + WS_WA), 1, scr, r, lane); continue; } r -= I_G;
            if (r < I_G) { transpose_item(a->in[5], DM, DFF, (bf16*)(ws + WS_WA), 2, scr, r, lane); continue; } r -= I_G;
            if (r < I_D) { transpose_item(a->in[6], DFF, DM, (bf16*)(ws + WS_WD), 0, scr, r, lane); continue; } r -= I_D;
            transpose_item(a->in[16], DM, DM, (bf16*)(ws + WS_WOUT), 0, scr, r, lane);
        }
    } else if (set == 1) {
        for (int it = wrank; it < I_IN; it += nwaves) transpose_item(a->in[8], DM, IN_W, (bf16*)(ws + WS_WIN), 0, scr, it, lane, a->in[7]);
    } else if (set == 2) {
        for (int it = wrank; it < 2 * I_G; it += nwaves) {
            if (it < I_G) transpose_item(a->in[18], DM, DFF, (bf16*)(ws + WS_WA), 1, scr, it, lane, a->in[17]);
            else transpose_item(a->in[19], DM, DFF, (bf16*)(ws + WS_WA), 2, scr, it - I_G, lane, a->in[17]);
        }
    } else {
        for (int it = wrank; it < I_D; it += nwaves) transpose_item(a->in[20], DFF, DM, (bf16*)(ws + WS_WD), 0, scr, it, lane);
    }
}
__device__ __forceinline__ int idle_rank(const int nwg, const int G, const int c, int& nidle) {
    const int last = (nwg + G - 1) / G - 1, first_idle = nwg - last * G;
    nidle = G - first_idle; return c >= first_idle ? c - first_idle : -1;
}
__device__ __forceinline__ void p0_prologue(Frame& F, ArgsP a) {
    {
      float* tab = (float*)(a->ws + WS_ROPE); const int t0 = (F.vcu * NWAVES + F.wave) * 64 + F.lane_now();
      for (int t = t0; t < L_MAX * 16; t += F.G * NWAVES * 64) { const int pos = t >> 4, i = t & 15; float rh, rl; rope_consts(i, rh, rl);
          const float pf = (float)pos, ang = fmaf(pf, rl, __builtin_amdgcn_fractf(pf * rh));
          tab[pos * 32 + i] = __builtin_amdgcn_cosf(ang); tab[pos * 32 + 16 + i] = __builtin_amdgcn_sinf(ang); } }
    p_weights(F, a, 0, F.vcu * NWAVES + F.wave, F.G * NWAVES);
    const int gw = F.vcu * NWAVES + F.wave, NGW = F.G * NWAVES, lane = F.lane_now();
    bf16* HN = (bf16*)(a->ws + WS_HN); bf16* PR = (bf16*)(a->ws + WS_BIG);
    for (int m = gw; m < MP; m += NGW) {
        if (m < NTOK) { const float* x = m < S_P ? a->in[0] + (size_t)m * DM : a->in[1] + (size_t)(m - S_P) * DM; rms_row<false>(x, a->in[3], HN + (size_t)m * DM, lane); }
        else if (m < NTOK + NMETA) rms_row<false>(a->in[2] + (size_t)(m - NTOK) * DM, a->in[3], HN + (size_t)m * DM, lane);
        else zero_row_bf16(HN + (size_t)m * DM, lane);
    }
}
__device__ __forceinline__ void p_stats(Frame& F, ArgsP a, const int which) {
    const int gw = F.vcu * NWAVES + F.wave, NGW = F.G * NWAVES, lane = F.lane_now();
    const float* SSQP = (const float*)(a->ws + WS_SSQP); float* RSTD = (float*)(a->ws + WS_RSTD);
    for (int m = gw; m < NTOK; m += NGW) { const float s = wave_sum(SSQP[(size_t)m * 64 + lane]); if (lane == 0) RSTD[m] = 1.f / sqrtf(s * (1.f / DM) + EPS); }
    if (which == 1) { const float* HM = (const float*)(a->ws + WS_HMETA);
        for (int i = gw; i < NMETA; i += NGW) { const f32x4* xr = (const f32x4*)(HM + (size_t)i * DM) + lane; float s = 0.f;
#pragma unroll
            for (int j = 0; j < 16; ++j) { const f32x4 v = xr[64 * j]; s += (v.x * v.x + v.y * v.y) + (v.z * v.z + v.w * v.w); }
            s = wave_sum(s); if (lane == 0) RSTD[NTOK + i] = 1.f / sqrtf(s * (1.f / DM) + EPS); } }
}
template <class Epi> __device__ __forceinline__ void meta_gemm(Frame& F, const bf16* __restrict__ A16, const int lda, const bf16* __restrict__ Bt, const int K, const int nblk, const Epi& E) {
    LAS f32x4* red = (LAS f32x4*)(F.lds + RING_OFF);
    const int lane = F.lane_now(), row = lane & 15, quad = lane >> 4, kw = K / NWAVES;
    for (int cb = F.vcu; cb < nblk; cb += F.G) {
        const bf16* ap = A16 + (size_t)row * lda + F.wave * kw + quad * 8;
        const bf16* bp = Bt + (size_t)(E.brow(cb) + row) * K + F.wave * kw + quad * 8;
        f32x4 acc = {0.f, 0.f, 0.f, 0.f};
#pragma unroll 4
        for (int k = 0; k < kw; k += 32) { const bf16x8 av = *(const bf16x8*)(ap + k), bv = *(const bf16x8*)(bp + k); acc = __builtin_amdgcn_mfma_f32_16x16x32_bf16(bv, av, acc, 0, 0, 0); }
        __syncthreads();
        red[F.wave * 64 + lane] = acc;
        __syncthreads();
        if (F.wave == 0) { f32x4 s = red[lane];
#pragma unroll
            for (int w = 1; w < NWAVES; ++w) s = s + red[w * 64 + lane];
            E(cb, row, 4 * quad, s); }
    }
    __syncthreads();
}
struct MetaEpiDown {
    const float* xm; float* hm; bf16* hb;
    __device__ __forceinline__ int brow(int cb) const { return 16 * cb; }
    __device__ __forceinline__ void operator()(int cb, int r, int c4, f32x4 s) const { const int col = 16 * cb + c4;
        const f32x4 h = *(const f32x4*)(xm + (size_t)r * DM + col) + s * 0.5f; *(f32x4*)(hm + (size_t)r * DM + col) = h;
        *(unsigned long long*)(hb + (size_t)(NTOK + r) * DM + col) = (unsigned long long)pk2(h.x, h.y) | ((unsigned long long)pk2(h.z, h.w) << 32); }
};
struct MetaEpiKV {
    const float* rstd; bf16* pr; const float* tab;
    __device__ __forceinline__ int brow(int cb) const { const int c32 = 32 * cb, seg = c32 >> 11; return (seg == 0 ? C_KNA : seg == 1 ? C_VNA : seg == 2 ? C_KD : C_VD) + (c32 & 2047); }
    __device__ __forceinline__ void operator()(int cb, int r, int c4, f32x4 s0, f32x4 s1) const { const float sc = rstd[NTOK + r]; f32x4 v0 = s0 * sc, v1 = s1 * sc; const int col = brow(cb) + c4;
        if (col >= C_KD && col < C_VD && (col & 127) < 16) {
            const f32x4 c = *(const f32x4*)(tab + r * 32 + c4), s = *(const f32x4*)(tab + r * 32 + 16 + c4); const f32x4 x1 = v0, x2 = v1; v0 = x1 * c - x2 * s; v1 = x1 * s + x2 * c; }
        bf16* p = pr + (size_t)(NTOK + r) * IN_W + col;
        *(unsigned long long*)p = (unsigned long long)pk2(v0.x, v0.y) | ((unsigned long long)pk2(v0.z, v0.w) << 32);
        *(unsigned long long*)(p + 16) = (unsigned long long)pk2(v1.x, v1.y) | ((unsigned long long)pk2(v1.z, v1.w) << 32);
#pragma unroll
        for (int z = 1; z < 4; ++z) { *(unsigned long long*)(p + (size_t)16 * z * IN_W) = 0ull; *(unsigned long long*)(p + (size_t)16 * z * IN_W + 16) = 0ull; } }
};
template <class Epi> __device__ __forceinline__ void meta_gemm2(Frame& F, const bf16* __restrict__ A16, const int lda, const bf16* __restrict__ Bt, const int K, const int nblk, const Epi& E) {
    LAS f32x4* red = (LAS f32x4*)(F.lds + RING_OFF);
    const int lane = F.lane_now(), row = lane & 15, quad = lane >> 4, kw = K / NWAVES;
    for (int cb = F.vcu; cb < nblk; cb += F.G) {
        const bf16* ap = A16 + (size_t)row * lda + F.wave * kw + quad * 8;
        const bf16* bp = Bt + (size_t)(E.brow(cb) + row) * K + F.wave * kw + quad * 8;
        f32x4 acc0 = {0.f, 0.f, 0.f, 0.f}, acc1 = acc0;
#pragma unroll 4
        for (int k = 0; k < kw; k += 32) { const bf16x8 av = *(const bf16x8*)(ap + k), b0 = *(const bf16x8*)(bp + k), b1 = *(const bf16x8*)(bp + (size_t)16 * K + k);
            acc0 = __builtin_amdgcn_mfma_f32_16x16x32_bf16(b0, av, acc0, 0, 0, 0); acc1 = __builtin_amdgcn_mfma_f32_16x16x32_bf16(b1, av, acc1, 0, 0, 0); }
        __syncthreads();
        red[(F.wave * 64 + lane) * 2] = acc0; red[(F.wave * 64 + lane) * 2 + 1] = acc1;
        __syncthreads();
        if (F.wave == 0) { f32x4 s0 = red[lane * 2], s1 = red[lane * 2 + 1];
#pragma unroll
            for (int w = 1; w < NWAVES; ++w) { s0 = s0 + red[(w * 64 + lane) * 2]; s1 = s1 + red[(w * 64 + lane) * 2 + 1]; }
            E(cb, row, 4 * quad, s0, s1); }
    }
    __syncthreads();
}
__device__ __forceinline__ void p_final(Frame& F, ArgsP a) {
    const int gw = F.vcu * NWAVES + F.wave, NGW = F.G * NWAVES, lane = F.lane_now();
    const bf16* H3 = (const bf16*)(a->ws + WS_H3); const float* SSQP = (const float*)(a->ws + WS_SSQP); const f32x4* gr = (const f32x4*)a->in[21] + lane;
    for (int m = gw; m < NTOK; m += NGW) {
        const float rstd = 1.f / sqrtf(wave_sum(SSQP[(size_t)m * 64 + lane]) * (1.f / DM) + EPS);
        const unsigned long long* hr = (const unsigned long long*)(H3 + (size_t)m * DM) + lane;
        f32x4* o = (f32x4*)(a->out + (size_t)m * DM) + lane;
        unsigned long long w[16];
#pragma unroll
        for (int j = 0; j < 16; ++j) w[j] = hr[64 * j];
#pragma unroll
        for (int j = 0; j < 16; ++j) { const unsigned lo = (unsigned)w[j], hi = (unsigned)(w[j] >> 32); const f32x4 gg = gr[64 * j];
            o[64 * j] = (f32x4){__uint_as_float(lo << 16), __uint_as_float(lo & 0xffff0000u), __uint_as_float(hi << 16), __uint_as_float(hi & 0xffff0000u)} * rstd * gg; }
    }
}

__device__ __forceinline__ void diff_unit(Frame& F, ArgsP a, int seq_row0, int S, int h, int qb) {
    using namespace att;
    const att::rsrc_t rs = __builtin_amdgcn_make_buffer_rsrc((void*)(a->ws + WS_BIG), 0, (int)((size_t)MP * IN_W * 2), 0x00020000);
    ATT_LAS char* lds = (ATT_LAS char*)(F.lds + RING_OFF);
    const int qrow0 = seq_row0 + qb * 256, NT = 1 + S / 64;
    for (int map = 0; map < 2; ++map) {
        f32x16 o[8]; float rli[16];
        att2::diff_run(rs, ((unsigned)qrow0 * LD + C_QD + (h * 2 + map) * 128) * 2u, (unsigned)(C_KD + (h * 2 + map) * 128) * 2u, (unsigned)(C_VD + h * 256) * 2u, seq_row0, NT, lds, o, rli, F.wave);
        int ln_ = att::lane_of(); asm volatile("" : "+v"(ln_));
        const int tt = F.wave * 64 + ln_, r32 = ln_ & 31, hi = ln_ >> 5, wv = F.wave;
        float* scrw = (float*)(a->ws + WS_SCR) + (size_t)blockIdx.x * 512 * 128;
        const unsigned so = (unsigned)tt * 128u;
        if (map == 0) {
#pragma unroll
            for (int d = 0; d < 8; ++d)
#pragma unroll
                for (int q = 0; q < 4; ++q) *(f32x4*)(scrw + so + d * 16 + q * 4) = (f32x4){o[d][4 * q] * rli[4 * q], o[d][4 * q + 1] * rli[4 * q + 1], o[d][4 * q + 2] * rli[4 * q + 2], o[d][4 * q + 3] * rli[4 * q + 3]};
        } else {
            float lam; { const int ln = tt & 63; const float* lq1 = a->in[11]; const float* lk1 = a->in[12]; const float* lq2 = a->in[13]; const float* lk2 = a->in[14];
                const float d1 = wave_sum(lq1[ln] * lk1[ln] + lq1[ln + 64] * lk1[ln + 64]), d2 = wave_sum(lq2[ln] * lk2[ln] + lq2[ln + 64] * lk2[ln + 64]);
                lam = expf(d1) - expf(d2) + LAM_INIT; }
#pragma unroll
            for (int r = 0; r < 16; ++r) rli[r] *= -lam;
            float ssq[16];
#pragma unroll
            for (int r = 0; r < 16; ++r) ssq[r] = 0.f;
#pragma unroll
            for (int d = 0; d < 8; ++d) {
#pragma unroll
                for (int q = 0; q < 4; ++q) { const f32x4 t = *(const f32x4*)(scrw + so + d * 16 + q * 4);
#pragma unroll
                    for (int e = 0; e < 4; ++e) { const float v = fmaf(o[d][4 * q + e], rli[4 * q + e], t[e]); ssq[4 * q + e] = fmaf(v, v, ssq[4 * q + e]); } }
                asm volatile("" ::: "memory"); }
#pragma unroll
            for (int r = 0; r < 16; ++r) ssq[r] = (1.0f - LAM_INIT) / sqrtf(half_sum(ssq[r]) * (1.0f / 256.0f) + SUBLN_EPS);
            const float* gn = a->in[15];
            bf16* obase = (bf16*)(a->ws + WS_HN) + (size_t)qrow0 * DM + NA_W + h * 256;
            const unsigned oo = (unsigned)((wv * 32 + 4 * hi) * DM + r32);
#pragma unroll
            for (int d = 0; d < 8; ++d) { const float g = gn[d * 32 + r32];
#pragma unroll
                for (int q = 0; q < 4; ++q) { const f32x4 t = *(const f32x4*)(scrw + so + d * 16 + q * 4);
#pragma unroll
                    for (int e = 0; e < 4; ++e) { const int r = 4 * q + e; const float v = fmaf(o[d][r], rli[r], t[e]);
                        obase[oo + (unsigned)(((r & 3) + 8 * (r >> 2)) * DM + d * 32)] = f2bf_s(v * ssq[r] * g); } }
                asm volatile("" ::: "memory"); }
        }
    }
}
__device__ __forceinline__ void na_unit(Frame& F, ArgsP a, int seq_row0, int nrows, int h, int qb) {
    using namespace att;
    const att::rsrc_t rs = __builtin_amdgcn_make_buffer_rsrc((void*)(a->ws + WS_BIG), 0, (int)((size_t)MP * IN_W * 2), 0x00020000); bf16* MIX = (bf16*)(a->ws + WS_HN);
    ATT_LAS char* lds = (ATT_LAS char*)(F.lds + RING_OFF);
    ATT_LAS float* rpb = (ATT_LAS float*)(F.lds + ATT_RPB_OFF);
    const int lane = F.lane_now(), r32 = lane & 31, hi = lane >> 5;
    __syncthreads();
    for (int i = F.wave * 64 + lane; i < 15 * 31; i += NWAVES * 64) rpb[i] = a->in[9][h * 465 + i] * (1.0f / SCALE);
    const int qrow0 = seq_row0 + qb * 256;
    NaCtx na; na.qrow = 4 * qb + (F.wave >> 1); na.r0 = min(max(na.qrow - 4, 0), nrows - 8); na.kr_first = min(max(4 * qb - 4, 0), nrows - 11);
    na.c = 32 * (F.wave & 1) + r32; na.c0 = min(max(na.c - 8, 0), 48); na.rpb = rpb;
    f32x16 o[4];
    attn_run<true>(rs, ((unsigned)qrow0 * LD + C_QNA + h * 128) * 2u, (unsigned)(C_KNA + h * 128) * 2u, (unsigned)(C_VNA + h * 128) * 2u, seq_row0 + na.kr_first * 64, 12, lds, na, o, F.wave);
    int ln_ = att::lane_of(); asm volatile("" : "+v"(ln_));
    const int e32 = ln_ & 31, ehi = ln_ >> 5, wv = F.wave;
    const float* gn = a->in[10] + h * 128;
    float g[4];
#pragma unroll
    for (int d = 0; d < 4; ++d) g[d] = gn[d * 32 + e32];
    bf16* ob = MIX + (size_t)(qrow0 + wv * 32 + 4 * ehi) * DM + h * 128 + e32;
#pragma unroll
    for (int r = 0; r < 16; ++r) { float s = 0.f;
#pragma unroll
        for (int d = 0; d < 4; ++d) s += o[d][r] * o[d][r];
        const float rs = 1.0f / sqrtf(half_sum(s) * (1.0f / 128.0f) + EPS);
        bf16* op = ob + (size_t)((r & 3) + 8 * (r >> 2)) * DM;
#pragma unroll
        for (int d = 0; d < 4; ++d) op[d * 32] = f2bf_s(o[d][r] * rs * g[d]); }
}
__device__ __forceinline__ void p_attention(Frame& F, ArgsP a) {
    if (F.wave >= 4) __builtin_amdgcn_s_setprio(1);
    const int v = F.vcu;
    for (int u = v; u < 256 + 512; u += F.G) {
        int seq_row0, S, h, qb;
        if (u < 256) { seq_row0 = 0; S = S_P; h = u >> 5; qb = u & 31; }
        else { const int t = u - 256, pair = t >> 4; seq_row0 = S_P + (pair >> 3) * S_S; S = S_S; h = pair & 7; qb = t & 15; }
#ifndef ATT_NO_DIFF
        diff_unit(F, a, seq_row0, S, h, qb);
#endif
    }
    for (int n = v; n < 16 * 96; n += F.G) { const int h = n / 96, q = n - h * 96; int seq_row0, nrows, qb;
        if (q < 32) { seq_row0 = 0; nrows = S_P / 64; qb = q; }
        else { const int t = q - 32; seq_row0 = S_P + (t >> 4) * S_S; nrows = S_S / 64; qb = t & 15; }
#ifndef ATT_NO_NA
        na_unit(F, a, seq_row0, nrows, h, qb);
#endif
    }
    __builtin_amdgcn_s_setprio(0);
}

__global__ void __launch_bounds__(NWAVES * 64, 2) mk_fwd(Args args) {
    extern __shared__ __attribute__((aligned(16))) unsigned char lds[];
    Frame F;
    F.lds = (LAS unsigned char*)lds;
    F.MISC = (volatile LAS unsigned*)(F.lds + MISC_OFF);
    F.wave = __builtin_amdgcn_readfirstlane((int)threadIdx.x >> 6);
    F.G = gridDim.x; { const int bx = blockIdx.x; F.vcu = (F.G % 8 == 0) ? (bx % 8) * (F.G / 8) + bx / 8 : bx; }
    int lo, hi;
    { ARGS_HERE(a0); F.ctl = (gu32*)(a0->ws + WS_CTL); lo = a0->ph_lo; hi = a0->ph_hi; }
    for (int u = F.wave * 64 + F.lane_now(); u < (LDS_BYTES - LDSCTL_OFF) / 4; u += NWAVES * 64) ((LAS unsigned*)(F.lds + LDSCTL_OFF))[u] = 0u;
    __syncthreads();
    XcdBarrier bar; bar.bar = (unsigned*)(F.ctl + CW_BAR); bar.x = 0; bar.st = nullptr;
    if (N_LAUNCHES == 1) bar = xcd_barrier_post((unsigned*)(F.ctl + CW_BAR), F.MISC + 8, F.wave * 64 + att::lane_of());
#ifndef PH_MASK
#define PH_MASK 0xFFF
#endif
#define IN(k) ((((PH_MASK) >> (k)) & 1) && lo <= (k) && (k) < hi)
#define SEAM(k) do { if (IN(k) && IN((k) + 1 + ((k) == 4))) xcd_barrier(bar, F.wave * 64 + att::lane_of()); } while (0)
#define WSP(T, off) ((T*)(a->ws + (off)))

#define PHASE(k) if (IN(k))

    PHASE(0) { ARGS_HERE(a); p0_prologue(F, a); } SEAM(0);
    PHASE(1) {
        ARGS_HERE(a);
        pg8::Gemm g{WSP(bf16, WS_HN), WSP(bf16, WS_WA), MP, 2 * DFF, DM}; pg8::StaticOrder S; S.init(MP, 2 * DFF, F.G, (int)blockIdx.x);
        pg8::EpiSwiglu E{WSP(bf16, WS_BIG), DFF, nullptr};
        pg8::gemm_phase<pg8::EpiSwiglu, pg8::StaticOrder, true, true>(F.lds + RING_OFF, g, S, E, F.wave);
        { int nidle; const int r = idle_rank(S.nwg, F.G, (int)blockIdx.x, nidle);
          if (nidle == 0) p_weights(F, a, 1, F.vcu * NWAVES + F.wave, F.G * NWAVES); else if (r >= 0) p_weights(F, a, 1, r * NWAVES + F.wave, nidle * NWAVES); } } SEAM(1);
    PHASE(2) {
        ARGS_HERE(a);
        { MetaEpiDown ME{a->in[2], WSP(float, WS_HMETA), WSP(bf16, WS_HB)}; meta_gemm(F, WSP(bf16, WS_BIG) + (size_t)NTOK * DFF, DFF, WSP(bf16, WS_WD), DFF, DM / 16, ME); }
        pg8::Gemm g{WSP(bf16, WS_BIG), WSP(bf16, WS_WD), NTOK, DM, DFF}; pg8::StaticOrder S; S.init(NTOK, DM, F.G, (int)blockIdx.x);
        pg8::EpiRes<0, 1> E{a->in[0], a->in[1], nullptr, nullptr, WSP(bf16, WS_HB), WSP(float, WS_SSQP), 0.5f, DM};
        pg8::gemm_phase<pg8::EpiRes<0, 1>, pg8::StaticOrder, false, true>(F.lds + RING_OFF, g, S, E, F.wave); } SEAM(2);
    PHASE(3) { ARGS_HERE(a); p_stats(F, a, 1); } SEAM(3);
    PHASE(4) {
        ARGS_HERE(a);
        { MetaEpiKV ME{WSP(float, WS_RSTD), WSP(bf16, WS_BIG), WSP(float, WS_ROPE)}; meta_gemm2(F, WSP(bf16, WS_HB) + (size_t)NTOK * DM, DM, WSP(bf16, WS_WIN), DM, 8192 / 32, ME); }
        pg8::Gemm g{WSP(bf16, WS_HB), WSP(bf16, WS_WIN), NTOK, IN_W, DM}; pg8::StaticOrder S; S.init(NTOK, IN_W, F.G, (int)blockIdx.x);
        pg8::EpiProj E{WSP(bf16, WS_BIG), IN_W, WSP(float, WS_RSTD), WSP(float, WS_ROPE), C_QD / 256, C_VD / 256};
        pg8::gemm_phase<pg8::EpiProj, pg8::StaticOrder, true, true>(F.lds + RING_OFF, g, S, E, F.wave); } SEAM(4);
    PHASE(6) { ARGS_HERE(a); p_attention(F, a); } SEAM(6);
    PHASE(7) {
        ARGS_HERE(a);
        pg8::Gemm g{WSP(bf16, WS_HN), WSP(bf16, WS_WOUT), NTOK, DM, DM}; pg8::StaticOrder S; S.init(NTOK, DM, F.G, (int)blockIdx.x);
        pg8::EpiRes<1, 1> E{nullptr, nullptr, WSP(bf16, WS_HB), nullptr, WSP(bf16, WS_HB), WSP(float, WS_SSQP), 1.0f, DM};
        pg8::gemm_phase<pg8::EpiRes<1, 1>, pg8::StaticOrder, false, true>(F.lds + RING_OFF, g, S, E, F.wave); } SEAM(7);
    PHASE(8) { ARGS_HERE(a); p_stats(F, a, 2); p_weights(F, a, 2, F.vcu * NWAVES + F.wave, F.G * NWAVES); } SEAM(8);
    PHASE(9) {
        ARGS_HERE(a);
        pg8::Gemm g{WSP(bf16, WS_HB), WSP(bf16, WS_WA), NTOK, 2 * DFF, DM}; pg8::StaticOrder S; S.init(NTOK, 2 * DFF, F.G, (int)blockIdx.x);
        pg8::EpiSwiglu E{WSP(bf16, WS_BIG), DFF, WSP(float, WS_RSTD)};
        pg8::gemm_phase<pg8::EpiSwiglu, pg8::StaticOrder, true, true>(F.lds + RING_OFF, g, S, E, F.wave);
        { int nidle; const int r = idle_rank(S.nwg, F.G, (int)blockIdx.x, nidle);
          if (nidle == 0) p_weights(F, a, 3, F.vcu * NWAVES + F.wave, F.G * NWAVES); else if (r >= 0) p_weights(F, a, 3, r * NWAVES + F.wave, nidle * NWAVES); } } SEAM(9);
    PHASE(10) {
        ARGS_HERE(a);
        pg8::Gemm g{WSP(bf16, WS_BIG), WSP(bf16, WS_WD), NTOK, DM, DFF}; pg8::StaticOrder S; S.init(NTOK, DM, F.G, (int)blockIdx.x);
        pg8::EpiRes<1, 1> E{nullptr, nullptr, WSP(bf16, WS_HB), nullptr, WSP(bf16, WS_H3), WSP(float, WS_SSQP), 0.5f, DM};
        pg8::gemm_phase<pg8::EpiRes<1, 1>, pg8::StaticOrder, false, true>(F.lds + RING_OFF, g, S, E, F.wave); } SEAM(10);
    PHASE(11) { ARGS_HERE(a); p_final(F, a); }
#undef PHASE
#undef IN
#undef SEAM
#undef WSP
}

extern "C" void kernel_launch(void* const* d_in, const int* in_sizes, int n_in, void* d_out, int out_size, void* d_ws, size_t ws_size, hipStream_t stream) {
    static int grid = 0;
    if (grid == 0) {
        if (n_in != 22 || in_sizes[0] != S_P * DM || in_sizes[1] != NB_S * S_S * DM || out_size != NTOK * DM || ws_size < WS_END) {
            fprintf(stderr, "kernel_launch: shape mismatch: n_in %d in0 %d in1 %d out %d ws %zu (need %zu)\n", n_in, n_in > 0 ? in_sizes[0] : -1, n_in > 1 ? in_sizes[1] : -1, out_size, ws_size, (size_t)WS_END); grid = -1; return; }
        int dev = 0, cus = 0, per_cu = 0;
        if (hipGetDevice(&dev) != hipSuccess || hipDeviceGetAttribute(&cus, hipDeviceAttributeMultiprocessorCount, dev) != hipSuccess) { grid = -1; return; }
        if (hipFuncSetAttribute((const void*)mk_fwd, hipFuncAttributeMaxDynamicSharedMemorySize, LDS_BYTES) != hipSuccess) { fprintf(stderr, "kernel_launch: hipFuncSetAttribute failed\n"); grid = -1; return; }
        if (hipOccupancyMaxActiveBlocksPerMultiprocessor(&per_cu, (const void*)mk_fwd, NWAVES * 64, LDS_BYTES) != hipSuccess || per_cu < 1)
            fprintf(stderr, "kernel_launch: note: occupancy query reports %d workgroups per CU\n", per_cu);
        (void)hipGetLastError();
        grid = cus;
    }
    if (grid < 0) return;
    if (hipMemsetAsync((char*)d_ws + WS_CTL, 0, CTL_ZERO_BYTES, stream) != hipSuccess) { fprintf(stderr, "kernel_launch: memset failed\n"); return; }
    Args a{};
    for (int i = 0; i < 22; ++i) a.in[i] = (const float*)d_in[i];
    a.out = (float*)d_out; a.ws = (unsigned char*)d_ws;
#if defined(PROBE_TWICE)
    for (int pass_ = 0; pass_ < 2; ++pass_)
#endif
    for (int li = 0; li < N_LAUNCHES; ++li) {
        a.ph_lo = (N_LAUNCHES == 1) ? 0 : li; a.ph_hi = (N_LAUNCHES == 1) ? N_PHASES : li + 1;
        hipLaunchKernelGGL(mk_fwd, dim3(grid), dim3(NWAVES * 64), LDS_BYTES, stream, a);
#if defined(PROBE_REPEAT)
#ifndef PROBE_TIMES
#define PROBE_TIMES 1
#endif
        if (N_LAUNCHES > 1 && (((PROBE_REPEAT) >> li) & 1)) for (int rp_ = 0; rp_ < PROBE_TIMES; ++rp_) hipLaunchKernelGGL(mk_fwd, dim3(grid), dim3(NWAVES * 64), LDS_BYTES, stream, a);
#endif
#if defined(PROBE_SEQ01)
        if (N_LAUNCHES > 1 && li == 1) { Args b = a; b.ph_lo = 0; b.ph_hi = 1; hipLaunchKernelGGL(mk_fwd, dim3(grid), dim3(NWAVES * 64), LDS_BYTES, stream, b); hipLaunchKernelGGL(mk_fwd, dim3(grid), dim3(NWAVES * 64), LDS_BYTES, stream, a); }
#endif
#if defined(PROBE_ROPE)
        if (N_LAUNCHES > 1 && li == 5) { Args b = a; b.probe = 1; hipLaunchKernelGGL(mk_fwd, dim3(grid), dim3(NWAVES * 64), LDS_BYTES, stream, b); hipLaunchKernelGGL(mk_fwd, dim3(grid), dim3(NWAVES * 64), LDS_BYTES, stream, a); }
#endif
#if defined(PROBE_REPEAT_ALT)
        if (N_LAUNCHES > 1 && (((PROBE_REPEAT_ALT) >> li) & 1)) { Args b = a; b.out = (float*)((unsigned char*)d_ws + WS_BIG); b.probe = PROBE_FOLD;
            hipLaunchKernelGGL(mk_fwd, dim3(grid), dim3(NWAVES * 64), LDS_BYTES, stream, b); }
#endif
        const hipError_t le = hipPeekAtLastError();
        if (le != hipSuccess) { fprintf(stderr, "kernel_launch: launch %d failed: %s\n", li, hipGetErrorName(le)); break; }
    }
}
```

```cpp
#include <hip/hip_runtime.h>
#include <cstdio>
#include <cstdint>
#include <cmath>
namespace pg8 {
#define PG8_LAS __attribute__((address_space(3)))
typedef unsigned short bf16_t;
typedef short bf16x8 __attribute__((ext_vector_type(8)));
typedef float f32x4 __attribute__((ext_vector_type(4)));
typedef unsigned u32x4 __attribute__((ext_vector_type(4)));
constexpr int BM = 256, BK = 64, HALF = 128, HTB = HALF * BK * 2  , STAGE_BYTES = 8 * HTB, NXCD = 8, WGM = 8;

__host__ __device__ __forceinline__ int lds_byte(int r, int c) { const int st = (r >> 4) * 2 + (c >> 5), rr = r & 15, cc = c & 31, ob = rr * 64 + cc * 2; return st * 1024 + (ob ^ (((ob >> 9) & 1) << 5)); }
__host__ __device__ __forceinline__ void stage_rc(int b, int& R, int& C) { const int st = b / 1024, sb = b % 1024, swz = sb ^ (((sb >> 9) & 1) << 5); R = (st >> 1) * 16 + swz / 64; C = (st & 1) * 32 + (swz % 64) / 2; }
__host__ __device__ __forceinline__ int perm32(int rho) { const int n = rho >> 4, i = rho & 15; return 8 * (i >> 2) + 4 * n + (i & 3); }

struct Unit { int pm, pn; };
struct Gemm { const bf16_t* A; const bf16_t* Bt; int M, N, K; };

struct StaticOrder {
    int nM, nN, nwg, G, c, fold;
    __host__ __device__ void init(int M, int N, int G_, int c_) { nM = M / BM; nN = N / BM; nwg = nM * nN; G = G_; c = c_; fold = 0; }
    __host__ __device__ bool next(int i, Unit& u) const {
        const long L = (long)i * G + c; if (L >= nwg) return false;
        int wgid = (int)L; { const int q = nwg / NXCD, r = nwg % NXCD, xcd = wgid % NXCD, off = wgid / NXCD; wgid = (xcd < r ? xcd * (q + 1) : r * (q + 1) + (xcd - r) * q) + off; }
        const int nig = WGM * nN, gid = wgid / nig, fm = gid * WGM, gsz = (nM - fm) < WGM ? (nM - fm) : WGM;
        u.pm = fm + ((wgid % nig) % gsz); u.pn = (wgid % nig) / gsz; if (fold) { u.pm &= 1; u.pn &= 1; } return true;
    }
    __device__ __forceinline__ void a_ready(const Unit&) const {}
    __device__ __forceinline__ void done(const Unit&) const {}
};

__device__ __forceinline__ unsigned cvt_pk_bf16(float lo, float hi) { unsigned r; asm volatile("v_cvt_pk_bf16_f32 %0, %1, %2" : "=v"(r) : "v"(lo), "v"(hi)); return r; }
typedef float f32x2 __attribute__((ext_vector_type(2)));

__device__ __forceinline__ int pg8_lane_now() { int l; asm volatile("v_mbcnt_lo_u32_b32 %0, -1, 0\n\tv_mbcnt_hi_u32_b32 %0, -1, %0" : "=v"(l)); return l; }
__device__ __forceinline__ float silu_mul(float g, float up) { const float e = __builtin_amdgcn_exp2f(g * -1.4426950408889634f); return g * __builtin_amdgcn_rcpf(1.0f + e) * up; }
__device__ __forceinline__ float bf_lo(unsigned w) { return __uint_as_float(w << 16); }
__device__ __forceinline__ float bf_hi(unsigned w) { return __uint_as_float(w & 0xffff0000u); }
struct EpiSwiglu {
    static constexpr bool PERM = true, AFTER_DRAIN = false;
    bf16_t* O; int ldc; const float* rs;
    __device__ __forceinline__ void operator()(const f32x4 (&acc)[2][2][4][2], const Unit& u, int wr, int wc, int fr, int fq) const {
        const int row0 = u.pm * BM + wr * 64 + fr, col0 = u.pn * HALF + wc * 32 + 8 * fq;
#pragma unroll
        for (int ai = 0; ai < 2; ++ai)
#pragma unroll
            for (int m = 0; m < 4; ++m) { const int row = row0 + ai * HALF + m * 16; bf16_t* rowp = O + (size_t)row * ldc + col0;
                const float sc = rs ? rs[row] : 1.0f;
                float v[8];
#pragma unroll
                for (int n = 0; n < 2; ++n)
#pragma unroll
                    for (int j = 0; j < 4; ++j) v[n * 4 + j] = silu_mul(acc[ai][0][m][n][j] * sc, acc[ai][1][m][n][j] * sc);
                u32x4 w; w.x = cvt_pk_bf16(v[0], v[1]); w.y = cvt_pk_bf16(v[2], v[3]); w.z = cvt_pk_bf16(v[4], v[5]); w.w = cvt_pk_bf16(v[6], v[7]);
                *(u32x4*)rowp = w; }
    }
};
struct EpiProj {
    static constexpr bool PERM = true, AFTER_DRAIN = false;
    bf16_t* O; int ldc; const float* rs; const float* tab; int pn_lo, pn_hi;
    __device__ __forceinline__ void operator()(const f32x4 (&acc)[2][2][4][2], const Unit& u, int wr, int wc, int fr, int fq) const {
        const int row0 = u.pm * BM + wr * 64 + fr, col0 = u.pn * BM + wc * 32 + 8 * fq;
        const bool rope = wc == 0 && u.pn >= pn_lo && u.pn < pn_hi;
        const float sg = fq < 2 ? -1.f : 1.f;
#pragma unroll
        for (int ai = 0; ai < 2; ++ai)
#pragma unroll
            for (int m = 0; m < 4; ++m) { const int row = row0 + ai * HALF + m * 16; bf16_t* rowp = O + (size_t)row * ldc + col0;
                const float sc = rs ? rs[row] : 1.0f;
                f32x4 c0, c1, s0, s1;
                if (rope) { const int pos = row < 8192 ? 16 + row : 16 + ((row - 8192) & 4095); const float* tb = tab + pos * 32 + 8 * (fq & 1);
                    c0 = *(const f32x4*)tb; c1 = *(const f32x4*)(tb + 4); s0 = *(const f32x4*)(tb + 16) * sg; s1 = *(const f32x4*)(tb + 20) * sg; }
#pragma unroll
                for (int bj = 0; bj < 2; ++bj) { f32x4 v0 = acc[ai][bj][m][0] * sc, v1 = acc[ai][bj][m][1] * sc;
                    if (rope) { f32x4 q0, q1;
#pragma unroll
                        for (int e2 = 0; e2 < 4; ++e2) { q0[e2] = __shfl_xor(v0[e2], 32); q1[e2] = __shfl_xor(v1[e2], 32); }
                        v0 = v0 * c0 + q0 * s0; v1 = v1 * c1 + q1 * s1; }
                    u32x4 w; w.x = cvt_pk_bf16(v0[0], v0[1]); w.y = cvt_pk_bf16(v0[2], v0[3]); w.z = cvt_pk_bf16(v1[0], v1[1]); w.w = cvt_pk_bf16(v1[2], v1[3]);
                    *(u32x4*)(rowp + bj * HALF) = w; } }
    }
};
template <int SRC, int DST> struct EpiRes {
    static constexpr bool PERM = true, AFTER_DRAIN = false;
    const float* s0; const float* s1; const bf16_t* sb; float* df; bf16_t* db; float* ssq; float alpha; int ldc;
    __device__ __forceinline__ void operator()(const f32x4 (&acc)[2][2][4][2], const Unit& u, int wr, int wc, int fr, int fq) const {
        const int pm = u.pm;
        const char* sfb = (const char*)(pm < 32 ? s0 + (size_t)pm * BM * ldc : s1 + (size_t)(pm - 32) * BM * ldc);
        const char* sbb = (const char*)(sb + (size_t)pm * BM * ldc); char* dbb = (char*)(db + (size_t)pm * BM * ldc); char* dfb = (char*)(df + (size_t)pm * BM * ldc);
        float* sqb = ssq + (size_t)pm * BM * 64 + 4 * u.pn + wc;
        const int rloc0 = wr * 64 + fr; const unsigned col0 = (unsigned)(u.pn * BM + wc * 32 + 8 * fq);
#pragma unroll
        for (int ai = 0; ai < 2; ++ai) {
            f32x4 hf[SRC == 0 ? 4 : 1][2][2]; u32x4 hw[SRC == 1 ? 4 : 1][2];
            if constexpr (SRC != 2)
#pragma unroll
            for (int m = 0; m < 4; ++m) { const unsigned eoff = (unsigned)(rloc0 + ai * HALF + m * 16) * (unsigned)ldc + col0;
#pragma unroll
                for (int bj = 0; bj < 2; ++bj) {
                    if constexpr (SRC == 0) { hf[m][bj][0] = *(const f32x4*)(sfb + (eoff + bj * HALF) * 4u); hf[m][bj][1] = *(const f32x4*)(sfb + (eoff + bj * HALF + 4) * 4u); }
                    else hw[m][bj] = *(const u32x4*)(sbb + (eoff + bj * HALF) * 2u); } }
#pragma unroll
            for (int m = 0; m < 4; ++m) { const int rloc = rloc0 + ai * HALF + m * 16; const unsigned eoff = (unsigned)rloc * (unsigned)ldc + col0;
                float sq = 0.f;
#pragma unroll
                for (int bj = 0; bj < 2; ++bj) { f32x4 h0, h1;
                    if constexpr (SRC == 0) { h0 = hf[m][bj][0]; h1 = hf[m][bj][1]; }
                    else if constexpr (SRC == 2) { h0 = (f32x4){0.f, 0.f, 0.f, 0.f}; h1 = h0; }
                    else { const u32x4 w = hw[m][bj]; h0 = (f32x4){bf_lo(w.x), bf_hi(w.x), bf_lo(w.y), bf_hi(w.y)}; h1 = (f32x4){bf_lo(w.z), bf_hi(w.z), bf_lo(w.w), bf_hi(w.w)}; }
                    h0 = h0 + acc[ai][bj][m][0] * alpha; h1 = h1 + acc[ai][bj][m][1] * alpha;
                    if constexpr (DST == 1) sq += ((h0[0] * h0[0] + h0[1] * h0[1]) + (h0[2] * h0[2] + h0[3] * h0[3])) + ((h1[0] * h1[0] + h1[1] * h1[1]) + (h1[2] * h1[2] + h1[3] * h1[3]));
                    if constexpr (DST == 0) { *(f32x4*)(dfb + (eoff + bj * HALF) * 4u) = h0; *(f32x4*)(dfb + (eoff + bj * HALF + 4) * 4u) = h1; }
                    else { u32x4 w; w.x = cvt_pk_bf16(h0[0], h0[1]); w.y = cvt_pk_bf16(h0[2], h0[3]); w.z = cvt_pk_bf16(h1[0], h1[1]); w.w = cvt_pk_bf16(h1[2], h1[3]);
                        *(u32x4*)(dbb + (eoff + bj * HALF) * 2u) = w; } }
                if constexpr (DST == 1) { sq += __shfl_xor(sq, 16); sq += __shfl_xor(sq, 32);
                    if (fq == 0) sqb[(unsigned)rloc * 64u] = sq; } }
            asm volatile("" ::: "memory"); }
    }
};

template <class Epi, class Sched, bool ALIGN_EPI = false, bool SP2 = false>
__device__ __forceinline__ void gemm_phase(PG8_LAS unsigned char* lds, const Gemm g, const Sched& S, const Epi& E, const int wave_) {
    const int wid = wave_, lane = pg8_lane_now(), tid = wid * 64 + lane, wr = wid >> 2, wc = wid & 3, fr = lane & 15, fq = lane >> 4;
    const int K = g.K, nt = K / BK;
    unsigned voffA[2], voffB[2];
#pragma unroll
    for (int i = 0; i < 2; ++i) { int R, C; stage_rc(tid * 16 + i * 8192, R, C); const int Rb = Epi::PERM ? ((R & ~31) + perm32(R & 31)) : R;
        voffA[i] = (unsigned)(R * K + C) * 2u; voffB[i] = (unsigned)(Rb * K + C) * 2u; }
    const size_t kstep = (size_t)(BK * 2);
    const size_t hstep = (size_t)HALF * K * 2;
    const size_t tstep = 2 * hstep;
    const unsigned ldsw = (unsigned)wid * 1024u;
    const int aoff = lds_byte(wr * 64 + fr, fq * 8), boff = lds_byte(wc * 32 + fr, fq * 8);
#define PG8_SA(b, h) (((b) * 2 + (h)) * HTB)
#define PG8_SB(b, h) ((4 + (b) * 2 + (h)) * HTB)
#define PG8_STAGE(bufoff, gbase, voff) do { _Pragma("unroll") for (int _i = 0; _i < 2; ++_i) \
        __builtin_amdgcn_global_load_lds((const unsigned*)((const char*)(gbase) + (voff)[_i]), (PG8_LAS unsigned*)(lds + (bufoff) + ldsw + _i * 8192), 16, 0, 0); } while (0)
#define PG8_LDA(dst, b, h) do { _Pragma("unroll") for (int m = 0; m < 4; ++m) _Pragma("unroll") for (int k = 0; k < 2; ++k) dst[m][k] = *(const PG8_LAS bf16x8*)(lds + PG8_SA(b, h) + aoff + m * 2048 + k * 1024); } while (0)
#define PG8_LDB(dst, b, h) do { _Pragma("unroll") for (int n = 0; n < 2; ++n) _Pragma("unroll") for (int k = 0; k < 2; ++k) dst[n][k] = *(const PG8_LAS bf16x8*)(lds + PG8_SB(b, h) + boff + n * 2048 + k * 1024); } while (0)
#define PG8_MMA(ai, bj, At, Bt) do { __builtin_amdgcn_s_setprio(1); _Pragma("unroll") for (int m = 0; m < 4; ++m) _Pragma("unroll") for (int n = 0; n < 2; ++n) _Pragma("unroll") for (int k = 0; k < 2; ++k) \
        acc[ai][bj][m][n] = __builtin_amdgcn_mfma_f32_16x16x32_bf16(Bt[n][k], At[m][k], acc[ai][bj][m][n], 0, 0, 0); __builtin_amdgcn_s_setprio(0); } while (0)
#define PG8_WAIT_V(n) asm volatile("s_waitcnt vmcnt(" #n ")" ::: "memory")
#define PG8_WAIT_L(n) asm volatile("s_waitcnt lgkmcnt(" #n ")" ::: "memory")
#define PG8_BAR __builtin_amdgcn_s_barrier()
#define PG8_SCHED __builtin_amdgcn_sched_barrier(0)
    Unit cur, nxt; int ui = 0;
    if (!S.next(0, cur)) return;
    f32x4 acc[2][2][4][2];
#pragma unroll
    for (int a = 0; a < 2; ++a)
#pragma unroll
        for (int b = 0; b < 2; ++b)
#pragma unroll
            for (int m = 0; m < 4; ++m)
#pragma unroll
                for (int n = 0; n < 2; ++n) acc[a][b][m][n] = (f32x4){0.f, 0.f, 0.f, 0.f};
    bf16x8 At[4][2], B0[2][2], B1[2][2];
    const char* cA = (const char*)g.A + (size_t)cur.pm * tstep; const char* cB = (const char*)g.Bt + (size_t)cur.pn * tstep;
    S.a_ready(cur);
    if constexpr (SP2) {
        PG8_STAGE(PG8_SB(0, 0), cB, voffB); PG8_STAGE(PG8_SB(0, 1), cB + hstep, voffB); PG8_STAGE(PG8_SA(0, 0), cA, voffA); PG8_STAGE(PG8_SA(0, 1), cA + hstep, voffA);
        if (wr == 1) PG8_BAR;
        PG8_WAIT_V(2); PG8_BAR;
        PG8_STAGE(PG8_SB(1, 0), cB + kstep, voffB); PG8_STAGE(PG8_SA(1, 0), cA + kstep, voffA); PG8_STAGE(PG8_SB(1, 1), cB + hstep + kstep, voffB);
        PG8_WAIT_V(6); PG8_BAR;
    } else {
        PG8_STAGE(PG8_SB(0, 0), cB, voffB); PG8_STAGE(PG8_SA(0, 0), cA, voffA); PG8_STAGE(PG8_SB(0, 1), cB + hstep, voffB); PG8_STAGE(PG8_SA(0, 1), cA + hstep, voffA);
        if (wr == 1) PG8_BAR;
        PG8_WAIT_V(4); PG8_BAR;
        PG8_STAGE(PG8_SB(1, 0), cB + kstep, voffB); PG8_STAGE(PG8_SA(1, 0), cA + kstep, voffA); PG8_STAGE(PG8_SB(1, 1), cB + hstep + kstep, voffB);
        PG8_WAIT_V(6); PG8_BAR;
    }
    for (;;) {
        const bool has_next = S.next(ui + 1, nxt);
        const char* nA = has_next ? (const char*)g.A + (size_t)nxt.pm * tstep : cA; const char* nB = has_next ? (const char*)g.Bt + (size_t)nxt.pn * tstep : cB;
        for (int t = 0; t < nt; t += 2) {
            const bool last = (t == nt - 2);
            const char* a1 = cA + (size_t)(t + 1) * kstep;
            const char* a2 = last ? nA : cA + (size_t)(t + 2) * kstep; const char* b2 = last ? nB : cB + (size_t)(t + 2) * kstep;
            const char* a3 = a2 + kstep; const char* b3 = b2 + kstep;
            if (last && has_next) S.a_ready(nxt);
            if constexpr (SP2) {
            PG8_LDB(B0, 0, 0); PG8_LDB(B1, 0, 1); PG8_SCHED; PG8_LDA(At, 0, 0); PG8_STAGE(PG8_SA(1, 1), a1 + hstep, voffA);
            PG8_WAIT_V(8); PG8_WAIT_L(0); PG8_BAR; PG8_MMA(0, 0, At, B0); PG8_MMA(0, 1, At, B1); PG8_BAR; PG8_SCHED;
            PG8_LDA(At, 0, 1); PG8_STAGE(PG8_SB(0, 0), b2, voffB); PG8_STAGE(PG8_SB(0, 1), b2 + hstep, voffB); PG8_STAGE(PG8_SA(0, 0), a2, voffA);
            PG8_WAIT_V(8); PG8_WAIT_L(0); PG8_BAR; PG8_MMA(1, 0, At, B0); PG8_MMA(1, 1, At, B1); PG8_BAR; PG8_SCHED;
            PG8_LDB(B0, 1, 0); PG8_LDB(B1, 1, 1); PG8_SCHED; PG8_LDA(At, 1, 0); PG8_STAGE(PG8_SA(0, 1), a2 + hstep, voffA);
            PG8_WAIT_V(8); PG8_WAIT_L(0); PG8_BAR; PG8_MMA(0, 0, At, B0); PG8_MMA(0, 1, At, B1); PG8_BAR; PG8_SCHED;
            PG8_LDA(At, 1, 1); PG8_STAGE(PG8_SB(1, 0), b3, voffB); PG8_STAGE(PG8_SB(1, 1), b3 + hstep, voffB); PG8_STAGE(PG8_SA(1, 0), a3, voffA);
            PG8_WAIT_V(8); PG8_WAIT_L(0); PG8_BAR; PG8_MMA(1, 0, At, B0); PG8_MMA(1, 1, At, B1); PG8_BAR; PG8_SCHED;
            } else {
            PG8_LDB(B0, 0, 0); PG8_SCHED; PG8_LDA(At, 0, 0); PG8_STAGE(PG8_SA(1, 1), a1 + hstep, voffA);
            PG8_WAIT_L(8); PG8_BAR; PG8_WAIT_L(0); PG8_MMA(0, 0, At, B0); PG8_BAR; PG8_SCHED;
            PG8_LDB(B1, 0, 1); PG8_STAGE(PG8_SB(0, 0), b2, voffB);
            PG8_BAR; PG8_WAIT_L(0); PG8_MMA(0, 1, At, B1); PG8_BAR;
            PG8_LDA(At, 0, 1); PG8_STAGE(PG8_SA(0, 0), a2, voffA);
            PG8_BAR; PG8_WAIT_L(0); PG8_MMA(1, 0, At, B0); PG8_BAR; PG8_SCHED;
            PG8_STAGE(PG8_SB(0, 1), b2 + hstep, voffB);
            PG8_WAIT_V(6); PG8_BAR; PG8_MMA(1, 1, At, B1); PG8_BAR;
            PG8_LDB(B0, 1, 0); PG8_SCHED; PG8_LDA(At, 1, 0); PG8_STAGE(PG8_SA(0, 1), a2 + hstep, voffA);
            PG8_WAIT_L(8); PG8_BAR; PG8_WAIT_L(0); PG8_MMA(0, 0, At, B0); PG8_BAR; PG8_SCHED;
            PG8_LDB(B1, 1, 1); PG8_STAGE(PG8_SB(1, 0), b3, voffB);
            PG8_BAR; PG8_WAIT_L(0); PG8_MMA(0, 1, At, B1); PG8_BAR;
            PG8_LDA(At, 1, 1); PG8_STAGE(PG8_SA(1, 0), a3, voffA);
            PG8_BAR; PG8_WAIT_L(0); PG8_MMA(1, 0, At, B0); PG8_BAR; PG8_SCHED;
            PG8_STAGE(PG8_SB(1, 1), b3 + hstep, voffB);
            PG8_WAIT_V(6); PG8_BAR; PG8_MMA(1, 1, At, B1); PG8_BAR;
            }
        }
        if constexpr (ALIGN_EPI) { if (wr == 0) PG8_BAR; }
        if constexpr (!Epi::AFTER_DRAIN) { E(acc, cur, wr, wc, fr, fq); S.done(cur); }
        if (!has_next) break;
#pragma unroll
        for (int a = 0; a < 2; ++a)
#pragma unroll
            for (int b = 0; b < 2; ++b)
#pragma unroll
                for (int m = 0; m < 4; ++m)
#pragma unroll
                    for (int n = 0; n < 2; ++n) acc[a][b][m][n] = (f32x4){0.f, 0.f, 0.f, 0.f};
        cur = nxt; cA = nA; cB = nB; ++ui;
        if constexpr (ALIGN_EPI) { if (wr == 1) PG8_BAR; }
    }
    PG8_WAIT_V(0);
    if constexpr (!ALIGN_EPI) { if (wr == 0) PG8_BAR; }
    PG8_BAR;
    if constexpr (Epi::AFTER_DRAIN) { E.fused(acc, cur, wr, wc, fr, fq, lds, wid, lane); S.done(cur); }
#undef PG8_SA
#undef PG8_SB
#undef PG8_STAGE
#undef PG8_LDA
#undef PG8_LDB
#undef PG8_MMA
#undef PG8_WAIT_V
#undef PG8_WAIT_L
#undef PG8_BAR
#undef PG8_SCHED
}
}

namespace att {
#define ATT_LAS __attribute__((address_space(3)))
typedef unsigned short bf16_t;
using bf16x8 = __attribute__((ext_vector_type(8))) short;
using s16x4  = __attribute__((ext_vector_type(4))) short;
using f32x16 = __attribute__((ext_vector_type(16))) float;
using u32x4  = __attribute__((ext_vector_type(4))) unsigned;
constexpr int   D = 128, NW = 8, QBLK = 32, KVBLK = 64;
constexpr float SCALE = 0.088388347648318440f;
constexpr float THR = 8.f;
constexpr float NEG = -1.0e30f;
constexpr int   LD = 12288;
constexpr int   META_ROW = 24576;
constexpr int   SHM_V = KVBLK * D * 2, SHM_K = KVBLK * D * 2, SHM_ATTN = 2 * SHM_V + 2 * SHM_K + NW * 64 * 4;
#define KSWZ(row, colB) ((row) * 256 + ((colB) ^ (((row) & 7) << 4)))
#define SBAR() __builtin_amdgcn_sched_barrier(0)
__device__ __forceinline__ int crow(int r, int hi) { return (r & 3) + 8 * (r >> 2) + 4 * hi; }
__device__ __forceinline__ int lane_of() { int l; asm volatile("v_mbcnt_lo_u32_b32 %0, -1, 0\n\tv_mbcnt_hi_u32_b32 %0, -1, %0" : "=v"(l)); return l; }
__device__ __forceinline__ unsigned cvtpk(float lo, float hi) { unsigned r; asm volatile("v_cvt_pk_bf16_f32 %0, %1, %2" : "=v"(r) : "v"(lo), "v"(hi)); return r; }

struct NaCtx { int qrow, r0, kr_first, c, c0; const ATT_LAS float* rpb; };

__device__ __forceinline__ void partialSM(f32x16& p0, f32x16& p1, float& m_reg, float& mn, float& alpha) {
  constexpr float C = SCALE * 1.4426950408889634f;
  float pmax = p0[0];
#pragma unroll
  for (int r = 1; r < 16; ++r) pmax = fmaxf(pmax, p0[r]);
#pragma unroll
  for (int r = 0; r < 16; ++r) pmax = fmaxf(pmax, p1[r]);
  { auto rr = __builtin_amdgcn_permlane32_swap(__float_as_uint(pmax), __float_as_uint(pmax), false, false);
    pmax = fmaxf(__uint_as_float(rr[0]), __uint_as_float(rr[1])); }
  if (__builtin_expect(__all(pmax - m_reg <= THR / SCALE), 1)) { mn = m_reg; alpha = 1.f; }
  else { mn = fmaxf(m_reg, pmax); alpha = __builtin_amdgcn_exp2f((m_reg - mn) * C); m_reg = mn; }
  float mnC = -mn * C;
#pragma unroll
  for (int r = 0; r < 16; ++r) p0[r] = fmaf(p0[r], C, mnC);
#pragma unroll
  for (int r = 0; r < 16; ++r) p1[r] = fmaf(p1[r], C, mnC);
#pragma unroll
  for (int r = 0; r < 16; ++r) p0[r] = __builtin_amdgcn_exp2f(p0[r]);
}
__device__ __forceinline__ void finishSM(f32x16& p0, f32x16& p1, float alpha, float& l_reg, bf16x8& pa0, bf16x8& pa1, bf16x8& pa2, bf16x8& pa3) {
#pragma unroll
  for (int r = 0; r < 16; ++r) p1[r] = __builtin_amdgcn_exp2f(p1[r]);
  float ps = 0;
#pragma unroll
  for (int r = 0; r < 16; ++r) ps += p0[r];
#pragma unroll
  for (int r = 0; r < 16; ++r) ps += p1[r];
  { auto rr = __builtin_amdgcn_permlane32_swap(__float_as_uint(ps), __float_as_uint(ps), false, false);
    ps = __uint_as_float(rr[0]) + __uint_as_float(rr[1]); }
  l_reg = l_reg * alpha + ps;
#define PK4(P, BASE, OUT) do { unsigned a0 = cvtpk(P[BASE + 0], P[BASE + 1]), a1 = cvtpk(P[BASE + 2], P[BASE + 3]);   \
    unsigned b0 = cvtpk(P[BASE + 4], P[BASE + 5]), b1 = cvtpk(P[BASE + 6], P[BASE + 7]);                              \
    auto r0 = __builtin_amdgcn_permlane32_swap(a0, b0, false, false); auto r1 = __builtin_amdgcn_permlane32_swap(a1, b1, false, false); \
    u32x4 w = {r0[0], r1[0], r0[1], r1[1]}; OUT = *reinterpret_cast<bf16x8*>(&w); } while (0)
  PK4(p0, 0, pa0); PK4(p0, 8, pa1); PK4(p1, 0, pa2); PK4(p1, 8, pa3);
#undef PK4
}
__device__ __forceinline__ void qkt(f32x16& p0, f32x16& p1, const ATT_LAS char* Ks, const bf16x8* qr, int r32, int hi) {
  p0 = f32x16{}; p1 = f32x16{};
#pragma unroll
  for (int d0 = 0; d0 < 8; ++d0) { int cb = (d0 * 16 + hi * 8) * 2;
    bf16x8 b0 = *reinterpret_cast<const ATT_LAS bf16x8*>(Ks + KSWZ(r32, cb));
    bf16x8 b1 = *reinterpret_cast<const ATT_LAS bf16x8*>(Ks + KSWZ(32 + r32, cb));
    p0 = __builtin_amdgcn_mfma_f32_32x32x16_bf16(b0, qr[d0], p0, 0, 0, 0);
    p1 = __builtin_amdgcn_mfma_f32_32x32x16_bf16(b1, qr[d0], p1, 0, 0, 0); }
}
__device__ __forceinline__ int v_st(int k, int c) { const int kk = (k & ~0xC) | ((k & 4) << 1) | ((k & 8) >> 1); return ((kk >> 3) * 4 + (c >> 5)) * 512 + ((kk & 7) * 32 + (c & 31)) * 2; }
__device__ __forceinline__ int v_rd_base(int lane) { return ((lane & 3) << 3) | (((lane >> 2) & 3) << 6) | (((lane >> 4) & 1) << 5) | (((lane >> 5) & 1) << 8); }
constexpr int v_rd_off(int d0, int ks, int half) { return d0 * 512 + ks * 4096 + half * 2048; }
template <int OFF> __device__ __forceinline__ s16x4 tr_read(int vb) {
  s16x4 r; asm volatile("ds_read_b64_tr_b16 %0, %1 offset:%2" : "=&v"(r) : "v"(vb), "i"(OFF) : "memory"); return r;
}
template <int D0> __device__ __forceinline__ void pv_one(f32x16& od, int vb, bf16x8 pa0, bf16x8 pa1, bf16x8 pa2, bf16x8 pa3) {
  const s16x4 l0 = tr_read<v_rd_off(D0, 0, 0)>(vb), h0 = tr_read<v_rd_off(D0, 0, 1)>(vb), l1 = tr_read<v_rd_off(D0, 1, 0)>(vb), h1 = tr_read<v_rd_off(D0, 1, 1)>(vb);
  const s16x4 l2 = tr_read<v_rd_off(D0, 2, 0)>(vb), h2 = tr_read<v_rd_off(D0, 2, 1)>(vb), l3 = tr_read<v_rd_off(D0, 3, 0)>(vb), h3 = tr_read<v_rd_off(D0, 3, 1)>(vb);
  asm volatile("s_waitcnt lgkmcnt(0)" ::: "memory"); SBAR();
#define PK(L, H) (bf16x8){L[0], L[1], L[2], L[3], H[0], H[1], H[2], H[3]}
  od = __builtin_amdgcn_mfma_f32_32x32x16_bf16(pa0, PK(l0, h0), od, 0, 0, 0);
  od = __builtin_amdgcn_mfma_f32_32x32x16_bf16(pa1, PK(l1, h1), od, 0, 0, 0);
  od = __builtin_amdgcn_mfma_f32_32x32x16_bf16(pa2, PK(l2, h2), od, 0, 0, 0);
  od = __builtin_amdgcn_mfma_f32_32x32x16_bf16(pa3, PK(l3, h3), od, 0, 0, 0);
#undef PK
}
__device__ __forceinline__ void pv_d0(f32x16* o, int vb, bf16x8 pa0, bf16x8 pa1, bf16x8 pa2, bf16x8 pa3) {
  pv_one<0>(o[0], vb, pa0, pa1, pa2, pa3); pv_one<1>(o[1], vb, pa0, pa1, pa2, pa3); pv_one<2>(o[2], vb, pa0, pa1, pa2, pa3); pv_one<3>(o[3], vb, pa0, pa1, pa2, pa3);
}
template <bool IS_NA> __device__ __forceinline__ void mask_tile(f32x16& p0, f32x16& p1, int j, const NaCtx& na, int hi) {
  if constexpr (IS_NA) {
    const int kr = na.kr_first + (j - 1);
    if ((unsigned)(kr - na.r0) >= 8u) {
#pragma unroll
      for (int r = 0; r < 16; ++r) { p0[r] = NEG; p1[r] = NEG; }
    } else {
      const ATT_LAS float* rb = na.rpb + (kr - na.qrow + 7) * 31 + 15 - na.c + 4 * hi;
      const int dbase = 4 * hi - na.c0;
#pragma unroll
      for (int r = 0; r < 16; ++r) { const int kc = (r & 3) + 8 * (r >> 2);
        const float b0 = rb[kc], b1 = rb[kc + 32];
        p0[r] = ((unsigned)(kc + dbase) < 16u) ? p0[r] + b0 : NEG;
        p1[r] = ((unsigned)(kc + 32 + dbase) < 16u) ? p1[r] + b1 : NEG; }
    }
  }
}

typedef __amdgpu_buffer_rsrc_t rsrc_t;
__device__ __forceinline__ bf16x8 bld(rsrc_t rs, unsigned voff, unsigned soff) { auto v = __builtin_amdgcn_raw_buffer_load_b128(rs, (int)voff, (int)soff, 0); return __builtin_bit_cast(bf16x8, v); }
template <bool IS_NA>
__device__ __forceinline__ void attn_run(const rsrc_t rs, const unsigned qoffB  , const unsigned kcolB, const unsigned vcolB  ,
                                         const int krow1, const int NT, ATT_LAS char* lds, const NaCtx na, f32x16 (&o)[4], const int wid  ) {
  const int lane = lane_of(), tid = wid * 64 + lane, r32 = lane & 31, hi = lane >> 5;
  ATT_LAS char* V_lds = lds; ATT_LAS char* K_lds = lds + 2 * SHM_V;
  ATT_LAS float* wsf = (ATT_LAS float*)(lds + 2 * SHM_V + 2 * SHM_K) + wid * 64; ATT_LAS float* li_l = wsf; ATT_LAS float* al_l = wsf + 32;
  float m_reg = NEG, l_reg = 0; bf16x8 qr[8];
#pragma unroll
  for (int d = 0; d < 4; ++d) o[d] = f32x16{};
  { const unsigned qv = (unsigned)((wid * QBLK + r32) * LD + hi * 8) * 2u;
#pragma unroll
    for (int d0 = 0; d0 < 8; ++d0) qr[d0] = bld(rs, qv + d0 * 32, qoffB); }
  const int sr = tid >> 4, sc = (tid & 15) * 8, vst0 = v_st(sr, sc), vst1 = v_st(32 + sr, sc);
  const int vb0 = (int)(unsigned)(uintptr_t)V_lds + v_rd_base(lane);
  struct { bf16x8 vs0, vs1, ks0, ks1; } sr_[2];
#define TROW(j) ((j) == 0 ? META_ROW : krow1 + ((j) - 1) * KVBLK)
  const unsigned stv = (unsigned)(sr * LD + sc) * 2u;
#define SLOAD(i, j) do { const unsigned t0_ = (unsigned)TROW(j) * (unsigned)(LD * 2); sr_[i].vs0 = bld(rs, stv, t0_ + vcolB); sr_[i].vs1 = bld(rs, stv, t0_ + vcolB + 32u * LD * 2u); \
    sr_[i].ks0 = bld(rs, stv, t0_ + kcolB); sr_[i].ks1 = bld(rs, stv, t0_ + kcolB + 32u * LD * 2u); } while (0)
#define SWRITE(b, i) do { *(ATT_LAS bf16x8*)(V_lds + (b) * SHM_V + vst0) = sr_[i].vs0;          \
    *(ATT_LAS bf16x8*)(V_lds + (b) * SHM_V + vst1) = sr_[i].vs1; const int kc_ = sc * 2;               \
    *(ATT_LAS bf16x8*)(K_lds + (b) * SHM_K + KSWZ(sr, kc_)) = sr_[i].ks0;                       \
    *(ATT_LAS bf16x8*)(K_lds + (b) * SHM_K + KSWZ(32 + sr, kc_)) = sr_[i].ks1; } while (0)
#define SWAIT() asm volatile("s_waitcnt vmcnt(4)" ::: "memory")
#define RESC(a) do { if (__any((a) < 1.f)) { if (hi == 0) al_l[r32] = (a); asm volatile("s_waitcnt lgkmcnt(0)" ::: "memory"); \
    _Pragma("unroll") for (int d = 0; d < 4; ++d) _Pragma("unroll") for (int r = 0; r < 16; ++r) o[d][r] *= al_l[crow(r, hi)]; } } while (0)
  f32x16 pA0, pA1, pB0, pB1; float mnA, mnB, alA, alB; bf16x8 pa0, pa1, pa2, pa3;
  constexpr int SE = 0, SO = 1;
  __syncthreads();
  SLOAD(SE, 0); asm volatile("s_waitcnt vmcnt(0)" ::: "memory"); SWRITE(0, SE); __syncthreads();
  qkt(pA0, pA1, K_lds, qr, r32, hi);
#pragma unroll
  for (int r = 8; r < 16; ++r) pA0[r] = NEG;
#pragma unroll
  for (int r = 0; r < 16; ++r) pA1[r] = NEG;
  partialSM(pA0, pA1, m_reg, mnA, alA);
  SLOAD(SO, 1); if (2 < NT) SLOAD(SE, 2);
  SWAIT(); SWRITE(1, SO); __syncthreads();
  for (int j = 1; j + 2 < NT; j += 2) {
    SBAR(); qkt(pB0, pB1, K_lds + SHM_K, qr, r32, hi);
    finishSM(pA0, pA1, alA, l_reg, pa0, pa1, pa2, pa3); SBAR();
    if (j + 2 < NT) SLOAD(SO, j + 2); SBAR();
    pv_d0(o, vb0, pa0, pa1, pa2, pa3); mask_tile<IS_NA>(pB0, pB1, j, na, hi); partialSM(pB0, pB1, m_reg, mnB, alB);
    __syncthreads(); SWAIT(); SWRITE(0, SE);
    RESC(alB); __syncthreads();
    SBAR(); qkt(pA0, pA1, K_lds, qr, r32, hi);
    finishSM(pB0, pB1, alB, l_reg, pa0, pa1, pa2, pa3); SBAR();
    if (j + 3 < NT) SLOAD(SE, j + 3); SBAR();
    pv_d0(o, vb0 + SHM_V, pa0, pa1, pa2, pa3); mask_tile<IS_NA>(pA0, pA1, j + 1, na, hi); partialSM(pA0, pA1, m_reg, mnA, alA);
    __syncthreads(); SWAIT(); if (j + 2 < NT) SWRITE(1, SO);
    RESC(alA); __syncthreads();
  }
  SBAR(); qkt(pB0, pB1, K_lds + SHM_K, qr, r32, hi);
  finishSM(pA0, pA1, alA, l_reg, pa0, pa1, pa2, pa3); SBAR();
  pv_d0(o, vb0, pa0, pa1, pa2, pa3); mask_tile<IS_NA>(pB0, pB1, NT - 1, na, hi); partialSM(pB0, pB1, m_reg, mnB, alB);
  RESC(alB);
  finishSM(pB0, pB1, alB, l_reg, pa0, pa1, pa2, pa3); SBAR();
  pv_d0(o, vb0 + SHM_V, pa0, pa1, pa2, pa3);
  if (hi == 0) li_l[r32] = l_reg; asm volatile("s_waitcnt lgkmcnt(0)" ::: "memory");
#pragma unroll
  for (int r = 0; r < 16; ++r) { const float rl = __builtin_amdgcn_rcpf(li_l[crow(r, hi)]);
#pragma unroll
    for (int d = 0; d < 4; ++d) o[d][r] *= rl; }
#undef TROW
#undef SLOAD
#undef SWRITE
#undef SWAIT
#undef RESC
}
__device__ __forceinline__ float half_sum(float v) {
#pragma unroll
  for (int o = 1; o < 32; o <<= 1) v += __shfl_xor(v, o);
  return v;
}
}


namespace att2 {
using namespace att;
constexpr int KB = 16384, VB = 32768;
constexpr int L_K = 0, L_V = 2 * KB, L_WS = 2 * KB + 2 * VB, SHM2 = L_WS + NW * 64 * 4;
__device__ __forceinline__ void dma16(const rsrc_t rs, ATT_LAS char* dst, unsigned voff, unsigned soff) { __builtin_amdgcn_raw_ptr_buffer_load_lds(rs, (ATT_LAS void*)dst, 16, (int)voff, (int)soff, 0, 0); }
#define WAITBAR(N) asm volatile("s_waitcnt vmcnt(" #N ") lgkmcnt(0)\n\ts_barrier" ::: "memory")
template <int D0, int VH> __device__ __forceinline__ void pv_one2(f32x16& od, int vb, bf16x8 pa0, bf16x8 pa1, bf16x8 pa2, bf16x8 pa3) {
  constexpr int B = VH * 16384;
  const s16x4 l0 = tr_read<B + v_rd_off(D0, 0, 0)>(vb), h0 = tr_read<B + v_rd_off(D0, 0, 1)>(vb), l1 = tr_read<B + v_rd_off(D0, 1, 0)>(vb), h1 = tr_read<B + v_rd_off(D0, 1, 1)>(vb);
  const s16x4 l2 = tr_read<B + v_rd_off(D0, 2, 0)>(vb), h2 = tr_read<B + v_rd_off(D0, 2, 1)>(vb), l3 = tr_read<B + v_rd_off(D0, 3, 0)>(vb), h3 = tr_read<B + v_rd_off(D0, 3, 1)>(vb);
  asm volatile("s_waitcnt lgkmcnt(0)" ::: "memory"); SBAR();
#define PK(L, H) (bf16x8){L[0], L[1], L[2], L[3], H[0], H[1], H[2], H[3]}
  od = __builtin_amdgcn_mfma_f32_32x32x16_bf16(pa0, PK(l0, h0), od, 0, 0, 0);
  od = __builtin_amdgcn_mfma_f32_32x32x16_bf16(pa1, PK(l1, h1), od, 0, 0, 0);
  od = __builtin_amdgcn_mfma_f32_32x32x16_bf16(pa2, PK(l2, h2), od, 0, 0, 0);
  od = __builtin_amdgcn_mfma_f32_32x32x16_bf16(pa3, PK(l3, h3), od, 0, 0, 0);
#undef PK
}
__device__ __forceinline__ void pv8(f32x16* o, int vb, bf16x8 pa0, bf16x8 pa1, bf16x8 pa2, bf16x8 pa3) {
  pv_one2<0, 0>(o[0], vb, pa0, pa1, pa2, pa3); pv_one2<1, 0>(o[1], vb, pa0, pa1, pa2, pa3); pv_one2<2, 0>(o[2], vb, pa0, pa1, pa2, pa3); pv_one2<3, 0>(o[3], vb, pa0, pa1, pa2, pa3);
  pv_one2<0, 1>(o[4], vb, pa0, pa1, pa2, pa3); pv_one2<1, 1>(o[5], vb, pa0, pa1, pa2, pa3); pv_one2<2, 1>(o[6], vb, pa0, pa1, pa2, pa3); pv_one2<3, 1>(o[7], vb, pa0, pa1, pa2, pa3);
}
template <int BASE> __device__ __forceinline__ bf16x8 pk4t(const f32x16& P) {
  unsigned a0 = cvtpk(P[BASE + 0], P[BASE + 1]), a1 = cvtpk(P[BASE + 2], P[BASE + 3]), b0 = cvtpk(P[BASE + 4], P[BASE + 5]), b1 = cvtpk(P[BASE + 6], P[BASE + 7]);
  auto r0 = __builtin_amdgcn_permlane32_swap(a0, b0, false, false); auto r1 = __builtin_amdgcn_permlane32_swap(a1, b1, false, false);
  u32x4 w = {r0[0], r1[0], r0[1], r1[1]}; return *reinterpret_cast<bf16x8*>(&w);
}
#define TRV(D, KS, HF) tr_read<((D) >> 2) * 16384 + v_rd_off((D) & 3, KS, HF)>(vb)
#define PKF(L, H) (bf16x8){L[0], L[1], L[2], L[3], H[0], H[1], H[2], H[3]}
#define RD2(S, KS, D) do { S##l0 = TRV((D), KS, 0); S##h0 = TRV((D), KS, 1); S##l1 = TRV((D) + 1, KS, 0); S##h1 = TRV((D) + 1, KS, 1); } while (0)
#define GAPV(OD, PA, L, H, STMT) do { OD = __builtin_amdgcn_mfma_f32_32x32x16_bf16(PA, PKF(L, H), OD, 0, 0, 0); STMT SBAR(); } while (0)
__device__ __forceinline__ void pv8_softmax(f32x16* o, const int vb, bf16x8& pa0, bf16x8& pa1, bf16x8& pa2, const bf16x8 pa3, f32x16& p0, f32x16& p1, float& m_reg, float& al, float& ps) {
  constexpr float CSM = SCALE * 1.4426950408889634f;
  s16x4 Al0, Ah0, Al1, Ah1, Bl0, Bh0, Bl1, Bh1; float pm, mn, mnC;
  RD2(A, 0, 0); SBAR();
  asm volatile("s_waitcnt lgkmcnt(0)" ::: "memory"); SBAR();
  RD2(B, 0, 2); SBAR();
  GAPV(o[0], pa0, Al0, Ah0, pm = fmaxf(p0[0], p0[1]); pm = fmaxf(pm, p0[2]); pm = fmaxf(pm, p0[3]); pm = fmaxf(pm, p0[4]); pm = fmaxf(pm, p0[5]); asm volatile("" : "+v"(pm)););
  GAPV(o[1], pa0, Al1, Ah1, pm = fmaxf(pm, p0[6]); pm = fmaxf(pm, p0[7]); pm = fmaxf(pm, p0[8]); pm = fmaxf(pm, p0[9]); pm = fmaxf(pm, p0[10]); pm = fmaxf(pm, p0[11]); asm volatile("" : "+v"(pm)););
  asm volatile("s_waitcnt lgkmcnt(0)" ::: "memory"); SBAR();
  RD2(A, 0, 4); SBAR();
  GAPV(o[2], pa0, Bl0, Bh0, pm = fmaxf(pm, p0[12]); pm = fmaxf(pm, p0[13]); pm = fmaxf(pm, p0[14]); pm = fmaxf(pm, p0[15]); pm = fmaxf(pm, p1[0]); pm = fmaxf(pm, p1[1]); asm volatile("" : "+v"(pm)););
  GAPV(o[3], pa0, Bl1, Bh1, pm = fmaxf(pm, p1[2]); pm = fmaxf(pm, p1[3]); pm = fmaxf(pm, p1[4]); pm = fmaxf(pm, p1[5]); pm = fmaxf(pm, p1[6]); pm = fmaxf(pm, p1[7]); asm volatile("" : "+v"(pm)););
  asm volatile("s_waitcnt lgkmcnt(0)" ::: "memory"); SBAR();
  RD2(B, 0, 6); SBAR();
  GAPV(o[4], pa0, Al0, Ah0, pm = fmaxf(pm, p1[8]); pm = fmaxf(pm, p1[9]); pm = fmaxf(pm, p1[10]); pm = fmaxf(pm, p1[11]); pm = fmaxf(pm, p1[12]); pm = fmaxf(pm, p1[13]); asm volatile("" : "+v"(pm)););
  GAPV(o[5], pa0, Al1, Ah1, pm = fmaxf(pm, p1[14]); pm = fmaxf(pm, p1[15]); { auto rr_ = __builtin_amdgcn_permlane32_swap(__float_as_uint(pm), __float_as_uint(pm), false, false); pm = fmaxf(__uint_as_float(rr_[0]), __uint_as_float(rr_[1])); } asm volatile("" : "+v"(pm)););
  asm volatile("s_waitcnt lgkmcnt(0)" ::: "memory"); SBAR();
  RD2(A, 1, 0); SBAR();
  GAPV(o[6], pa0, Bl0, Bh0, if (__builtin_expect(__all(pm - m_reg <= THR / SCALE), 1)) { mn = m_reg; al = 1.f; } else { mn = fmaxf(m_reg, pm); al = __builtin_amdgcn_exp2f((m_reg - mn) * CSM); m_reg = mn; } mnC = -mn * CSM; asm volatile("" : "+v"(mnC)); asm volatile("" : "+v"(al)););
  GAPV(o[7], pa0, Bl1, Bh1, p0[0] = fmaf(p0[0], CSM, mnC); p0[1] = fmaf(p0[1], CSM, mnC); p0[2] = fmaf(p0[2], CSM, mnC); p0[3] = fmaf(p0[3], CSM, mnC); p0[4] = fmaf(p0[4], CSM, mnC); p0[5] = fmaf(p0[5], CSM, mnC); asm volatile("" : "+v"(p0)););
  asm volatile("s_waitcnt lgkmcnt(0)" ::: "memory"); SBAR();
  RD2(B, 1, 2); SBAR();
  GAPV(o[0], pa1, Al0, Ah0, p0[6] = fmaf(p0[6], CSM, mnC); p0[7] = fmaf(p0[7], CSM, mnC); p0[8] = fmaf(p0[8], CSM, mnC); p0[9] = fmaf(p0[9], CSM, mnC); p0[10] = fmaf(p0[10], CSM, mnC); p0[11] = fmaf(p0[11], CSM, mnC); asm volatile("" : "+v"(p0)););
  GAPV(o[1], pa1, Al1, Ah1, p0[12] = fmaf(p0[12], CSM, mnC); p0[13] = fmaf(p0[13], CSM, mnC); p0[14] = fmaf(p0[14], CSM, mnC); p0[15] = fmaf(p0[15], CSM, mnC); p1[0] = fmaf(p1[0], CSM, mnC); p1[1] = fmaf(p1[1], CSM, mnC); asm volatile("" : "+v"(p0)); asm volatile("" : "+v"(p1)););
  asm volatile("s_waitcnt lgkmcnt(0)" ::: "memory"); SBAR();
  RD2(A, 1, 4); SBAR();
  GAPV(o[2], pa1, Bl0, Bh0, p1[2] = fmaf(p1[2], CSM, mnC); p1[3] = fmaf(p1[3], CSM, mnC); p1[4] = fmaf(p1[4], CSM, mnC); p1[5] = fmaf(p1[5], CSM, mnC); p1[6] = fmaf(p1[6], CSM, mnC); p1[7] = fmaf(p1[7], CSM, mnC); asm volatile("" : "+v"(p1)););
  GAPV(o[3], pa1, Bl1, Bh1, p1[8] = fmaf(p1[8], CSM, mnC); p1[9] = fmaf(p1[9], CSM, mnC); p1[10] = fmaf(p1[10], CSM, mnC); p1[11] = fmaf(p1[11], CSM, mnC); p1[12] = fmaf(p1[12], CSM, mnC); p1[13] = fmaf(p1[13], CSM, mnC); asm volatile("" : "+v"(p1)););
  asm volatile("s_waitcnt lgkmcnt(0)" ::: "memory"); SBAR();
  RD2(B, 1, 6); SBAR();
  GAPV(o[4], pa1, Al0, Ah0, p1[14] = fmaf(p1[14], CSM, mnC); p1[15] = fmaf(p1[15], CSM, mnC); asm volatile("" : "+v"(p1)););
  GAPV(o[5], pa1, Al1, Ah1, p0[0] = __builtin_amdgcn_exp2f(p0[0]); p0[1] = __builtin_amdgcn_exp2f(p0[1]); p0[2] = __builtin_amdgcn_exp2f(p0[2]); asm volatile("" : "+v"(p0)););
  asm volatile("s_waitcnt lgkmcnt(0)" ::: "memory"); SBAR();
  RD2(A, 2, 0); SBAR();
  GAPV(o[6], pa1, Bl0, Bh0, p0[3] = __builtin_amdgcn_exp2f(p0[3]); p0[4] = __builtin_amdgcn_exp2f(p0[4]); p0[5] = __builtin_amdgcn_exp2f(p0[5]); asm volatile("" : "+v"(p0)););
  GAPV(o[7], pa1, Bl1, Bh1, p0[6] = __builtin_amdgcn_exp2f(p0[6]); p0[7] = __builtin_amdgcn_exp2f(p0[7]); p0[8] = __builtin_amdgcn_exp2f(p0[8]); asm volatile("" : "+v"(p0)););
  asm volatile("s_waitcnt lgkmcnt(0)" ::: "memory"); SBAR();
  RD2(B, 2, 2); SBAR();
  GAPV(o[0], pa2, Al0, Ah0, p0[9] = __builtin_amdgcn_exp2f(p0[9]); p0[10] = __builtin_amdgcn_exp2f(p0[10]); p0[11] = __builtin_amdgcn_exp2f(p0[11]); asm volatile("" : "+v"(p0)););
  GAPV(o[1], pa2, Al1, Ah1, p0[12] = __builtin_amdgcn_exp2f(p0[12]); p0[13] = __builtin_amdgcn_exp2f(p0[13]); p0[14] = __builtin_amdgcn_exp2f(p0[14]); asm volatile("" : "+v"(p0)););
  asm volatile("s_waitcnt lgkmcnt(0)" ::: "memory"); SBAR();
  RD2(A, 2, 4); SBAR();
  GAPV(o[2], pa2, Bl0, Bh0, p0[15] = __builtin_amdgcn_exp2f(p0[15]); p1[0] = __builtin_amdgcn_exp2f(p1[0]); p1[1] = __builtin_amdgcn_exp2f(p1[1]); asm volatile("" : "+v"(p0)); asm volatile("" : "+v"(p1)););
  GAPV(o[3], pa2, Bl1, Bh1, p1[2] = __builtin_amdgcn_exp2f(p1[2]); p1[3] = __builtin_amdgcn_exp2f(p1[3]); p1[4] = __builtin_amdgcn_exp2f(p1[4]); asm volatile("" : "+v"(p1)););
  asm volatile("s_waitcnt lgkmcnt(0)" ::: "memory"); SBAR();
  RD2(B, 2, 6); SBAR();
  GAPV(o[4], pa2, Al0, Ah0, p1[5] = __builtin_amdgcn_exp2f(p1[5]); p1[6] = __builtin_amdgcn_exp2f(p1[6]); p1[7] = __builtin_amdgcn_exp2f(p1[7]); asm volatile("" : "+v"(p1)););
  GAPV(o[5], pa2, Al1, Ah1, p1[8] = __builtin_amdgcn_exp2f(p1[8]); p1[9] = __builtin_amdgcn_exp2f(p1[9]); p1[10] = __builtin_amdgcn_exp2f(p1[10]); asm volatile("" : "+v"(p1)););
  asm volatile("s_waitcnt lgkmcnt(0)" ::: "memory"); SBAR();
  RD2(A, 3, 0); SBAR();
  GAPV(o[6], pa2, Bl0, Bh0, p1[11] = __builtin_amdgcn_exp2f(p1[11]); p1[12] = __builtin_amdgcn_exp2f(p1[12]); p1[13] = __builtin_amdgcn_exp2f(p1[13]); asm volatile("" : "+v"(p1)););
  GAPV(o[7], pa2, Bl1, Bh1, p1[14] = __builtin_amdgcn_exp2f(p1[14]); p1[15] = __builtin_amdgcn_exp2f(p1[15]); asm volatile("" : "+v"(p1)););
  asm volatile("s_waitcnt lgkmcnt(0)" ::: "memory"); SBAR();
  RD2(B, 3, 2); SBAR();
  GAPV(o[0], pa3, Al0, Ah0, ps = p0[0] + p0[1]; ps += p0[2]; ps += p0[3]; ps += p0[4]; ps += p0[5]; ps += p0[6]; ps += p0[7]; asm volatile("" : "+v"(ps)););
  GAPV(o[1], pa3, Al1, Ah1, ps += p0[8]; ps += p0[9]; ps += p0[10]; ps += p0[11]; ps += p0[12]; ps += p0[13]; ps += p0[14]; ps += p0[15]; asm volatile("" : "+v"(ps)););
  asm volatile("s_waitcnt lgkmcnt(0)" ::: "memory"); SBAR();
  RD2(A, 3, 4); SBAR();
  GAPV(o[2], pa3, Bl0, Bh0, ps += p1[0]; ps += p1[1]; ps += p1[2]; ps += p1[3]; ps += p1[4]; ps += p1[5]; ps += p1[6]; ps += p1[7]; asm volatile("" : "+v"(ps)););
  GAPV(o[3], pa3, Bl1, Bh1, ps += p1[8]; ps += p1[9]; ps += p1[10]; ps += p1[11]; ps += p1[12]; ps += p1[13]; ps += p1[14]; ps += p1[15]; asm volatile("" : "+v"(ps)););
  asm volatile("s_waitcnt lgkmcnt(0)" ::: "memory"); SBAR();
  RD2(B, 3, 6); SBAR();
  GAPV(o[4], pa3, Al0, Ah0, pa0 = pk4t<0>(p0); asm volatile("" : "+v"(pa0)););
  GAPV(o[5], pa3, Al1, Ah1, pa1 = pk4t<8>(p0); asm volatile("" : "+v"(pa1)););
  asm volatile("s_waitcnt lgkmcnt(0)" ::: "memory"); SBAR();
  GAPV(o[6], pa3, Bl0, Bh0, pa2 = pk4t<0>(p1); asm volatile("" : "+v"(pa2)););
  GAPV(o[7], pa3, Bl1, Bh1, );
}
#undef TRV
#undef RD2
#undef GAPV
#undef PKF
__device__ __forceinline__ void finish_tail(const f32x16& p1, float ps, float alpha, float& l_reg, bf16x8& pa3) {
  { auto rr = __builtin_amdgcn_permlane32_swap(__float_as_uint(ps), __float_as_uint(ps), false, false); ps = __uint_as_float(rr[0]) + __uint_as_float(rr[1]); }
  l_reg = l_reg * alpha + ps;
  pa3 = pk4t<8>(p1);
}
__device__ __forceinline__ void diff_run(const rsrc_t rs, const unsigned qoffB, const unsigned kcolB, const unsigned vcolB  ,
                                         const int krow1, const int NT, ATT_LAS char* lds, f32x16 (&o)[8], float (&rli)[16], const int wid  ) {
  int lane = lane_of(); asm volatile("" : "+v"(lane));
  const int tid = wid * 64 + lane, r32 = lane & 31, hi = lane >> 5;
  ATT_LAS float* wsf = (ATT_LAS float*)(lds + L_WS) + wid * 64; ATT_LAS float* li_l = wsf; ATT_LAS float* al_l = wsf + 32;
  float m_reg = NEG, l_reg = 0; bf16x8 qr[8];
#pragma unroll
  for (int d = 0; d < 8; ++d) o[d] = f32x16{};
  { const unsigned qv = (unsigned)((wid * QBLK + r32) * LD + hi * 8) * 2u;
#pragma unroll
    for (int d0 = 0; d0 < 8; ++d0) qr[d0] = bld(rs, qv + d0 * 32, qoffB); }
  const unsigned kvo = (unsigned)((tid >> 4) * LD * 2 + (((tid & 15) ^ ((tid >> 4) & 7)) << 4));
  const int kkb = (tid >> 7) * 8 + ((tid & 31) >> 2), kbr = (kkb & ~0xC) | ((kkb & 4) << 1) | ((kkb & 8) >> 1);
  const unsigned vvo = (unsigned)(kbr * LD * 2 + ((((tid >> 5) & 3) * 32 + (tid & 3) * 8) << 1));
  ATT_LAS char* kd = lds + L_K + wid * 1024; ATT_LAS char* vd = lds + L_V + wid * 1024;
  constexpr unsigned R32 = 32u * LD * 2u;
#define TROW(j) ((j) == 0 ? META_ROW : krow1 + ((j) - 1) * KVBLK)
#define DMA_K(j, b) do { const unsigned t0_ = (unsigned)TROW(j) * (unsigned)(LD * 2) + kcolB; dma16(rs, kd + (b) * KB, kvo, t0_); dma16(rs, kd + (b) * KB + 8192, kvo, t0_ + R32); } while (0)
#define DMA_V(j, b) do { const unsigned t0_ = (unsigned)TROW(j) * (unsigned)(LD * 2) + vcolB; dma16(rs, vd + (b) * VB, vvo, t0_); dma16(rs, vd + (b) * VB + 8192, vvo, t0_ + R32); \
    dma16(rs, vd + (b) * VB + 16384, vvo, t0_ + 256u); dma16(rs, vd + (b) * VB + 24576, vvo, t0_ + R32 + 256u); } while (0)
#define RESC(a) do { if (__any((a) < 1.f)) { if (hi == 0) al_l[r32] = (a); asm volatile("s_waitcnt lgkmcnt(0)" ::: "memory"); \
    _Pragma("unroll") for (int d = 0; d < 8; ++d) _Pragma("unroll") for (int r = 0; r < 16; ++r) o[d][r] *= al_l[crow(r, hi)]; } } while (0)
  const int vb0 = (int)(unsigned)(uintptr_t)(lds + L_V) + v_rd_base(lane);
  f32x16 p0, p1; float mn, al; bf16x8 pa0, pa1, pa2, pa3;
  asm volatile("s_waitcnt vmcnt(0) lgkmcnt(0)" ::: "memory"); __builtin_amdgcn_s_barrier();
  DMA_K(0, 0); DMA_K(1, 1); DMA_V(0, 0);
  WAITBAR(6);
  {
    SBAR(); qkt(p0, p1, lds + L_K, qr, r32, hi);
#pragma unroll
    for (int r = 8; r < 16; ++r) p0[r] = NEG;
#pragma unroll
    for (int r = 0; r < 16; ++r) p1[r] = NEG;
    WAITBAR(6);
    { const int jn = 2 < NT ? 2 : NT - 1; DMA_K(jn, 0); }
    partialSM(p0, p1, m_reg, mn, al); finishSM(p0, p1, al, l_reg, pa0, pa1, pa2, pa3);
    WAITBAR(6);
    { const int jn = 1 < NT ? 1 : NT - 1; DMA_V(jn, 1); }
  }
  for (int j = 1; j < NT; ++j) {
    const int jb = j & 1;
    int r32o = r32; asm volatile("" : "+v"(r32o));
    SBAR(); qkt(p0, p1, lds + L_K + jb * KB, qr, r32o, hi);
    WAITBAR(6);
    { const int jn = j + 2 < NT ? j + 2 : NT - 1; DMA_K(jn, jb); }
    float ps; pv8_softmax(o, vb0 + (jb ^ 1) * VB, pa0, pa1, pa2, pa3, p0, p1, m_reg, al, ps);
    RESC(al);
    finish_tail(p1, ps, al, l_reg, pa3);
    WAITBAR(6);
    { const int jn = j + 1 < NT ? j + 1 : NT - 1; DMA_V(jn, jb ^ 1); }
  }
  WAITBAR(0);
  pv8(o, vb0 + ((NT - 1) & 1) * VB, pa0, pa1, pa2, pa3);
  if (hi == 0) li_l[r32] = l_reg; asm volatile("s_waitcnt lgkmcnt(0)" ::: "memory");
#pragma unroll
  for (int r = 0; r < 16; ++r) rli[r] = __builtin_amdgcn_rcpf(li_l[crow(r, hi)]);
#undef TROW
#undef DMA_K
#undef DMA_V
#undef RESC
}
#undef WAITBAR
}


#ifndef PROBE_FOLD
#define PROBE_FOLD 0
#endif
#ifndef MK_N_LAUNCHES
#define MK_N_LAUNCHES 1
#endif
constexpr int NWAVES = 8;
constexpr int N_PHASES = 12;
constexpr int N_LAUNCHES = MK_N_LAUNCHES;

constexpr int DM = 4096, DFF = 11008, NMETA = 16;
constexpr int S_P = 8192, S_S = 4096, NB_S = 4;
constexpr int NTOK = S_P + NB_S * S_S;
constexpr int MP = NTOK + 256;
constexpr int NA_W = 2048, DF_W = 2048, IN_W = 12288;
constexpr int C_QNA = 0, C_KNA = 2048, C_VNA = 4096, C_QD = 6144, C_KD = 8192, C_VD = 10240;
constexpr float EPS = 1e-6f, SUBLN_EPS = 1e-5f, LAM_INIT = 0.2f;

constexpr size_t MiB = 1u << 20;
constexpr size_t WS_CTL = 0, CTL_ZERO_BYTES = 1 * MiB;
constexpr size_t SZ_WA = (size_t)2 * DFF * DM * 2, SZ_WD = (size_t)DM * DFF * 2, SZ_WIN = (size_t)IN_W * DM * 2, SZ_WOUT = (size_t)DM * DM * 2;
constexpr size_t WS_WA = 1 * MiB, WS_WD = WS_WA + SZ_WA, WS_WIN = WS_WD + SZ_WD, WS_WOUT = WS_WIN + SZ_WIN;
constexpr size_t WS_HMETA = WS_WOUT + SZ_WOUT;
constexpr size_t WS_RSTD = WS_HMETA + (size_t)NMETA * DM * 4;
constexpr size_t WS_SSQP = WS_RSTD + (size_t)MP * 4 + 3072;
constexpr size_t WS_HN = WS_SSQP + (size_t)NTOK * 64 * 4;
constexpr size_t WS_HB = WS_HN + (size_t)MP * DM * 2;
constexpr size_t WS_BIG = WS_HB + (size_t)MP * DM * 2;
constexpr size_t WS_SCR = WS_BIG + (size_t)MP * IN_W * 2;
constexpr int L_MAX = NMETA + S_P;
constexpr size_t WS_ROPE = WS_SCR + (size_t)256 * 2 * 64 * 512 * 4;
constexpr size_t WS_END = WS_ROPE + (size_t)L_MAX * 32 * 4;
static_assert(WS_SSQP % 256 == 0 && WS_HN % 256 == 0, "alignment");
constexpr size_t WS_H3 = WS_HN;
constexpr int CW_BAR = 4096;

constexpr int RING_OFF = 0, RING_BYTES = 131072;
constexpr int ATT_RPB_OFF = 69632, ATT_SSQ_OFF = ATT_RPB_OFF + 2048;
constexpr int TR_BYTES = 64 * 65 * 4;
constexpr int LDSCTL_OFF = 143360, MISC_OFF = LDSCTL_OFF + 320;
constexpr int LDS_BYTES = 147456;
static_assert(att2::SHM2 <= RING_BYTES && NWAVES * TR_BYTES <= LDSCTL_OFF && att::SHM_ATTN <= ATT_RPB_OFF && ATT_SSQ_OFF + 1024 <= LDSCTL_OFF && MISC_OFF + 128 <= LDS_BYTES, "LDS map");

#define GAS __attribute__((address_space(1)))
#define LAS __attribute__((address_space(3)))
typedef unsigned short bf16;
typedef unsigned v4u __attribute__((ext_vector_type(4)));
typedef float f32x4 __attribute__((ext_vector_type(4)));
typedef short bf16x8 __attribute__((ext_vector_type(8)));
typedef GAS unsigned gu32;
typedef GAS unsigned long long gu64;
#define RLX_AGENT __ATOMIC_RELAXED, __HIP_MEMORY_SCOPE_AGENT
#define LDS_WAIT() asm volatile("s_waitcnt lgkmcnt(0)" ::: "memory")
#define VM_WAIT() asm volatile("s_waitcnt vmcnt(0)" ::: "memory")
__device__ __forceinline__ unsigned long long rt() { return __builtin_amdgcn_s_memrealtime(); }
__device__ __forceinline__ unsigned f2bf(float f) { unsigned u = __builtin_bit_cast(unsigned, f); return (u + 0x7fffu + ((u >> 16) & 1u)) >> 16; }
__device__ __forceinline__ unsigned pk2(float lo, float hi) { return f2bf(lo) | (f2bf(hi) << 16); }

#define XB_TMO      128
#define XB_XCNT(j)  (256  + 64 * (j))
#define XB_XSUB(j)  (1280 + 64 * (j))
#define XB_XGEN(j)  (2304 + 64 * (j))
#define XB_TOP      3328
#define XB_TOPGEN   3392
#define XCD_BAR_WORDS 3456
#define XB_SPIN_CAP (1u << 18)

__device__ __forceinline__ unsigned xb_ld(unsigned* p)              { return __hip_atomic_load(p, __ATOMIC_RELAXED, __HIP_MEMORY_SCOPE_AGENT); }
__device__ __forceinline__ unsigned xb_add(unsigned* p, unsigned v) { return __hip_atomic_fetch_add(p, v, __ATOMIC_RELAXED, __HIP_MEMORY_SCOPE_AGENT); }
__device__ __forceinline__ unsigned xb_xcc_id() { return (unsigned)__builtin_amdgcn_s_getreg((3 << 11) | 20) & 0xFu; }
#define XB_SPIN(cond, bar) do { unsigned _sp = 0; while (cond) { __builtin_amdgcn_s_sleep(1); \
    if ((++_sp & 255u) == 0u) { if (xb_ld(&(bar)[XB_TMO])) break; if (_sp > XB_SPIN_CAP) { atomicAdd(&(bar)[XB_TMO], 1u); break; } } } } while (0)

struct XcdBarrier {
    unsigned* bar; unsigned x;
    volatile LAS unsigned* st;
};

__device__ __forceinline__ XcdBarrier xcd_barrier_post(unsigned* bar, volatile LAS unsigned* st, const int tid_) {
    XcdBarrier b; b.bar = bar; b.x = xb_xcc_id(); b.st = st;
    if (tid_ == 0) (void)xb_add(&bar[XB_XCNT(b.x)], 1u);
    return b;
}
__device__ __forceinline__ void xcd_barrier_complete(unsigned* bar, unsigned x, unsigned& nloc, unsigned& nx) {
    const unsigned G = gridDim.x * gridDim.y * gridDim.z;
    unsigned sum, cnt, mine, sp = 0u;
    for (;;) {
        sum = 0u; cnt = 0u; mine = 0u;
#pragma unroll
        for (unsigned j = 0; j < 16; ++j) { const unsigned c = xb_ld(&bar[XB_XCNT(j)]); sum += c; cnt += (c > 0u) ? 1u : 0u; mine = (j == x) ? c : mine; }
        if (sum == G) break;
        __builtin_amdgcn_s_sleep(1);
        if ((++sp & 255u) == 0u) { if (xb_ld(&bar[XB_TMO])) break; if (sp > XB_SPIN_CAP) { atomicAdd(&bar[XB_TMO], 1u); break; } }
    }
    nloc = mine > 0u ? mine : 1u; nx = cnt > 0u ? cnt : 1u;
}

__device__ __forceinline__ void xcd_barrier(const XcdBarrier& b, const int tid_) {
    asm volatile("s_waitcnt vmcnt(0)" ::: "memory");
    __syncthreads();
    if (tid_ == 0) {
        unsigned* bar = b.bar;
        __builtin_amdgcn_s_waitcnt(0);
        unsigned nloc = b.st[0], nx = b.st[1];
        if (nloc == 0u) { xcd_barrier_complete(bar, b.x, nloc, nx); b.st[0] = nloc; b.st[1] = nx; }
        const unsigned old = xb_add(&bar[XB_XSUB(b.x)], 1u);
        const unsigned gen = old / nloc;
        if (old + 1u == (gen + 1u) * nloc) {
            __builtin_amdgcn_fence(__ATOMIC_RELEASE, "agent");
            asm volatile("s_waitcnt vmcnt(0)" ::: "memory");
            const unsigned og = xb_add(&bar[XB_TOP], 1u);
            const unsigned tg = og / nx;
            if (og + 1u == (tg + 1u) * nx) xb_add(&bar[XB_TOPGEN], 1u);
            else XB_SPIN(xb_ld(&bar[XB_TOPGEN]) == tg, bar);
            __builtin_amdgcn_fence(__ATOMIC_ACQUIRE, "agent");
            xb_add(&bar[XB_XGEN(b.x)], 1u);
            asm volatile("s_waitcnt vmcnt(0)" ::: "memory");
        } else {
            XB_SPIN(xb_ld(&bar[XB_XGEN(b.x)]) == gen, bar);
            __builtin_amdgcn_fence(__ATOMIC_ACQUIRE, "agent");
            asm volatile("s_waitcnt vmcnt(0)" ::: "memory");
        }
    }
    __syncthreads();
}


struct Frame {
    LAS unsigned char* lds;
    volatile LAS unsigned* MISC;
    gu32* ctl;
    int wave;
    __device__ __forceinline__ int lane_now() const { return att::lane_of(); }
    int vcu, G;
};
__device__ __forceinline__ float wave_sum(float v) {
#pragma unroll
    for (int o = 1; o < 64; o <<= 1) v += __shfl_xor(v, o);
    return v;
}
__device__ __forceinline__ unsigned short f2bf_s(float f) { return (unsigned short)f2bf(f); }

__device__ __forceinline__ void transpose_item(const float* __restrict__ W, int K, int N, bf16* __restrict__ WT, int mode, LAS float* scr, int item, int lane, const float* __restrict__ gk = nullptr) {
    const int nblk = N / 64, kb = item / nblk, nb = item - kb * nblk, k0 = 64 * kb, n0 = 64 * nb;
    const int q = lane & 15, kr = lane >> 4;
    f32x4 v[16];
#pragma unroll
    for (int i = 0; i < 16; ++i) v[i] = *(const f32x4*)(W + (size_t)(k0 + 4 * i + kr) * N + n0 + 4 * q);
    if (gk) {
#pragma unroll
        for (int i = 0; i < 16; ++i) v[i] = v[i] * gk[k0 + 4 * i + kr]; }
#pragma unroll
    for (int i = 0; i < 16; ++i) { LAS float* s = scr + (4 * i + kr) * 65 + 4 * q; s[0] = v[i].x; s[1] = v[i].y; s[2] = v[i].z; s[3] = v[i].w; }
    LDS_WAIT(); asm volatile("" ::: "memory");
    const int c = lane & 7;
#pragma unroll
    for (int j = 0; j < 8; ++j) { const int n = 8 * j + (lane >> 3); const LAS float* s = scr + (8 * c) * 65 + n;
        v4u o; o.x = pk2(s[0 * 65], s[1 * 65]); o.y = pk2(s[2 * 65], s[3 * 65]); o.z = pk2(s[4 * 65], s[5 * 65]); o.w = pk2(s[6 * 65], s[7 * 65]);
        const int ng = n0 + n; const int row = mode == 0 ? ng : 256 * (ng >> 7) + 128 * (mode - 1) + (ng & 127);
        *(v4u*)(WT + (size_t)row * K + k0 + 8 * c) = o; }
    LDS_WAIT(); asm volatile("" ::: "memory");
}
template <bool OUT_F32>
__device__ __forceinline__ void rms_row(const float* __restrict__ xrow, const float* __restrict__ g, void* orow, int lane) {
    const f32x4* xr = (const f32x4*)xrow + lane; const f32x4* gr = (const f32x4*)g + lane;
    f32x4 v[16]; float s = 0.f;
#pragma unroll
    for (int j = 0; j < 16; ++j) { v[j] = xr[64 * j]; s += (v[j].x * v[j].x + v[j].y * v[j].y) + (v[j].z * v[j].z + v[j].w * v[j].w); }
    const float rstd = 1.f / sqrtf(wave_sum(s) * (1.f / DM) + EPS);
    if constexpr (OUT_F32) { f32x4* o = (f32x4*)orow + lane;
#pragma unroll
        for (int j = 0; j < 16; ++j) { const f32x4 gg = gr[64 * j]; o[64 * j] = v[j] * rstd * gg; } }
    else { unsigned long long* o8 = (unsigned long long*)orow + lane;
#pragma unroll
        for (int j = 0; j < 16; ++j) { const f32x4 gg = gr[64 * j]; const f32x4 y = v[j] * rstd * gg;
            o8[64 * j] = (unsigned long long)pk2(y.x, y.y) | ((unsigned long long)pk2(y.z, y.w) << 32); } }
}
__device__ __forceinline__ void zero_row_bf16(bf16* orow, int lane) {
    unsigned long long* o8 = (unsigned long long*)orow + lane;
#pragma unroll
    for (int j = 0; j < 16; ++j) o8[64 * j] = 0ull;
}

struct Args { const float* in[22]; float* out; unsigned char* ws; int ph_lo, ph_hi, probe, pad; };
typedef const Args __attribute__((address_space(4)))* ArgsP;
#define ARGS_HERE(name) ArgsP name = (ArgsP)__builtin_amdgcn_kernarg_segment_ptr(); asm volatile("" : "+s"(name))

__device__ __forceinline__ void rope_consts(int i, float& rh, float& rl) {
    constexpr float RH[16] = {0x1.45c0000000000p-3f, 0x1.1f00000000000p-4f, 0x1.f980000000000p-6f, 0x1.bd40000000000p-7f, 0x1.8800000000000p-8f, 0x1.5940000000000p-9f, 0x1.3040000000000p-10f, 0x1.0bc0000000000p-11f, 0x1.d800000000000p-13f, 0x1.9f80000000000p-14f, 0x1.6e00000000000p-15f, 0x1.4240000000000p-16f, 0x1.1c00000000000p-17f, 0x1.f440000000000p-19f, 0x1.b880000000000p-20f, 0x1.8400000000000p-21f};
    constexpr float RL[16] = {0x1.9836e40000000p-14f, 0x1.30b61c0000000p-16f, 0x1.600ce80000000p-17f, 0x1.cae3200000000p-19f, 0x1.f6072c0000000p-19f, 0x1.b4dc9a0000000p-20f, 0x1.68c2f60000000p-25f, 0x1.c83dda0000000p-22f, 0x1.9a44960000000p-27f, 0x1.d334540000000p-25f, 0x1.2a1e800000000p-26f, 0x1.cffd9e0000000p-27f, 0x1.0312900000000p-31f, 0x1.19196a0000000p-32f, 0x1.df43180000000p-32f, 0x1.0e74a40000000p-33f};
    rh = RH[0]; rl = RL[0];
#pragma unroll
    for (int k = 1; k < 16; ++k) if (i == k) { rh = RH[k]; rl = RL[k]; }
}
__device__ __forceinline__ void p_weights(Frame& F, ArgsP a, const int set, const int wrank, const int nwaves) {
    LAS float* scr = (LAS float*)(F.lds + RING_OFF + F.wave * TR_BYTES);
    const int lane = F.lane_now();
    unsigned char* ws = a->ws;
    constexpr int I_G = (DM / 64) * (DFF / 64), I_D = (DFF / 64) * (DM / 64), I_IN = (DM / 64) * (IN_W / 64), I_OUT = (DM / 64) * (DM / 64);
    if (set == 0) {
        for (int it = wrank; it < 2 * I_G + I_D + I_OUT; it += nwaves) {
            int r = it;
            if (r < I_G) { transpose_item(a->in[4], DM, DFF, (bf16*)(ws + WS_WA), 1, scr, r, lane, a->in[3]); continue; } r -= I_G;
            if (r < I_G) { transpose_item(a->in[5], DM, DFF, (bf16*)(ws + WS_WA), 2, scr, r, lane, a->in[3]); continue; } r -= I_G;
            if (r < I_D) { transpose_item(a->in[6], DFF, DM, (bf16*)(ws + WS_WD), 0, scr, r, lane); continue; } r -= I_D;
            transpose_item(a->in[16], DM, DM, (bf16*)(ws + WS_WOUT), 0, scr, r, lane);
        }
    } else if (set == 1) {
        for (int it = wrank; it < I_IN; it += nwaves) transpose_item(a->in[8], DM, IN_W, (bf16*)(ws + WS_WIN), 0, scr, it, lane, a->in[7]);
    } else if (set == 2) {
        for (int it = wrank; it < 2 * I_G; it += nwaves) {
            if (it < I_G) transpose_item(a->in[18], DM, DFF, (bf16*)(ws + WS_WA), 1, scr, it, lane, a->in[17]);
            else transpose_item(a->in[19], DM, DFF, (bf16*)(ws + WS_WA), 2, scr, it - I_G, lane, a->in[17]);
        }
    } else {
        for (int it = wrank; it < I_D; it += nwaves) transpose_item(a->in[20], DFF, DM, (bf16*)(ws + WS_WD), 0, scr, it, lane);
    }
}
__device__ __forceinline__ int idle_rank(const int nwg, const int G, const int c, int& nidle) {
    const int last = (nwg + G - 1) / G - 1, first_idle = nwg - last * G;
    nidle = G - first_idle; return c >= first_idle ? c - first_idle : -1;
}
__device__ __forceinline__ void p0_prologue(Frame& F, ArgsP a) {
    {
      float* tab = (float*)(a->ws + WS_ROPE); const int t0 = (F.vcu * NWAVES + F.wave) * 64 + F.lane_now();
      for (int t = t0; t < L_MAX * 16; t += F.G * NWAVES * 64) { const int pos = t >> 4, i = t & 15; float rh, rl; rope_consts(i, rh, rl);
          const float pf = (float)pos, ang = fmaf(pf, rl, __builtin_amdgcn_fractf(pf * rh));
          tab[pos * 32 + i] = __builtin_amdgcn_cosf(ang); tab[pos * 32 + 16 + i] = __builtin_amdgcn_sinf(ang); } }
    p_weights(F, a, 0, F.vcu * NWAVES + F.wave, F.G * NWAVES);
    const int gw = F.vcu * NWAVES + F.wave, NGW = F.G * NWAVES, lane = F.lane_now();
    bf16* HN = (bf16*)(a->ws + WS_HN); float* RSTD = (float*)(a->ws + WS_RSTD);
    for (int m = gw; m < MP; m += NGW) {
        if (m < NTOK + NMETA) { const float* x = m < S_P ? a->in[0] + (size_t)m * DM : (m < NTOK ? a->in[1] + (size_t)(m - S_P) * DM : a->in[2] + (size_t)(m - NTOK) * DM);
            const f32x4* xr = (const f32x4*)x + lane; unsigned long long* o8 = (unsigned long long*)(HN + (size_t)m * DM) + lane; f32x4 v[16]; float s = 0.f;
#pragma unroll
            for (int j = 0; j < 16; ++j) { v[j] = xr[64 * j]; s += (v[j].x * v[j].x + v[j].y * v[j].y) + (v[j].z * v[j].z + v[j].w * v[j].w); }
#pragma unroll
            for (int j = 0; j < 16; ++j) o8[64 * j] = (unsigned long long)pk2(v[j].x, v[j].y) | ((unsigned long long)pk2(v[j].z, v[j].w) << 32);
            s = wave_sum(s); if (lane == 0) RSTD[m] = 1.f / sqrtf(s * (1.f / DM) + EPS); }
        else { zero_row_bf16(HN + (size_t)m * DM, lane); if (lane == 0) RSTD[m] = 1.f; }
    }
}
__device__ __forceinline__ void p_stats(Frame& F, ArgsP a, const int which) {
    const int gw = F.vcu * NWAVES + F.wave, NGW = F.G * NWAVES, lane = F.lane_now();
    const float* SSQP = (const float*)(a->ws + WS_SSQP); float* RSTD = (float*)(a->ws + WS_RSTD);
    for (int m = gw; m < NTOK; m += NGW) { const float s = wave_sum(SSQP[(size_t)m * 64 + lane]); if (lane == 0) RSTD[m] = 1.f / sqrtf(s * (1.f / DM) + EPS); }
    if (which == 1) { const float* HM = (const float*)(a->ws + WS_HMETA);
        for (int i = gw; i < NMETA; i += NGW) { const f32x4* xr = (const f32x4*)(HM + (size_t)i * DM) + lane; float s = 0.f;
#pragma unroll
            for (int j = 0; j < 16; ++j) { const f32x4 v = xr[64 * j]; s += (v.x * v.x + v.y * v.y) + (v.z * v.z + v.w * v.w); }
            s = wave_sum(s); if (lane == 0) RSTD[NTOK + i] = 1.f / sqrtf(s * (1.f / DM) + EPS); } }
}
template <class Epi> __device__ __forceinline__ void meta_gemm(Frame& F, const bf16* __restrict__ A16, const int lda, const bf16* __restrict__ Bt, const int K, const int nblk, const Epi& E) {
    LAS f32x4* red = (LAS f32x4*)(F.lds + RING_OFF);
    const int lane = F.lane_now(), row = lane & 15, quad = lane >> 4, kw = K / NWAVES;
    for (int cb = F.vcu; cb < nblk; cb += F.G) {
        const bf16* ap = A16 + (size_t)row * lda + F.wave * kw + quad * 8;
        const bf16* bp = Bt + (size_t)(E.brow(cb) + row) * K + F.wave * kw + quad * 8;
        f32x4 acc = {0.f, 0.f, 0.f, 0.f};
#pragma unroll 4
        for (int k = 0; k < kw; k += 32) { const bf16x8 av = *(const bf16x8*)(ap + k), bv = *(const bf16x8*)(bp + k); acc = __builtin_amdgcn_mfma_f32_16x16x32_bf16(bv, av, acc, 0, 0, 0); }
        __syncthreads();
        red[F.wave * 64 + lane] = acc;
        __syncthreads();
        if (F.wave == 0) { f32x4 s = red[lane];
#pragma unroll
            for (int w = 1; w < NWAVES; ++w) s = s + red[w * 64 + lane];
            E(cb, row, 4 * quad, s); }
    }
    __syncthreads();
}
struct MetaEpiDown {
    const float* xm; float* hm; bf16* hb;
    __device__ __forceinline__ int brow(int cb) const { return 16 * cb; }
    __device__ __forceinline__ void operator()(int cb, int r, int c4, f32x4 s) const { const int col = 16 * cb + c4;
        const f32x4 h = *(const f32x4*)(xm + (size_t)r * DM + col) + s * 0.5f; *(f32x4*)(hm + (size_t)r * DM + col) = h;
        *(unsigned long long*)(hb + (size_t)(NTOK + r) * DM + col) = (unsigned long long)pk2(h.x, h.y) | ((unsigned long long)pk2(h.z, h.w) << 32); }
};
struct MetaEpiKV {
    const float* rstd; bf16* pr; const float* tab;
    __device__ __forceinline__ int brow(int cb) const { const int c32 = 32 * cb, seg = c32 >> 11; return (seg == 0 ? C_KNA : seg == 1 ? C_VNA : seg == 2 ? C_KD : C_VD) + (c32 & 2047); }
    __device__ __forceinline__ void operator()(int cb, int r, int c4, f32x4 s0, f32x4 s1) const { const float sc = rstd[NTOK + r]; f32x4 v0 = s0 * sc, v1 = s1 * sc; const int col = brow(cb) + c4;
        if (col >= C_KD && col < C_VD && (col & 127) < 16) {
            const f32x4 c = *(const f32x4*)(tab + r * 32 + c4), s = *(const f32x4*)(tab + r * 32 + 16 + c4); const f32x4 x1 = v0, x2 = v1; v0 = x1 * c - x2 * s; v1 = x1 * s + x2 * c; }
        bf16* p = pr + (size_t)(NTOK + r) * IN_W + col;
        *(unsigned long long*)p = (unsigned long long)pk2(v0.x, v0.y) | ((unsigned long long)pk2(v0.z, v0.w) << 32);
        *(unsigned long long*)(p + 16) = (unsigned long long)pk2(v1.x, v1.y) | ((unsigned long long)pk2(v1.z, v1.w) << 32);
#pragma unroll
        for (int z = 1; z < 4; ++z) { *(unsigned long long*)(p + (size_t)16 * z * IN_W) = 0ull; *(unsigned long long*)(p + (size_t)16 * z * IN_W + 16) = 0ull; } }
};
template <class Epi> __device__ __forceinline__ void meta_gemm2(Frame& F, const bf16* __restrict__ A16, const int lda, const bf16* __restrict__ Bt, const int K, const int nblk, const Epi& E) {
    LAS f32x4* red = (LAS f32x4*)(F.lds + RING_OFF);
    const int lane = F.lane_now(), row = lane & 15, quad = lane >> 4, kw = K / NWAVES;
    for (int cb = F.vcu; cb < nblk; cb += F.G) {
        const bf16* ap = A16 + (size_t)row * lda + F.wave * kw + quad * 8;
        const bf16* bp = Bt + (size_t)(E.brow(cb) + row) * K + F.wave * kw + quad * 8;
        f32x4 acc0 = {0.f, 0.f, 0.f, 0.f}, acc1 = acc0;
#pragma unroll 4
        for (int k = 0; k < kw; k += 32) { const bf16x8 av = *(const bf16x8*)(ap + k), b0 = *(const bf16x8*)(bp + k), b1 = *(const bf16x8*)(bp + (size_t)16 * K + k);
            acc0 = __builtin_amdgcn_mfma_f32_16x16x32_bf16(b0, av, acc0, 0, 0, 0); acc1 = __builtin_amdgcn_mfma_f32_16x16x32_bf16(b1, av, acc1, 0, 0, 0); }
        __syncthreads();
        red[(F.wave * 64 + lane) * 2] = acc0; red[(F.wave * 64 + lane) * 2 + 1] = acc1;
        __syncthreads();
        if (F.wave == 0) { f32x4 s0 = red[lane * 2], s1 = red[lane * 2 + 1];
#pragma unroll
            for (int w = 1; w < NWAVES; ++w) { s0 = s0 + red[(w * 64 + lane) * 2]; s1 = s1 + red[(w * 64 + lane) * 2 + 1]; }
            E(cb, row, 4 * quad, s0, s1); }
    }
    __syncthreads();
}
__device__ __forceinline__ void p_final(Frame& F, ArgsP a) {
    const int gw = F.vcu * NWAVES + F.wave, NGW = F.G * NWAVES, lane = F.lane_now();
    const bf16* H3 = (const bf16*)(a->ws + WS_H3); const float* SSQP = (const float*)(a->ws + WS_SSQP); const f32x4* gr = (const f32x4*)a->in[21] + lane;
    for (int m = gw; m < NTOK; m += NGW) {
        const float rstd = 1.f / sqrtf(wave_sum(SSQP[(size_t)m * 64 + lane]) * (1.f / DM) + EPS);
        const unsigned long long* hr = (const unsigned long long*)(H3 + (size_t)m * DM) + lane;
        f32x4* o = (f32x4*)(a->out + (size_t)m * DM) + lane;
        unsigned long long w[16];
#pragma unroll
        for (int j = 0; j < 16; ++j) w[j] = hr[64 * j];
#pragma unroll
        for (int j = 0; j < 16; ++j) { const unsigned lo = (unsigned)w[j], hi = (unsigned)(w[j] >> 32); const f32x4 gg = gr[64 * j];
            o[64 * j] = (f32x4){__uint_as_float(lo << 16), __uint_as_float(lo & 0xffff0000u), __uint_as_float(hi << 16), __uint_as_float(hi & 0xffff0000u)} * rstd * gg; }
    }
}

__device__ __forceinline__ void diff_unit(Frame& F, ArgsP a, int seq_row0, int S, int h, int qb) {
    using namespace att;
    const att::rsrc_t rs = __builtin_amdgcn_make_buffer_rsrc((void*)(a->ws + WS_BIG), 0, (int)((size_t)MP * IN_W * 2), 0x00020000);
    ATT_LAS char* lds = (ATT_LAS char*)(F.lds + RING_OFF);
    const int qrow0 = seq_row0 + qb * 256, NT = 1 + S / 64;
    for (int map = 0; map < 2; ++map) {
        f32x16 o[8]; float rli[16];
        att2::diff_run(rs, ((unsigned)qrow0 * LD + C_QD + (h * 2 + map) * 128) * 2u, (unsigned)(C_KD + (h * 2 + map) * 128) * 2u, (unsigned)(C_VD + h * 256) * 2u, seq_row0, NT, lds, o, rli, F.wave);
        int ln_ = att::lane_of(); asm volatile("" : "+v"(ln_));
        const int tt = F.wave * 64 + ln_, r32 = ln_ & 31, hi = ln_ >> 5, wv = F.wave;
        float* scrw = (float*)(a->ws + WS_SCR) + (size_t)blockIdx.x * 512 * 128;
        const unsigned so = (unsigned)tt * 128u;
        if (map == 0) {
#pragma unroll
            for (int d = 0; d < 8; ++d)
#pragma unroll
                for (int q = 0; q < 4; ++q) *(f32x4*)(scrw + so + d * 16 + q * 4) = (f32x4){o[d][4 * q] * rli[4 * q], o[d][4 * q + 1] * rli[4 * q + 1], o[d][4 * q + 2] * rli[4 * q + 2], o[d][4 * q + 3] * rli[4 * q + 3]};
        } else {
            float lam; { const int ln = tt & 63; const float* lq1 = a->in[11]; const float* lk1 = a->in[12]; const float* lq2 = a->in[13]; const float* lk2 = a->in[14];
                const float d1 = wave_sum(lq1[ln] * lk1[ln] + lq1[ln + 64] * lk1[ln + 64]), d2 = wave_sum(lq2[ln] * lk2[ln] + lq2[ln + 64] * lk2[ln + 64]);
                lam = expf(d1) - expf(d2) + LAM_INIT; }
#pragma unroll
            for (int r = 0; r < 16; ++r) rli[r] *= -lam;
            float ssq[16];
#pragma unroll
            for (int r = 0; r < 16; ++r) ssq[r] = 0.f;
#pragma unroll
            for (int d = 0; d < 8; ++d) {
#pragma unroll
                for (int q = 0; q < 4; ++q) { const f32x4 t = *(const f32x4*)(scrw + so + d * 16 + q * 4);
#pragma unroll
                    for (int e = 0; e < 4; ++e) { const float v = fmaf(o[d][4 * q + e], rli[4 * q + e], t[e]); ssq[4 * q + e] = fmaf(v, v, ssq[4 * q + e]); } }
                asm volatile("" ::: "memory"); }
#pragma unroll
            for (int r = 0; r < 16; ++r) ssq[r] = (1.0f - LAM_INIT) / sqrtf(half_sum(ssq[r]) * (1.0f / 256.0f) + SUBLN_EPS);
            const float* gn = a->in[15];
            bf16* obase = (bf16*)(a->ws + WS_HN) + (size_t)qrow0 * DM + NA_W + h * 256;
            const unsigned oo = (unsigned)((wv * 32 + 4 * hi) * DM + r32);
#pragma unroll
            for (int d = 0; d < 8; ++d) { const float g = gn[d * 32 + r32];
#pragma unroll
                for (int q = 0; q < 4; ++q) { const f32x4 t = *(const f32x4*)(scrw + so + d * 16 + q * 4);
#pragma unroll
                    for (int e = 0; e < 4; ++e) { const int r = 4 * q + e; const float v = fmaf(o[d][r], rli[r], t[e]);
                        obase[oo + (unsigned)(((r & 3) + 8 * (r >> 2)) * DM + d * 32)] = f2bf_s(v * ssq[r] * g); } }
                asm volatile("" ::: "memory"); }
        }
    }
}
__device__ __forceinline__ void na_unit(Frame& F, ArgsP a, int seq_row0, int nrows, int h, int qb) {
    using namespace att;
    const att::rsrc_t rs = __builtin_amdgcn_make_buffer_rsrc((void*)(a->ws + WS_BIG), 0, (int)((size_t)MP * IN_W * 2), 0x00020000); bf16* MIX = (bf16*)(a->ws + WS_HN);
    ATT_LAS char* lds = (ATT_LAS char*)(F.lds + RING_OFF);
    ATT_LAS float* rpb = (ATT_LAS float*)(F.lds + ATT_RPB_OFF);
    const int lane = F.lane_now(), r32 = lane & 31, hi = lane >> 5;
    __syncthreads();
    for (int i = F.wave * 64 + lane; i < 15 * 31; i += NWAVES * 64) rpb[i] = a->in[9][h * 465 + i] * (1.0f / SCALE);
    const int qrow0 = seq_row0 + qb * 256;
    NaCtx na; na.qrow = 4 * qb + (F.wave >> 1); na.r0 = min(max(na.qrow - 4, 0), nrows - 8); na.kr_first = min(max(4 * qb - 4, 0), nrows - 11);
    na.c = 32 * (F.wave & 1) + r32; na.c0 = min(max(na.c - 8, 0), 48); na.rpb = rpb;
    f32x16 o[4];
    attn_run<true>(rs, ((unsigned)qrow0 * LD + C_QNA + h * 128) * 2u, (unsigned)(C_KNA + h * 128) * 2u, (unsigned)(C_VNA + h * 128) * 2u, seq_row0 + na.kr_first * 64, 12, lds, na, o, F.wave);
    int ln_ = att::lane_of(); asm volatile("" : "+v"(ln_));
    const int e32 = ln_ & 31, ehi = ln_ >> 5, wv = F.wave;
    const float* gn = a->in[10] + h * 128;
    float g[4];
#pragma unroll
    for (int d = 0; d < 4; ++d) g[d] = gn[d * 32 + e32];
    bf16* ob = MIX + (size_t)(qrow0 + wv * 32 + 4 * ehi) * DM + h * 128 + e32;
#pragma unroll
    for (int r = 0; r < 16; ++r) { float s = 0.f;
#pragma unroll
        for (int d = 0; d < 4; ++d) s += o[d][r] * o[d][r];
        const float rs = 1.0f / sqrtf(half_sum(s) * (1.0f / 128.0f) + EPS);
        bf16* op = ob + (size_t)((r & 3) + 8 * (r >> 2)) * DM;
#pragma unroll
        for (int d = 0; d < 4; ++d) op[d * 32] = f2bf_s(o[d][r] * rs * g[d]); }
}
__device__ __forceinline__ void p_attention(Frame& F, ArgsP a) {
    if (F.wave >= 4) __builtin_amdgcn_s_setprio(1);
    const int v = F.vcu;
    for (int u = v; u < 256 + 512; u += F.G) {
        int seq_row0, S, h, qb;
        if (u < 256) { seq_row0 = 0; S = S_P; h = u >> 5; qb = u & 31; }
        else { const int t = u - 256, pair = t >> 4; seq_row0 = S_P + (pair >> 3) * S_S; S = S_S; h = pair & 7; qb = t & 15; }
#ifndef ATT_NO_DIFF
        diff_unit(F, a, seq_row0, S, h, qb);
#endif
    }
    for (int n = v; n < 16 * 96; n += F.G) { const int h = n / 96, q = n - h * 96; int seq_row0, nrows, qb;
        if (q < 32) { seq_row0 = 0; nrows = S_P / 64; qb = q; }
        else { const int t = q - 32; seq_row0 = S_P + (t >> 4) * S_S; nrows = S_S / 64; qb = t & 15; }
#ifndef ATT_NO_NA
        na_unit(F, a, seq_row0, nrows, h, qb);
#endif
    }
    __builtin_amdgcn_s_setprio(0);
}

__global__ void __launch_bounds__(NWAVES * 64, 2) mk_fwd(Args args) {
    extern __shared__ __attribute__((aligned(16))) unsigned char lds[];
    Frame F;
    F.lds = (LAS unsigned char*)lds;
    F.MISC = (volatile LAS unsigned*)(F.lds + MISC_OFF);
    F.wave = __builtin_amdgcn_readfirstlane((int)threadIdx.x >> 6);
    F.G = gridDim.x; { const int bx = blockIdx.x; F.vcu = (F.G % 8 == 0) ? (bx % 8) * (F.G / 8) + bx / 8 : bx; }
    int lo, hi;
    { ARGS_HERE(a0); F.ctl = (gu32*)(a0->ws + WS_CTL); lo = a0->ph_lo; hi = a0->ph_hi; }
    for (int u = F.wave * 64 + F.lane_now(); u < (LDS_BYTES - LDSCTL_OFF) / 4; u += NWAVES * 64) ((LAS unsigned*)(F.lds + LDSCTL_OFF))[u] = 0u;
    __syncthreads();
    XcdBarrier bar; bar.bar = (unsigned*)(F.ctl + CW_BAR); bar.x = 0; bar.st = nullptr;
    if (N_LAUNCHES == 1) bar = xcd_barrier_post((unsigned*)(F.ctl + CW_BAR), F.MISC + 8, F.wave * 64 + att::lane_of());
#ifndef PH_MASK
#define PH_MASK 0xFFF
#endif
#define IN(k) ((((PH_MASK) >> (k)) & 1) && lo <= (k) && (k) < hi)
#define SEAM(k) do { if (IN(k) && IN((k) + 1 + ((k) == 4))) xcd_barrier(bar, F.wave * 64 + att::lane_of()); } while (0)
#define WSP(T, off) ((T*)(a->ws + (off)))

#define PHASE(k) if (IN(k))

    PHASE(0) { ARGS_HERE(a); p0_prologue(F, a); } SEAM(0);
    PHASE(1) {
        ARGS_HERE(a);
        pg8::Gemm g{WSP(bf16, WS_HN), WSP(bf16, WS_WA), MP, 2 * DFF, DM}; pg8::StaticOrder S; S.init(MP, 2 * DFF, F.G, (int)blockIdx.x);
        pg8::EpiSwiglu E{WSP(bf16, WS_BIG), DFF, WSP(float, WS_RSTD)};
        pg8::gemm_phase<pg8::EpiSwiglu, pg8::StaticOrder, true, true>(F.lds + RING_OFF, g, S, E, F.wave);
        { int nidle; const int r = idle_rank(S.nwg, F.G, (int)blockIdx.x, nidle);
          if (nidle == 0) p_weights(F, a, 1, F.vcu * NWAVES + F.wave, F.G * NWAVES); else if (r >= 0) p_weights(F, a, 1, r * NWAVES + F.wave, nidle * NWAVES); } } SEAM(1);
    PHASE(2) {
        ARGS_HERE(a);
        { MetaEpiDown ME{a->in[2], WSP(float, WS_HMETA), WSP(bf16, WS_HB)}; meta_gemm(F, WSP(bf16, WS_BIG) + (size_t)NTOK * DFF, DFF, WSP(bf16, WS_WD), DFF, DM / 16, ME); }
        pg8::Gemm g{WSP(bf16, WS_BIG), WSP(bf16, WS_WD), NTOK, DM, DFF}; pg8::StaticOrder S; S.init(NTOK, DM, F.G, (int)blockIdx.x);
        pg8::EpiRes<1, 1> E{nullptr, nullptr, WSP(bf16, WS_HN), nullptr, WSP(bf16, WS_HB), WSP(float, WS_SSQP), 0.5f, DM};
        pg8::gemm_phase<pg8::EpiRes<1, 1>, pg8::StaticOrder, false, true>(F.lds + RING_OFF, g, S, E, F.wave); } SEAM(2);
    PHASE(3) { ARGS_HERE(a); p_stats(F, a, 1); } SEAM(3);
    PHASE(4) {
        ARGS_HERE(a);
        { MetaEpiKV ME{WSP(float, WS_RSTD), WSP(bf16, WS_BIG), WSP(float, WS_ROPE)}; meta_gemm2(F, WSP(bf16, WS_HB) + (size_t)NTOK * DM, DM, WSP(bf16, WS_WIN), DM, 8192 / 32, ME); }
        pg8::Gemm g{WSP(bf16, WS_HB), WSP(bf16, WS_WIN), NTOK, IN_W, DM}; pg8::StaticOrder S; S.init(NTOK, IN_W, F.G, (int)blockIdx.x);
        pg8::EpiProj E{WSP(bf16, WS_BIG), IN_W, WSP(float, WS_RSTD), WSP(float, WS_ROPE), C_QD / 256, C_VD / 256};
        pg8::gemm_phase<pg8::EpiProj, pg8::StaticOrder, true, true>(F.lds + RING_OFF, g, S, E, F.wave); } SEAM(4);
    PHASE(6) { ARGS_HERE(a); p_attention(F, a); } SEAM(6);
    PHASE(7) {
        ARGS_HERE(a);
        pg8::Gemm g{WSP(bf16, WS_HN), WSP(bf16, WS_WOUT), NTOK, DM, DM}; pg8::StaticOrder S; S.init(NTOK, DM, F.G, (int)blockIdx.x);
        pg8::EpiRes<1, 1> E{nullptr, nullptr, WSP(bf16, WS_HB), nullptr, WSP(bf16, WS_HB), WSP(float, WS_SSQP), 1.0f, DM};
        pg8::gemm_phase<pg8::EpiRes<1, 1>, pg8::StaticOrder, false, true>(F.lds + RING_OFF, g, S, E, F.wave); } SEAM(7);
    PHASE(8) { ARGS_HERE(a); p_stats(F, a, 2); p_weights(F, a, 2, F.vcu * NWAVES + F.wave, F.G * NWAVES); } SEAM(8);
    PHASE(9) {
        ARGS_HERE(a);
        pg8::Gemm g{WSP(bf16, WS_HB), WSP(bf16, WS_WA), NTOK, 2 * DFF, DM}; pg8::StaticOrder S; S.init(NTOK, 2 * DFF, F.G, (int)blockIdx.x);
        pg8::EpiSwiglu E{WSP(bf16, WS_BIG), DFF, WSP(float, WS_RSTD)};
        pg8::gemm_phase<pg8::EpiSwiglu, pg8::StaticOrder, true, true>(F.lds + RING_OFF, g, S, E, F.wave);
        { int nidle; const int r = idle_rank(S.nwg, F.G, (int)blockIdx.x, nidle);
          if (nidle == 0) p_weights(F, a, 3, F.vcu * NWAVES + F.wave, F.G * NWAVES); else if (r >= 0) p_weights(F, a, 3, r * NWAVES + F.wave, nidle * NWAVES); } } SEAM(9);
    PHASE(10) {
        ARGS_HERE(a);
        pg8::Gemm g{WSP(bf16, WS_BIG), WSP(bf16, WS_WD), NTOK, DM, DFF}; pg8::StaticOrder S; S.init(NTOK, DM, F.G, (int)blockIdx.x);
        pg8::EpiRes<1, 1> E{nullptr, nullptr, WSP(bf16, WS_HB), nullptr, WSP(bf16, WS_H3), WSP(float, WS_SSQP), 0.5f, DM};
        pg8::gemm_phase<pg8::EpiRes<1, 1>, pg8::StaticOrder, false, true>(F.lds + RING_OFF, g, S, E, F.wave); } SEAM(10);
    PHASE(11) { ARGS_HERE(a); p_final(F, a); }
#undef PHASE
#undef IN
#undef SEAM
#undef WSP
}

extern "C" void kernel_launch(void* const* d_in, const int* in_sizes, int n_in, void* d_out, int out_size, void* d_ws, size_t ws_size, hipStream_t stream) {
    static int grid = 0;
    if (grid == 0) {
        if (n_in != 22 || in_sizes[0] != S_P * DM || in_sizes[1] != NB_S * S_S * DM || out_size != NTOK * DM || ws_size < WS_END) {
            fprintf(stderr, "kernel_launch: shape mismatch: n_in %d in0 %d in1 %d out %d ws %zu (need %zu)\n", n_in, n_in > 0 ? in_sizes[0] : -1, n_in > 1 ? in_sizes[1] : -1, out_size, ws_size, (size_t)WS_END); grid = -1; return; }
        int dev = 0, cus = 0, per_cu = 0;
        if (hipGetDevice(&dev) != hipSuccess || hipDeviceGetAttribute(&cus, hipDeviceAttributeMultiprocessorCount, dev) != hipSuccess) { grid = -1; return; }
        if (hipFuncSetAttribute((const void*)mk_fwd, hipFuncAttributeMaxDynamicSharedMemorySize, LDS_BYTES) != hipSuccess) { fprintf(stderr, "kernel_launch: hipFuncSetAttribute failed\n"); grid = -1; return; }
        if (hipOccupancyMaxActiveBlocksPerMultiprocessor(&per_cu, (const void*)mk_fwd, NWAVES * 64, LDS_BYTES) != hipSuccess || per_cu < 1)
            fprintf(stderr, "kernel_launch: note: occupancy query reports %d workgroups per CU\n", per_cu);
        (void)hipGetLastError();
        grid = cus;
    }
    if (grid < 0) return;
    if (hipMemsetAsync((char*)d_ws + WS_CTL, 0, CTL_ZERO_BYTES, stream) != hipSuccess) { fprintf(stderr, "kernel_launch: memset failed\n"); return; }
    Args a{};
    for (int i = 0; i < 22; ++i) a.in[i] = (const float*)d_in[i];
    a.out = (float*)d_out; a.ws = (unsigned char*)d_ws;
#if defined(PROBE_TWICE)
    for (int pass_ = 0; pass_ < 2; ++pass_)
#endif
    for (int li = 0; li < N_LAUNCHES; ++li) {
        a.ph_lo = (N_LAUNCHES == 1) ? 0 : li; a.ph_hi = (N_LAUNCHES == 1) ? N_PHASES : li + 1;
        hipLaunchKernelGGL(mk_fwd, dim3(grid), dim3(NWAVES * 64), LDS_BYTES, stream, a);
#if defined(PROBE_REPEAT)
#ifndef PROBE_TIMES
#define PROBE_TIMES 1
#endif
        if (N_LAUNCHES > 1 && (((PROBE_REPEAT) >> li) & 1)) for (int rp_ = 0; rp_ < PROBE_TIMES; ++rp_) hipLaunchKernelGGL(mk_fwd, dim3(grid), dim3(NWAVES * 64), LDS_BYTES, stream, a);
#endif
#if defined(PROBE_SEQ01)
        if (N_LAUNCHES > 1 && li == 1) { Args b = a; b.ph_lo = 0; b.ph_hi = 1; hipLaunchKernelGGL(mk_fwd, dim3(grid), dim3(NWAVES * 64), LDS_BYTES, stream, b); hipLaunchKernelGGL(mk_fwd, dim3(grid), dim3(NWAVES * 64), LDS_BYTES, stream, a); }
#endif
#if defined(PROBE_ROPE)
        if (N_LAUNCHES > 1 && li == 5) { Args b = a; b.probe = 1; hipLaunchKernelGGL(mk_fwd, dim3(grid), dim3(NWAVES * 64), LDS_BYTES, stream, b); hipLaunchKernelGGL(mk_fwd, dim3(grid), dim3(NWAVES * 64), LDS_BYTES, stream, a); }
#endif
#if defined(PROBE_REPEAT_ALT)
        if (N_LAUNCHES > 1 && (((PROBE_REPEAT_ALT) >> li) & 1)) { Args b = a; b.out = (float*)((unsigned char*)d_ws + WS_BIG); b.probe = PROBE_FOLD;
            hipLaunchKernelGGL(mk_fwd, dim3(grid), dim3(NWAVES * 64), LDS_BYTES, stream, b); }
#endif
        const hipError_t le = hipPeekAtLastError();
        if (le != hipSuccess) { fprintf(stderr, "kernel_launch: launch %d failed: %s\n", li, hipGetErrorName(le)); break; }
    }
}
```

```cpp
#include <hip/hip_runtime.h>
#include <cstdio>
#include <cstdint>
#include <cmath>
namespace pg8 {
#define PG8_LAS __attribute__((address_space(3)))
typedef unsigned short bf16_t;
typedef short bf16x8 __attribute__((ext_vector_type(8)));
typedef float f32x4 __attribute__((ext_vector_type(4)));
typedef unsigned u32x4 __attribute__((ext_vector_type(4)));
constexpr int BM = 256, BK = 64, HALF = 128, HTB = HALF * BK * 2  , STAGE_BYTES = 8 * HTB, NXCD = 8, WGM = 8;

__host__ __device__ __forceinline__ int lds_byte(int r, int c) { const int st = (r >> 4) * 2 + (c >> 5), rr = r & 15, cc = c & 31, ob = rr * 64 + cc * 2; return st * 1024 + (ob ^ (((ob >> 9) & 1) << 5)); }
__host__ __device__ __forceinline__ void stage_rc(int b, int& R, int& C) { const int st = b / 1024, sb = b % 1024, swz = sb ^ (((sb >> 9) & 1) << 5); R = (st >> 1) * 16 + swz / 64; C = (st & 1) * 32 + (swz % 64) / 2; }
__host__ __device__ __forceinline__ int perm32(int rho) { const int n = rho >> 4, i = rho & 15; return 8 * (i >> 2) + 4 * n + (i & 3); }

struct Unit { int pm, pn; };
struct Gemm { const bf16_t* A; const bf16_t* Bt; int M, N, K; };

struct StaticOrder {
    int nM, nN, nwg, G, c, fold;
    __host__ __device__ void init(int M, int N, int G_, int c_) { nM = M / BM; nN = N / BM; nwg = nM * nN; G = G_; c = c_; fold = 0; }
    __host__ __device__ bool next(int i, Unit& u) const {
        const long L = (long)i * G + c; if (L >= nwg) return false;
        int wgid = (int)L; { const int q = nwg / NXCD, r = nwg % NXCD, xcd = wgid % NXCD, off = wgid / NXCD; wgid = (xcd < r ? xcd * (q + 1) : r * (q + 1) + (xcd - r) * q) + off; }
        const int nig = WGM * nN, gid = wgid / nig, fm = gid * WGM, gsz = (nM - fm) < WGM ? (nM - fm) : WGM;
        u.pm = fm + ((wgid % nig) % gsz); u.pn = (wgid % nig) / gsz; if (fold) { u.pm &= 1; u.pn &= 1; } return true;
    }
    __device__ __forceinline__ void a_ready(const Unit&) const {}
    __device__ __forceinline__ void done(const Unit&) const {}
};

__device__ __forceinline__ unsigned cvt_pk_bf16(float lo, float hi) { unsigned r; asm volatile("v_cvt_pk_bf16_f32 %0, %1, %2" : "=v"(r) : "v"(lo), "v"(hi)); return r; }
typedef float f32x2 __attribute__((ext_vector_type(2)));

__device__ __forceinline__ int pg8_lane_now() { int l; asm volatile("v_mbcnt_lo_u32_b32 %0, -1, 0\n\tv_mbcnt_hi_u32_b32 %0, -1, %0" : "=v"(l)); return l; }
__device__ __forceinline__ float silu_mul(float g, float up) { const float e = __builtin_amdgcn_exp2f(g * -1.4426950408889634f); return g * __builtin_amdgcn_rcpf(1.0f + e) * up; }
__device__ __forceinline__ float bf_lo(unsigned w) { return __uint_as_float(w << 16); }
__device__ __forceinline__ float bf_hi(unsigned w) { return __uint_as_float(w & 0xffff0000u); }
struct EpiSwiglu {
    static constexpr bool PERM = true, AFTER_DRAIN = false;
    bf16_t* O; int ldc; const float* rs;
    __device__ __forceinline__ void operator()(const f32x4 (&acc)[2][2][4][2], const Unit& u, int wr, int wc, int fr, int fq) const {
        const int row0 = u.pm * BM + wr * 64 + fr, col0 = u.pn * HALF + wc * 32 + 8 * fq;
#pragma unroll
        for (int ai = 0; ai < 2; ++ai)
#pragma unroll
            for (int m = 0; m < 4; ++m) { const int row = row0 + ai * HALF + m * 16; bf16_t* rowp = O + (size_t)row * ldc + col0;
                const float sc = rs ? rs[row] : 1.0f;
                float v[8];
#pragma unroll
                for (int n = 0; n < 2; ++n)
#pragma unroll
                    for (int j = 0; j < 4; ++j) v[n * 4 + j] = silu_mul(acc[ai][0][m][n][j] * sc, acc[ai][1][m][n][j] * sc);
                u32x4 w; w.x = cvt_pk_bf16(v[0], v[1]); w.y = cvt_pk_bf16(v[2], v[3]); w.z = cvt_pk_bf16(v[4], v[5]); w.w = cvt_pk_bf16(v[6], v[7]);
                *(u32x4*)rowp = w; }
    }
};
struct EpiProj {
    static constexpr bool PERM = true, AFTER_DRAIN = false;
    bf16_t* O; int ldc; const float* rs; const float* tab; int pn_lo, pn_hi;
    __device__ __forceinline__ void operator()(const f32x4 (&acc)[2][2][4][2], const Unit& u, int wr, int wc, int fr, int fq) const {
        const int row0 = u.pm * BM + wr * 64 + fr, col0 = u.pn * BM + wc * 32 + 8 * fq;
        const bool rope = wc == 0 && u.pn >= pn_lo && u.pn < pn_hi;
        const float sg = fq < 2 ? -1.f : 1.f;
#pragma unroll
        for (int ai = 0; ai < 2; ++ai)
#pragma unroll
            for (int m = 0; m < 4; ++m) { const int row = row0 + ai * HALF + m * 16; bf16_t* rowp = O + (size_t)row * ldc + col0;
                const float sc = rs ? rs[row] : 1.0f;
                f32x4 c0, c1, s0, s1;
                if (rope) { const int pos = row < 8192 ? 16 + row : 16 + ((row - 8192) & 4095); const float* tb = tab + pos * 32 + 8 * (fq & 1);
                    c0 = *(const f32x4*)tb; c1 = *(const f32x4*)(tb + 4); s0 = *(const f32x4*)(tb + 16) * sg; s1 = *(const f32x4*)(tb + 20) * sg; }
#pragma unroll
                for (int bj = 0; bj < 2; ++bj) { f32x4 v0 = acc[ai][bj][m][0] * sc, v1 = acc[ai][bj][m][1] * sc;
                    if (rope) { f32x4 q0, q1;
#pragma unroll
                        for (int e2 = 0; e2 < 4; ++e2) { q0[e2] = __shfl_xor(v0[e2], 32); q1[e2] = __shfl_xor(v1[e2], 32); }
                        v0 = v0 * c0 + q0 * s0; v1 = v1 * c1 + q1 * s1; }
                    u32x4 w; w.x = cvt_pk_bf16(v0[0], v0[1]); w.y = cvt_pk_bf16(v0[2], v0[3]); w.z = cvt_pk_bf16(v1[0], v1[1]); w.w = cvt_pk_bf16(v1[2], v1[3]);
                    *(u32x4*)(rowp + bj * HALF) = w; } }
    }
};
template <int SRC, int DST> struct EpiRes {
    static constexpr bool PERM = true, AFTER_DRAIN = false;
    const float* s0; const float* s1; const bf16_t* sb; float* df; bf16_t* db; float* ssq; float alpha; int ldc;
    __device__ __forceinline__ void operator()(const f32x4 (&acc)[2][2][4][2], const Unit& u, int wr, int wc, int fr, int fq) const {
        const int pm = u.pm;
        const char* sfb = (const char*)(pm < 32 ? s0 + (size_t)pm * BM * ldc : s1 + (size_t)(pm - 32) * BM * ldc);
        const char* sbb = (const char*)(sb + (size_t)pm * BM * ldc); char* dbb = (char*)(db + (size_t)pm * BM * ldc); char* dfb = (char*)(df + (size_t)pm * BM * ldc);
        float* sqb = ssq + (size_t)pm * BM * 64 + 4 * u.pn + wc;
        const int rloc0 = wr * 64 + fr; const unsigned col0 = (unsigned)(u.pn * BM + wc * 32 + 8 * fq);
#pragma unroll
        for (int ai = 0; ai < 2; ++ai) {
            f32x4 hf[SRC == 0 ? 4 : 1][2][2]; u32x4 hw[SRC == 1 ? 4 : 1][2];
            if constexpr (SRC != 2)
#pragma unroll
            for (int m = 0; m < 4; ++m) { const unsigned eoff = (unsigned)(rloc0 + ai * HALF + m * 16) * (unsigned)ldc + col0;
#pragma unroll
                for (int bj = 0; bj < 2; ++bj) {
                    if constexpr (SRC == 0) { hf[m][bj][0] = *(const f32x4*)(sfb + (eoff + bj * HALF) * 4u); hf[m][bj][1] = *(const f32x4*)(sfb + (eoff + bj * HALF + 4) * 4u); }
                    else hw[m][bj] = *(const u32x4*)(sbb + (eoff + bj * HALF) * 2u); } }
#pragma unroll
            for (int m = 0; m < 4; ++m) { const int rloc = rloc0 + ai * HALF + m * 16; const unsigned eoff = (unsigned)rloc * (unsigned)ldc + col0;
                float sq = 0.f;
#pragma unroll
                for (int bj = 0; bj < 2; ++bj) { f32x4 h0, h1;
                    if constexpr (SRC == 0) { h0 = hf[m][bj][0]; h1 = hf[m][bj][1]; }
                    else if constexpr (SRC == 2) { h0 = (f32x4){0.f, 0.f, 0.f, 0.f}; h1 = h0; }
                    else { const u32x4 w = hw[m][bj]; h0 = (f32x4){bf_lo(w.x), bf_hi(w.x), bf_lo(w.y), bf_hi(w.y)}; h1 = (f32x4){bf_lo(w.z), bf_hi(w.z), bf_lo(w.w), bf_hi(w.w)}; }
                    h0 = h0 + acc[ai][bj][m][0] * alpha; h1 = h1 + acc[ai][bj][m][1] * alpha;
                    if constexpr (DST == 1) sq += ((h0[0] * h0[0] + h0[1] * h0[1]) + (h0[2] * h0[2] + h0[3] * h0[3])) + ((h1[0] * h1[0] + h1[1] * h1[1]) + (h1[2] * h1[2] + h1[3] * h1[3]));
                    if constexpr (DST == 0) { *(f32x4*)(dfb + (eoff + bj * HALF) * 4u) = h0; *(f32x4*)(dfb + (eoff + bj * HALF + 4) * 4u) = h1; }
                    else { u32x4 w; w.x = cvt_pk_bf16(h0[0], h0[1]); w.y = cvt_pk_bf16(h0[2], h0[3]); w.z = cvt_pk_bf16(h1[0], h1[1]); w.w = cvt_pk_bf16(h1[2], h1[3]);
                        *(u32x4*)(dbb + (eoff + bj * HALF) * 2u) = w; } }
                if constexpr (DST == 1) { sq += __shfl_xor(sq, 16); sq += __shfl_xor(sq, 32);
                    if (fq == 0) sqb[(unsigned)rloc * 64u] = sq; } }
            asm volatile("" ::: "memory"); }
    }
};

template <class Epi, class Sched, bool ALIGN_EPI = false, bool SP2 = false>
__device__ __forceinline__ void gemm_phase(PG8_LAS unsigned char* lds, const Gemm g, const Sched& S, const Epi& E, const int wave_) {
    const int wid = wave_, lane = pg8_lane_now(), tid = wid * 64 + lane, wr = wid >> 2, wc = wid & 3, fr = lane & 15, fq = lane >> 4;
    const int K = g.K, nt = K / BK;
    unsigned voffA[2], voffB[2];
#pragma unroll
    for (int i = 0; i < 2; ++i) { int R, C; stage_rc(tid * 16 + i * 8192, R, C); const int Rb = Epi::PERM ? ((R & ~31) + perm32(R & 31)) : R;
        voffA[i] = (unsigned)(R * K + C) * 2u; voffB[i] = (unsigned)(Rb * K + C) * 2u; }
    const size_t kstep = (size_t)(BK * 2);
    const size_t hstep = (size_t)HALF * K * 2;
    const size_t tstep = 2 * hstep;
    const unsigned ldsw = (unsigned)wid * 1024u;
    const int aoff = lds_byte(wr * 64 + fr, fq * 8), boff = lds_byte(wc * 32 + fr, fq * 8);
#define PG8_SA(b, h) (((b) * 2 + (h)) * HTB)
#define PG8_SB(b, h) ((4 + (b) * 2 + (h)) * HTB)
#define PG8_STAGE(bufoff, gbase, voff) do { _Pragma("unroll") for (int _i = 0; _i < 2; ++_i) \
        __builtin_amdgcn_global_load_lds((const unsigned*)((const char*)(gbase) + (voff)[_i]), (PG8_LAS unsigned*)(lds + (bufoff) + ldsw + _i * 8192), 16, 0, 0); } while (0)
#define PG8_LDA(dst, b, h) do { _Pragma("unroll") for (int m = 0; m < 4; ++m) _Pragma("unroll") for (int k = 0; k < 2; ++k) dst[m][k] = *(const PG8_LAS bf16x8*)(lds + PG8_SA(b, h) + aoff + m * 2048 + k * 1024); } while (0)
#define PG8_LDB(dst, b, h) do { _Pragma("unroll") for (int n = 0; n < 2; ++n) _Pragma("unroll") for (int k = 0; k < 2; ++k) dst[n][k] = *(const PG8_LAS bf16x8*)(lds + PG8_SB(b, h) + boff + n * 2048 + k * 1024); } while (0)
#define PG8_MMA(ai, bj, At, Bt) do { __builtin_amdgcn_s_setprio(1); _Pragma("unroll") for (int m = 0; m < 4; ++m) _Pragma("unroll") for (int n = 0; n < 2; ++n) _Pragma("unroll") for (int k = 0; k < 2; ++k) \
        acc[ai][bj][m][n] = __builtin_amdgcn_mfma_f32_16x16x32_bf16(Bt[n][k], At[m][k], acc[ai][bj][m][n], 0, 0, 0); __builtin_amdgcn_s_setprio(0); } while (0)
#define PG8_WAIT_V(n) asm volatile("s_waitcnt vmcnt(" #n ")" ::: "memory")
#define PG8_WAIT_L(n) asm volatile("s_waitcnt lgkmcnt(" #n ")" ::: "memory")
#define PG8_BAR __builtin_amdgcn_s_barrier()
#define PG8_SCHED __builtin_amdgcn_sched_barrier(0)
    Unit cur, nxt; int ui = 0;
    if (!S.next(0, cur)) return;
    f32x4 acc[2][2][4][2];
#pragma unroll
    for (int a = 0; a < 2; ++a)
#pragma unroll
        for (int b = 0; b < 2; ++b)
#pragma unroll
            for (int m = 0; m < 4; ++m)
#pragma unroll
                for (int n = 0; n < 2; ++n) acc[a][b][m][n] = (f32x4){0.f, 0.f, 0.f, 0.f};
    bf16x8 At[4][2], B0[2][2], B1[2][2];
    const char* cA = (const char*)g.A + (size_t)cur.pm * tstep; const char* cB = (const char*)g.Bt + (size_t)cur.pn * tstep;
    S.a_ready(cur);
    if constexpr (SP2) {
        PG8_STAGE(PG8_SB(0, 0), cB, voffB); PG8_STAGE(PG8_SB(0, 1), cB + hstep, voffB); PG8_STAGE(PG8_SA(0, 0), cA, voffA); PG8_STAGE(PG8_SA(0, 1), cA + hstep, voffA);
        if (wr == 1) PG8_BAR;
        PG8_WAIT_V(2); PG8_BAR;
        PG8_STAGE(PG8_SB(1, 0), cB + kstep, voffB); PG8_STAGE(PG8_SA(1, 0), cA + kstep, voffA); PG8_STAGE(PG8_SB(1, 1), cB + hstep + kstep, voffB);
        PG8_WAIT_V(6); PG8_BAR;
    } else {
        PG8_STAGE(PG8_SB(0, 0), cB, voffB); PG8_STAGE(PG8_SA(0, 0), cA, voffA); PG8_STAGE(PG8_SB(0, 1), cB + hstep, voffB); PG8_STAGE(PG8_SA(0, 1), cA + hstep, voffA);
        if (wr == 1) PG8_BAR;
        PG8_WAIT_V(4); PG8_BAR;
        PG8_STAGE(PG8_SB(1, 0), cB + kstep, voffB); PG8_STAGE(PG8_SA(1, 0), cA + kstep, voffA); PG8_STAGE(PG8_SB(1, 1), cB + hstep + kstep, voffB);
        PG8_WAIT_V(6); PG8_BAR;
    }
    for (;;) {
        const bool has_next = S.next(ui + 1, nxt);
        const char* nA = has_next ? (const char*)g.A + (size_t)nxt.pm * tstep : cA; const char* nB = has_next ? (const char*)g.Bt + (size_t)nxt.pn * tstep : cB;
        for (int t = 0; t < nt; t += 2) {
            const bool last = (t == nt - 2);
            const char* a1 = cA + (size_t)(t + 1) * kstep;
            const char* a2 = last ? nA : cA + (size_t)(t + 2) * kstep; const char* b2 = last ? nB : cB + (size_t)(t + 2) * kstep;
            const char* a3 = a2 + kstep; const char* b3 = b2 + kstep;
            if (last && has_next) S.a_ready(nxt);
            if constexpr (SP2) {
            PG8_LDB(B0, 0, 0); PG8_LDB(B1, 0, 1); PG8_SCHED; PG8_LDA(At, 0, 0); PG8_STAGE(PG8_SA(1, 1), a1 + hstep, voffA);
            PG8_WAIT_V(8); PG8_WAIT_L(0); PG8_BAR; PG8_MMA(0, 0, At, B0); PG8_MMA(0, 1, At, B1); PG8_BAR; PG8_SCHED;
            PG8_LDA(At, 0, 1); PG8_STAGE(PG8_SB(0, 0), b2, voffB); PG8_STAGE(PG8_SB(0, 1), b2 + hstep, voffB); PG8_STAGE(PG8_SA(0, 0), a2, voffA);
            PG8_WAIT_V(8); PG8_WAIT_L(0); PG8_BAR; PG8_MMA(1, 0, At, B0); PG8_MMA(1, 1, At, B1); PG8_BAR; PG8_SCHED;
            PG8_LDB(B0, 1, 0); PG8_LDB(B1, 1, 1); PG8_SCHED; PG8_LDA(At, 1, 0); PG8_STAGE(PG8_SA(0, 1), a2 + hstep, voffA);
            PG8_WAIT_V(8); PG8_WAIT_L(0); PG8_BAR; PG8_MMA(0, 0, At, B0); PG8_MMA(0, 1, At, B1); PG8_BAR; PG8_SCHED;
            PG8_LDA(At, 1, 1); PG8_STAGE(PG8_SB(1, 0), b3, voffB); PG8_STAGE(PG8_SB(1, 1), b3 + hstep, voffB); PG8_STAGE(PG8_SA(1, 0), a3, voffA);
            PG8_WAIT_V(8); PG8_WAIT_L(0); PG8_BAR; PG8_MMA(1, 0, At, B0); PG8_MMA(1, 1, At, B1); PG8_BAR; PG8_SCHED;
            } else {
            PG8_LDB(B0, 0, 0); PG8_SCHED; PG8_LDA(At, 0, 0); PG8_STAGE(PG8_SA(1, 1), a1 + hstep, voffA);
            PG8_WAIT_L(8); PG8_BAR; PG8_WAIT_L(0); PG8_MMA(0, 0, At, B0); PG8_BAR; PG8_SCHED;
            PG8_LDB(B1, 0, 1); PG8_STAGE(PG8_SB(0, 0), b2, voffB);
            PG8_BAR; PG8_WAIT_L(0); PG8_MMA(0, 1, At, B1); PG8_BAR;
            PG8_LDA(At, 0, 1); PG8_STAGE(PG8_SA(0, 0), a2, voffA);
            PG8_BAR; PG8_WAIT_L(0); PG8_MMA(1, 0, At, B0); PG8_BAR; PG8_SCHED;
            PG8_STAGE(PG8_SB(0, 1), b2 + hstep, voffB);
            PG8_WAIT_V(6); PG8_BAR; PG8_MMA(1, 1, At, B1); PG8_BAR;
            PG8_LDB(B0, 1, 0); PG8_SCHED; PG8_LDA(At, 1, 0); PG8_STAGE(PG8_SA(0, 1), a2 + hstep, voffA);
            PG8_WAIT_L(8); PG8_BAR; PG8_WAIT_L(0); PG8_MMA(0, 0, At, B0); PG8_BAR; PG8_SCHED;
            PG8_LDB(B1, 1, 1); PG8_STAGE(PG8_SB(1, 0), b3, voffB);
            PG8_BAR; PG8_WAIT_L(0); PG8_MMA(0, 1, At, B1); PG8_BAR;
            PG8_LDA(At, 1, 1); PG8_STAGE(PG8_SA(1, 0), a3, voffA);
            PG8_BAR; PG8_WAIT_L(0); PG8_MMA(1, 0, At, B0); PG8_BAR; PG8_SCHED;
            PG8_STAGE(PG8_SB(1, 1), b3 + hstep, voffB);
            PG8_WAIT_V(6); PG8_BAR; PG8_MMA(1, 1, At, B1); PG8_BAR;
            }
        }
        if constexpr (ALIGN_EPI) { if (wr == 0) PG8_BAR; }
        if constexpr (!Epi::AFTER_DRAIN) { E(acc, cur, wr, wc, fr, fq); S.done(cur); }
        if (!has_next) break;
#pragma unroll
        for (int a = 0; a < 2; ++a)
#pragma unroll
            for (int b = 0; b < 2; ++b)
#pragma unroll
                for (int m = 0; m < 4; ++m)
#pragma unroll
                    for (int n = 0; n < 2; ++n) acc[a][b][m][n] = (f32x4){0.f, 0.f, 0.f, 0.f};
        cur = nxt; cA = nA; cB = nB; ++ui;
        if constexpr (ALIGN_EPI) { if (wr == 1) PG8_BAR; }
    }
    PG8_WAIT_V(0);
    if constexpr (!ALIGN_EPI) { if (wr == 0) PG8_BAR; }
    PG8_BAR;
    if constexpr (Epi::AFTER_DRAIN) { E.fused(acc, cur, wr, wc, fr, fq, lds, wid, lane); S.done(cur); }
#undef PG8_SA
#undef PG8_SB
#undef PG8_STAGE
#undef PG8_LDA
#undef PG8_LDB
#undef PG8_MMA
#undef PG8_WAIT_V
#undef PG8_WAIT_L
#undef PG8_BAR
#undef PG8_SCHED
}
}

namespace att {
#define ATT_LAS __attribute__((address_space(3)))
typedef unsigned short bf16_t;
using bf16x8 = __attribute__((ext_vector_type(8))) short;
using s16x4  = __attribute__((ext_vector_type(4))) short;
using f32x16 = __attribute__((ext_vector_type(16))) float;
using u32x4  = __attribute__((ext_vector_type(4))) unsigned;
constexpr int   D = 128, NW = 8, QBLK = 32, KVBLK = 64;
constexpr float SCALE = 0.088388347648318440f;
constexpr float THR = 8.f;
constexpr float NEG = -1.0e30f;
constexpr int   LD = 12288;
constexpr int   META_ROW = 24576;
constexpr int   SHM_V = KVBLK * D * 2, SHM_K = KVBLK * D * 2, SHM_ATTN = 2 * SHM_V + 2 * SHM_K + NW * 64 * 4;
#define KSWZ(row, colB) ((row) * 256 + ((colB) ^ (((row) & 7) << 4)))
#define SBAR() __builtin_amdgcn_sched_barrier(0)
__device__ __forceinline__ int crow(int r, int hi) { return (r & 3) + 8 * (r >> 2) + 4 * hi; }
__device__ __forceinline__ int lane_of() { int l; asm volatile("v_mbcnt_lo_u32_b32 %0, -1, 0\n\tv_mbcnt_hi_u32_b32 %0, -1, %0" : "=v"(l)); return l; }
__device__ __forceinline__ unsigned cvtpk(float lo, float hi) { unsigned r; asm volatile("v_cvt_pk_bf16_f32 %0, %1, %2" : "=v"(r) : "v"(lo), "v"(hi)); return r; }

struct NaCtx { int qrow, r0, kr_first, c, c0; const ATT_LAS float* rpb; };

__device__ __forceinline__ void partialSM(f32x16& p0, f32x16& p1, float& m_reg, float& mn, float& alpha) {
  constexpr float C = SCALE * 1.4426950408889634f;
  float pmax = p0[0];
#pragma unroll
  for (int r = 1; r < 16; ++r) pmax = fmaxf(pmax, p0[r]);
#pragma unroll
  for (int r = 0; r < 16; ++r) pmax = fmaxf(pmax, p1[r]);
  { auto rr = __builtin_amdgcn_permlane32_swap(__float_as_uint(pmax), __float_as_uint(pmax), false, false);
    pmax = fmaxf(__uint_as_float(rr[0]), __uint_as_float(rr[1])); }
  if (__builtin_expect(__all(pmax - m_reg <= THR / SCALE), 1)) { mn = m_reg; alpha = 1.f; }
  else { mn = fmaxf(m_reg, pmax); alpha = __builtin_amdgcn_exp2f((m_reg - mn) * C); m_reg = mn; }
  float mnC = -mn * C;
#pragma unroll
  for (int r = 0; r < 16; ++r) p0[r] = fmaf(p0[r], C, mnC);
#pragma unroll
  for (int r = 0; r < 16; ++r) p1[r] = fmaf(p1[r], C, mnC);
#pragma unroll
  for (int r = 0; r < 16; ++r) p0[r] = __builtin_amdgcn_exp2f(p0[r]);
}
__device__ __forceinline__ void finishSM(f32x16& p0, f32x16& p1, float alpha, float& l_reg, bf16x8& pa0, bf16x8& pa1, bf16x8& pa2, bf16x8& pa3) {
#pragma unroll
  for (int r = 0; r < 16; ++r) p1[r] = __builtin_amdgcn_exp2f(p1[r]);
  float ps = 0;
#pragma unroll
  for (int r = 0; r < 16; ++r) ps += p0[r];
#pragma unroll
  for (int r = 0; r < 16; ++r) ps += p1[r];
  { auto rr = __builtin_amdgcn_permlane32_swap(__float_as_uint(ps), __float_as_uint(ps), false, false);
    ps = __uint_as_float(rr[0]) + __uint_as_float(rr[1]); }
  l_reg = l_reg * alpha + ps;
#define PK4(P, BASE, OUT) do { unsigned a0 = cvtpk(P[BASE + 0], P[BASE + 1]), a1 = cvtpk(P[BASE + 2], P[BASE + 3]);   \
    unsigned b0 = cvtpk(P[BASE + 4], P[BASE + 5]), b1 = cvtpk(P[BASE + 6], P[BASE + 7]);                              \
    auto r0 = __builtin_amdgcn_permlane32_swap(a0, b0, false, false); auto r1 = __builtin_amdgcn_permlane32_swap(a1, b1, false, false); \
    u32x4 w = {r0[0], r1[0], r0[1], r1[1]}; OUT = *reinterpret_cast<bf16x8*>(&w); } while (0)
  PK4(p0, 0, pa0); PK4(p0, 8, pa1); PK4(p1, 0, pa2); PK4(p1, 8, pa3);
#undef PK4
}
__device__ __forceinline__ void qkt(f32x16& p0, f32x16& p1, const ATT_LAS char* Ks, const bf16x8* qr, int r32, int hi) {
  p0 = f32x16{}; p1 = f32x16{};
#pragma unroll
  for (int d0 = 0; d0 < 8; ++d0) { int cb = (d0 * 16 + hi * 8) * 2;
    bf16x8 b0 = *reinterpret_cast<const ATT_LAS bf16x8*>(Ks + KSWZ(r32, cb));
    bf16x8 b1 = *reinterpret_cast<const ATT_LAS bf16x8*>(Ks + KSWZ(32 + r32, cb));
    p0 = __builtin_amdgcn_mfma_f32_32x32x16_bf16(b0, qr[d0], p0, 0, 0, 0);
    p1 = __builtin_amdgcn_mfma_f32_32x32x16_bf16(b1, qr[d0], p1, 0, 0, 0); }
}
__device__ __forceinline__ int v_st(int k, int c) { const int kk = (k & ~0xC) | ((k & 4) << 1) | ((k & 8) >> 1); return ((kk >> 3) * 4 + (c >> 5)) * 512 + ((kk & 7) * 32 + (c & 31)) * 2; }
__device__ __forceinline__ int v_rd_base(int lane) { return ((lane & 3) << 3) | (((lane >> 2) & 3) << 6) | (((lane >> 4) & 1) << 5) | (((lane >> 5) & 1) << 8); }
constexpr int v_rd_off(int d0, int ks, int half) { return d0 * 512 + ks * 4096 + half * 2048; }
template <int OFF> __device__ __forceinline__ s16x4 tr_read(int vb) {
  s16x4 r; asm volatile("ds_read_b64_tr_b16 %0, %1 offset:%2" : "=&v"(r) : "v"(vb), "i"(OFF) : "memory"); return r;
}
template <int D0> __device__ __forceinline__ void pv_one(f32x16& od, int vb, bf16x8 pa0, bf16x8 pa1, bf16x8 pa2, bf16x8 pa3) {
  const s16x4 l0 = tr_read<v_rd_off(D0, 0, 0)>(vb), h0 = tr_read<v_rd_off(D0, 0, 1)>(vb), l1 = tr_read<v_rd_off(D0, 1, 0)>(vb), h1 = tr_read<v_rd_off(D0, 1, 1)>(vb);
  const s16x4 l2 = tr_read<v_rd_off(D0, 2, 0)>(vb), h2 = tr_read<v_rd_off(D0, 2, 1)>(vb), l3 = tr_read<v_rd_off(D0, 3, 0)>(vb), h3 = tr_read<v_rd_off(D0, 3, 1)>(vb);
  asm volatile("s_waitcnt lgkmcnt(0)" ::: "memory"); SBAR();
#define PK(L, H) (bf16x8){L[0], L[1], L[2], L[3], H[0], H[1], H[2], H[3]}
  od = __builtin_amdgcn_mfma_f32_32x32x16_bf16(pa0, PK(l0, h0), od, 0, 0, 0);
  od = __builtin_amdgcn_mfma_f32_32x32x16_bf16(pa1, PK(l1, h1), od, 0, 0, 0);
  od = __builtin_amdgcn_mfma_f32_32x32x16_bf16(pa2, PK(l2, h2), od, 0, 0, 0);
  od = __builtin_amdgcn_mfma_f32_32x32x16_bf16(pa3, PK(l3, h3), od, 0, 0, 0);
#undef PK
}
__device__ __forceinline__ void pv_d0(f32x16* o, int vb, bf16x8 pa0, bf16x8 pa1, bf16x8 pa2, bf16x8 pa3) {
  pv_one<0>(o[0], vb, pa0, pa1, pa2, pa3); pv_one<1>(o[1], vb, pa0, pa1, pa2, pa3); pv_one<2>(o[2], vb, pa0, pa1, pa2, pa3); pv_one<3>(o[3], vb, pa0, pa1, pa2, pa3);
}
template <bool IS_NA> __device__ __forceinline__ void mask_tile(f32x16& p0, f32x16& p1, int j, const NaCtx& na, int hi) {
  if constexpr (IS_NA) {
    const int kr = na.kr_first + (j - 1);
    if ((unsigned)(kr - na.r0) >= 8u) {
#pragma unroll
      for (int r = 0; r < 16; ++r) { p0[r] = NEG; p1[r] = NEG; }
    } else {
      const ATT_LAS float* rb = na.rpb + (kr - na.qrow + 7) * 31 + 15 - na.c + 4 * hi;
      const int dbase = 4 * hi - na.c0;
#pragma unroll
      for (int r = 0; r < 16; ++r) { const int kc = (r & 3) + 8 * (r >> 2);
        const float b0 = rb[kc], b1 = rb[kc + 32];
        p0[r] = ((unsigned)(kc + dbase) < 16u) ? p0[r] + b0 : NEG;
        p1[r] = ((unsigned)(kc + 32 + dbase) < 16u) ? p1[r] + b1 : NEG; }
    }
  }
}

typedef __amdgpu_buffer_rsrc_t rsrc_t;
__device__ __forceinline__ bf16x8 bld(rsrc_t rs, unsigned voff, unsigned soff) { auto v = __builtin_amdgcn_raw_buffer_load_b128(rs, (int)voff, (int)soff, 0); return __builtin_bit_cast(bf16x8, v); }
template <bool IS_NA>
__device__ __forceinline__ void attn_run(const rsrc_t rs, const unsigned qoffB  , const unsigned kcolB, const unsigned vcolB  ,
                                         const int krow1, const int NT, ATT_LAS char* lds, const NaCtx na, f32x16 (&o)[4], const int wid  ) {
  const int lane = lane_of(), tid = wid * 64 + lane, r32 = lane & 31, hi = lane >> 5;
  ATT_LAS char* V_lds = lds; ATT_LAS char* K_lds = lds + 2 * SHM_V;
  ATT_LAS float* wsf = (ATT_LAS float*)(lds + 2 * SHM_V + 2 * SHM_K) + wid * 64; ATT_LAS float* li_l = wsf; ATT_LAS float* al_l = wsf + 32;
  float m_reg = NEG, l_reg = 0; bf16x8 qr[8];
#pragma unroll
  for (int d = 0; d < 4; ++d) o[d] = f32x16{};
  { const unsigned qv = (unsigned)((wid * QBLK + r32) * LD + hi * 8) * 2u;
#pragma unroll
    for (int d0 = 0; d0 < 8; ++d0) qr[d0] = bld(rs, qv + d0 * 32, qoffB); }
  const int sr = tid >> 4, sc = (tid & 15) * 8, vst0 = v_st(sr, sc), vst1 = v_st(32 + sr, sc);
  const int vb0 = (int)(unsigned)(uintptr_t)V_lds + v_rd_base(lane);
  struct { bf16x8 vs0, vs1, ks0, ks1; } sr_[2];
#define TROW(j) ((j) == 0 ? META_ROW : krow1 + ((j) - 1) * KVBLK)
  const unsigned stv = (unsigned)(sr * LD + sc) * 2u;
#define SLOAD(i, j) do { const unsigned t0_ = (unsigned)TROW(j) * (unsigned)(LD * 2); sr_[i].vs0 = bld(rs, stv, t0_ + vcolB); sr_[i].vs1 = bld(rs, stv, t0_ + vcolB + 32u * LD * 2u); \
    sr_[i].ks0 = bld(rs, stv, t0_ + kcolB); sr_[i].ks1 = bld(rs, stv, t0_ + kcolB + 32u * LD * 2u); } while (0)
#define SWRITE(b, i) do { *(ATT_LAS bf16x8*)(V_lds + (b) * SHM_V + vst0) = sr_[i].vs0;          \
    *(ATT_LAS bf16x8*)(V_lds + (b) * SHM_V + vst1) = sr_[i].vs1; const int kc_ = sc * 2;               \
    *(ATT_LAS bf16x8*)(K_lds + (b) * SHM_K + KSWZ(sr, kc_)) = sr_[i].ks0;                       \
    *(ATT_LAS bf16x8*)(K_lds + (b) * SHM_K + KSWZ(32 + sr, kc_)) = sr_[i].ks1; } while (0)
#define SWAIT() asm volatile("s_waitcnt vmcnt(4)" ::: "memory")
#define RESC(a) do { if (__any((a) < 1.f)) { if (hi == 0) al_l[r32] = (a); asm volatile("s_waitcnt lgkmcnt(0)" ::: "memory"); \
    _Pragma("unroll") for (int d = 0; d < 4; ++d) _Pragma("unroll") for (int r = 0; r < 16; ++r) o[d][r] *= al_l[crow(r, hi)]; } } while (0)
  f32x16 pA0, pA1, pB0, pB1; float mnA, mnB, alA, alB; bf16x8 pa0, pa1, pa2, pa3;
  constexpr int SE = 0, SO = 1;
  __syncthreads();
  SLOAD(SE, 0); asm volatile("s_waitcnt vmcnt(0)" ::: "memory"); SWRITE(0, SE); __syncthreads();
  qkt(pA0, pA1, K_lds, qr, r32, hi);
#pragma unroll
  for (int r = 8; r < 16; ++r) pA0[r] = NEG;
#pragma unroll
  for (int r = 0; r < 16; ++r) pA1[r] = NEG;
  partialSM(pA0, pA1, m_reg, mnA, alA);
  SLOAD(SO, 1); if (2 < NT) SLOAD(SE, 2);
  SWAIT(); SWRITE(1, SO); __syncthreads();
  for (int j = 1; j + 2 < NT; j += 2) {
    SBAR(); qkt(pB0, pB1, K_lds + SHM_K, qr, r32, hi);
    finishSM(pA0, pA1, alA, l_reg, pa0, pa1, pa2, pa3); SBAR();
    if (j + 2 < NT) SLOAD(SO, j + 2); SBAR();
    pv_d0(o, vb0, pa0, pa1, pa2, pa3); mask_tile<IS_NA>(pB0, pB1, j, na, hi); partialSM(pB0, pB1, m_reg, mnB, alB);
    __syncthreads(); SWAIT(); SWRITE(0, SE);
    RESC(alB); __syncthreads();
    SBAR(); qkt(pA0, pA1, K_lds, qr, r32, hi);
    finishSM(pB0, pB1, alB, l_reg, pa0, pa1, pa2, pa3); SBAR();
    if (j + 3 < NT) SLOAD(SE, j + 3); SBAR();
    pv_d0(o, vb0 + SHM_V, pa0, pa1, pa2, pa3); mask_tile<IS_NA>(pA0, pA1, j + 1, na, hi); partialSM(pA0, pA1, m_reg, mnA, alA);
    __syncthreads(); SWAIT(); if (j + 2 < NT) SWRITE(1, SO);
    RESC(alA); __syncthreads();
  }
  SBAR(); qkt(pB0, pB1, K_lds + SHM_K, qr, r32, hi);
  finishSM(pA0, pA1, alA, l_reg, pa0, pa1, pa2, pa3); SBAR();
  pv_d0(o, vb0, pa0, pa1, pa2, pa3); mask_tile<IS_NA>(pB0, pB1, NT - 1, na, hi); partialSM(pB0, pB1, m_reg, mnB, alB);
  RESC(alB);
  finishSM(pB0, pB1, alB, l_reg, pa0, pa1, pa2, pa3); SBAR();
  pv_d0(o, vb0 + SHM_V, pa0, pa1, pa2, pa3);
  if (hi == 0) li_l[r32] = l_reg; asm volatile("s_waitcnt lgkmcnt(0)" ::: "memory");
#pragma unroll
  for (int r = 0; r < 16; ++r) { const float rl = __builtin_amdgcn_rcpf(li_l[crow(r, hi)]);
#pragma unroll
    for (int d = 0; d < 4; ++d) o[d][r] *= rl; }
#undef TROW
#undef SLOAD
#undef SWRITE
#undef SWAIT
#undef RESC
}
__device__ __forceinline__ float half_sum(float v) {
#pragma unroll
  for (int o = 1; o < 32; o <<= 1) v += __shfl_xor(v, o);
  return v;
}
}


namespace att2 {
using namespace att;
constexpr int KB = 16384, VB = 32768;
constexpr int L_K = 0, L_V = 2 * KB, L_WS = 2 * KB + 2 * VB, SHM2 = L_WS + NW * 64 * 4;
__device__ __forceinline__ void dma16(const rsrc_t rs, ATT_LAS char* dst, unsigned voff, unsigned soff) { __builtin_amdgcn_raw_ptr_buffer_load_lds(rs, (ATT_LAS void*)dst, 16, (int)voff, (int)soff, 0, 0); }
#define WAITBAR(N) asm volatile("s_waitcnt vmcnt(" #N ") lgkmcnt(0)\n\ts_barrier" ::: "memory")
template <int D0, int VH> __device__ __forceinline__ void pv_one2(f32x16& od, int vb, bf16x8 pa0, bf16x8 pa1, bf16x8 pa2, bf16x8 pa3) {
  constexpr int B = VH * 16384;
  const s16x4 l0 = tr_read<B + v_rd_off(D0, 0, 0)>(vb), h0 = tr_read<B + v_rd_off(D0, 0, 1)>(vb), l1 = tr_read<B + v_rd_off(D0, 1, 0)>(vb), h1 = tr_read<B + v_rd_off(D0, 1, 1)>(vb);
  const s16x4 l2 = tr_read<B + v_rd_off(D0, 2, 0)>(vb), h2 = tr_read<B + v_rd_off(D0, 2, 1)>(vb), l3 = tr_read<B + v_rd_off(D0, 3, 0)>(vb), h3 = tr_read<B + v_rd_off(D0, 3, 1)>(vb);
  asm volatile("s_waitcnt lgkmcnt(0)" ::: "memory"); SBAR();
#define PK(L, H) (bf16x8){L[0], L[1], L[2], L[3], H[0], H[1], H[2], H[3]}
  od = __builtin_amdgcn_mfma_f32_32x32x16_bf16(pa0, PK(l0, h0), od, 0, 0, 0);
  od = __builtin_amdgcn_mfma_f32_32x32x16_bf16(pa1, PK(l1, h1), od, 0, 0, 0);
  od = __builtin_amdgcn_mfma_f32_32x32x16_bf16(pa2, PK(l2, h2), od, 0, 0, 0);
  od = __builtin_amdgcn_mfma_f32_32x32x16_bf16(pa3, PK(l3, h3), od, 0, 0, 0);
#undef PK
}
__device__ __forceinline__ void pv8(f32x16* o, int vb, bf16x8 pa0, bf16x8 pa1, bf16x8 pa2, bf16x8 pa3) {
  pv_one2<0, 0>(o[0], vb, pa0, pa1, pa2, pa3); pv_one2<1, 0>(o[1], vb, pa0, pa1, pa2, pa3); pv_one2<2, 0>(o[2], vb, pa0, pa1, pa2, pa3); pv_one2<3, 0>(o[3], vb, pa0, pa1, pa2, pa3);
  pv_one2<0, 1>(o[4], vb, pa0, pa1, pa2, pa3); pv_one2<1, 1>(o[5], vb, pa0, pa1, pa2, pa3); pv_one2<2, 1>(o[6], vb, pa0, pa1, pa2, pa3); pv_one2<3, 1>(o[7], vb, pa0, pa1, pa2, pa3);
}
template <int BASE> __device__ __forceinline__ bf16x8 pk4t(const f32x16& P) {
  unsigned a0 = cvtpk(P[BASE + 0], P[BASE + 1]), a1 = cvtpk(P[BASE + 2], P[BASE + 3]), b0 = cvtpk(P[BASE + 4], P[BASE + 5]), b1 = cvtpk(P[BASE + 6], P[BASE + 7]);
  auto r0 = __builtin_amdgcn_permlane32_swap(a0, b0, false, false); auto r1 = __builtin_amdgcn_permlane32_swap(a1, b1, false, false);
  u32x4 w = {r0[0], r1[0], r0[1], r1[1]}; return *reinterpret_cast<bf16x8*>(&w);
}
#define TRV(D, KS, HF) tr_read<((D) >> 2) * 16384 + v_rd_off((D) & 3, KS, HF)>(vb)
#define PKF(L, H) (bf16x8){L[0], L[1], L[2], L[3], H[0], H[1], H[2], H[3]}
#define RD2(S, KS, D) do { S##l0 = TRV((D), KS, 0); S##h0 = TRV((D), KS, 1); S##l1 = TRV((D) + 1, KS, 0); S##h1 = TRV((D) + 1, KS, 1); } while (0)
#define GAPV(OD, PA, L, H, STMT) do { OD = __builtin_amdgcn_mfma_f32_32x32x16_bf16(PA, PKF(L, H), OD, 0, 0, 0); STMT SBAR(); } while (0)
__device__ __forceinline__ void pv8_softmax(f32x16* o, const int vb, bf16x8& pa0, bf16x8& pa1, bf16x8& pa2, const bf16x8 pa3, f32x16& p0, f32x16& p1, float& m_reg, float& al, float& ps) {
  constexpr float CSM = SCALE * 1.4426950408889634f;
  s16x4 Al0, Ah0, Al1, Ah1, Bl0, Bh0, Bl1, Bh1; float pm, mn, mnC;
  RD2(A, 0, 0); SBAR();
  asm volatile("s_waitcnt lgkmcnt(0)" ::: "memory"); SBAR();
  RD2(B, 0, 2); SBAR();
  GAPV(o[0], pa0, Al0, Ah0, pm = fmaxf(p0[0], p0[1]); pm = fmaxf(pm, p0[2]); pm = fmaxf(pm, p0[3]); pm = fmaxf(pm, p0[4]); pm = fmaxf(pm, p0[5]); asm volatile("" : "+v"(pm)););
  GAPV(o[1], pa0, Al1, Ah1, pm = fmaxf(pm, p0[6]); pm = fmaxf(pm, p0[7]); pm = fmaxf(pm, p0[8]); pm = fmaxf(pm, p0[9]); pm = fmaxf(pm, p0[10]); pm = fmaxf(pm, p0[11]); asm volatile("" : "+v"(pm)););
  asm volatile("s_waitcnt lgkmcnt(0)" ::: "memory"); SBAR();
  RD2(A, 0, 4); SBAR();
  GAPV(o[2], pa0, Bl0, Bh0, pm = fmaxf(pm, p0[12]); pm = fmaxf(pm, p0[13]); pm = fmaxf(pm, p0[14]); pm = fmaxf(pm, p0[15]); pm = fmaxf(pm, p1[0]); pm = fmaxf(pm, p1[1]); asm volatile("" : "+v"(pm)););
  GAPV(o[3], pa0, Bl1, Bh1, pm = fmaxf(pm, p1[2]); pm = fmaxf(pm, p1[3]); pm = fmaxf(pm, p1[4]); pm = fmaxf(pm, p1[5]); pm = fmaxf(pm, p1[6]); pm = fmaxf(pm, p1[7]); asm volatile("" : "+v"(pm)););
  asm volatile("s_waitcnt lgkmcnt(0)" ::: "memory"); SBAR();
  RD2(B, 0, 6); SBAR();
  GAPV(o[4], pa0, Al0, Ah0, pm = fmaxf(pm, p1[8]); pm = fmaxf(pm, p1[9]); pm = fmaxf(pm, p1[10]); pm = fmaxf(pm, p1[11]); pm = fmaxf(pm, p1[12]); pm = fmaxf(pm, p1[13]); asm volatile("" : "+v"(pm)););
  GAPV(o[5], pa0, Al1, Ah1, pm = fmaxf(pm, p1[14]); pm = fmaxf(pm, p1[15]); { auto rr_ = __builtin_amdgcn_permlane32_swap(__float_as_uint(pm), __float_as_uint(pm), false, false); pm = fmaxf(__uint_as_float(rr_[0]), __uint_as_float(rr_[1])); } asm volatile("" : "+v"(pm)););
  asm volatile("s_waitcnt lgkmcnt(0)" ::: "memory"); SBAR();
  RD2(A, 1, 0); SBAR();
  GAPV(o[6], pa0, Bl0, Bh0, if (__builtin_expect(__all(pm - m_reg <= THR / SCALE), 1)) { mn = m_reg; al = 1.f; } else { mn = fmaxf(m_reg, pm); al = __builtin_amdgcn_exp2f((m_reg - mn) * CSM); m_reg = mn; } mnC = -mn * CSM; asm volatile("" : "+v"(mnC)); asm volatile("" : "+v"(al)););
  GAPV(o[7], pa0, Bl1, Bh1, p0[0] = fmaf(p0[0], CSM, mnC); p0[1] = fmaf(p0[1], CSM, mnC); p0[2] = fmaf(p0[2], CSM, mnC); p0[3] = fmaf(p0[3], CSM, mnC); p0[4] = fmaf(p0[4], CSM, mnC); p0[5] = fmaf(p0[5], CSM, mnC); asm volatile("" : "+v"(p0)););
  asm volatile("s_waitcnt lgkmcnt(0)" ::: "memory"); SBAR();
  RD2(B, 1, 2); SBAR();
  GAPV(o[0], pa1, Al0, Ah0, p0[6] = fmaf(p0[6], CSM, mnC); p0[7] = fmaf(p0[7], CSM, mnC); p0[8] = fmaf(p0[8], CSM, mnC); p0[9] = fmaf(p0[9], CSM, mnC); p0[10] = fmaf(p0[10], CSM, mnC); p0[11] = fmaf(p0[11], CSM, mnC); asm volatile("" : "+v"(p0)););
  GAPV(o[1], pa1, Al1, Ah1, p0[12] = fmaf(p0[12], CSM, mnC); p0[13] = fmaf(p0[13], CSM, mnC); p0[14] = fmaf(p0[14], CSM, mnC); p0[15] = fmaf(p0[15], CSM, mnC); p1[0] = fmaf(p1[0], CSM, mnC); p1[1] = fmaf(p1[1], CSM, mnC); asm volatile("" : "+v"(p0)); asm volatile("" : "+v"(p1)););
  asm volatile("s_waitcnt lgkmcnt(0)" ::: "memory"); SBAR();
  RD2(A, 1, 4); SBAR();
  GAPV(o[2], pa1, Bl0, Bh0, p1[2] = fmaf(p1[2], CSM, mnC); p1[3] = fmaf(p1[3], CSM, mnC); p1[4] = fmaf(p1[4], CSM, mnC); p1[5] = fmaf(p1[5], CSM, mnC); p1[6] = fmaf(p1[6], CSM, mnC); p1[7] = fmaf(p1[7], CSM, mnC); asm volatile("" : "+v"(p1)););
  GAPV(o[3], pa1, Bl1, Bh1, p1[8] = fmaf(p1[8], CSM, mnC); p1[9] = fmaf(p1[9], CSM, mnC); p1[10] = fmaf(p1[10], CSM, mnC); p1[11] = fmaf(p1[11], CSM, mnC); p1[12] = fmaf(p1[12], CSM, mnC); p1[13] = fmaf(p1[13], CSM, mnC); asm volatile("" : "+v"(p1)););
  asm volatile("s_waitcnt lgkmcnt(0)" ::: "memory"); SBAR();
  RD2(B, 1, 6); SBAR();
  GAPV(o[4], pa1, Al0, Ah0, p1[14] = fmaf(p1[14], CSM, mnC); p1[15] = fmaf(p1[15], CSM, mnC); asm volatile("" : "+v"(p1)););
  GAPV(o[5], pa1, Al1, Ah1, p0[0] = __builtin_amdgcn_exp2f(p0[0]); p0[1] = __builtin_amdgcn_exp2f(p0[1]); p0[2] = __builtin_amdgcn_exp2f(p0[2]); asm volatile("" : "+v"(p0)););
  asm volatile("s_waitcnt lgkmcnt(0)" ::: "memory"); SBAR();
  RD2(A, 2, 0); SBAR();
  GAPV(o[6], pa1, Bl0, Bh0, p0[3] = __builtin_amdgcn_exp2f(p0[3]); p0[4] = __builtin_amdgcn_exp2f(p0[4]); p0[5] = __builtin_amdgcn_exp2f(p0[5]); asm volatile("" : "+v"(p0)););
  GAPV(o[7], pa1, Bl1, Bh1, p0[6] = __builtin_amdgcn_exp2f(p0[6]); p0[7] = __builtin_amdgcn_exp2f(p0[7]); p0[8] = __builtin_amdgcn_exp2f(p0[8]); asm volatile("" : "+v"(p0)););
  asm volatile("s_waitcnt lgkmcnt(0)" ::: "memory"); SBAR();
  RD2(B, 2, 2); SBAR();
  GAPV(o[0], pa2, Al0, Ah0, p0[9] = __builtin_amdgcn_exp2f(p0[9]); p0[10] = __builtin_amdgcn_exp2f(p0[10]); p0[11] = __builtin_amdgcn_exp2f(p0[11]); asm volatile("" : "+v"(p0)););
  GAPV(o[1], pa2, Al1, Ah1, p0[12] = __builtin_amdgcn_exp2f(p0[12]); p0[13] = __builtin_amdgcn_exp2f(p0[13]); p0[14] = __builtin_amdgcn_exp2f(p0[14]); asm volatile("" : "+v"(p0)););
  asm volatile("s_waitcnt lgkmcnt(0)" ::: "memory"); SBAR();
  RD2(A, 2, 4); SBAR();
  GAPV(o[2], pa2, Bl0, Bh0, p0[15] = __builtin_amdgcn_exp2f(p0[15]); p1[0] = __builtin_amdgcn_exp2f(p1[0]); p1[1] = __builtin_amdgcn_exp2f(p1[1]); asm volatile("" : "+v"(p0)); asm volatile("" : "+v"(p1)););
  GAPV(o[3], pa2, Bl1, Bh1, p1[2] = __builtin_amdgcn_exp2f(p1[2]); p1[3] = __builtin_amdgcn_exp2f(p1[3]); p1[4] = __builtin_amdgcn_exp2f(p1[4]); asm volatile("" : "+v"(p1)););
  asm volatile("s_waitcnt lgkmcnt(0)" ::: "memory"); SBAR();
  RD2(B, 2, 6); SBAR();
  GAPV(o[4], pa2, Al0, Ah0, p1[5] = __builtin_amdgcn_exp2f(p1[5]); p1[6] = __builtin_amdgcn_exp2f(p1[6]); p1[7] = __builtin_amdgcn_exp2f(p1[7]); asm volatile("" : "+v"(p1)););
  GAPV(o[5], pa2, Al1, Ah1, p1[8] = __builtin_amdgcn_exp2f(p1[8]); p1[9] = __builtin_amdgcn_exp2f(p1[9]); p1[10] = __builtin_amdgcn_exp2f(p1[10]); asm volatile("" : "+v"(p1)););
  asm volatile("s_waitcnt lgkmcnt(0)" ::: "memory"); SBAR();
  RD2(A, 3, 0); SBAR();
  GAPV(o[6], pa2, Bl0, Bh0, p1[11] = __builtin_amdgcn_exp2f(p1[11]); p1[12] = __builtin_amdgcn_exp2f(p1[12]); p1[13] = __builtin_amdgcn_exp2f(p1[13]); asm volatile("" : "+v"(p1)););
  GAPV(o[7], pa2, Bl1, Bh1, p1[14] = __builtin_amdgcn_exp2f(p1[14]); p1[15] = __builtin_amdgcn_exp2f(p1[15]); asm volatile("" : "+v"(p1)););
  asm volatile("s_waitcnt lgkmcnt(0)" ::: "memory"); SBAR();
  RD2(B, 3, 2); SBAR();
  GAPV(o[0], pa3, Al0, Ah0, ps = p0[0] + p0[1]; ps += p0[2]; ps += p0[3]; ps += p0[4]; ps += p0[5]; ps += p0[6]; ps += p0[7]; asm volatile("" : "+v"(ps)););
  GAPV(o[1], pa3, Al1, Ah1, ps += p0[8]; ps += p0[9]; ps += p0[10]; ps += p0[11]; ps += p0[12]; ps += p0[13]; ps += p0[14]; ps += p0[15]; asm volatile("" : "+v"(ps)););
  asm volatile("s_waitcnt lgkmcnt(0)" ::: "memory"); SBAR();
  RD2(A, 3, 4); SBAR();
  GAPV(o[2], pa3, Bl0, Bh0, ps += p1[0]; ps += p1[1]; ps += p1[2]; ps += p1[3]; ps += p1[4]; ps += p1[5]; ps += p1[6]; ps += p1[7]; asm volatile("" : "+v"(ps)););
  GAPV(o[3], pa3, Bl1, Bh1, ps += p1[8]; ps += p1[9]; ps += p1[10]; ps += p1[11]; ps += p1[12]; ps += p1[13]; ps += p1[14]; ps += p1[15]; asm volatile("" : "+v"(ps)););
  asm volatile("s_waitcnt lgkmcnt(0)" ::: "memory"); SBAR();
  RD2(B, 3, 6); SBAR();
  GAPV(o[4], pa3, Al0, Ah0, pa0 = pk4t<0>(p0); asm volatile("" : "+v"(pa0)););
  GAPV(o[5], pa3, Al1, Ah1, pa1 = pk4t<8>(p0); asm volatile("" : "+v"(pa1)););
  asm volatile("s_waitcnt lgkmcnt(0)" ::: "memory"); SBAR();
  GAPV(o[6], pa3, Bl0, Bh0, pa2 = pk4t<0>(p1); asm volatile("" : "+v"(pa2)););
  GAPV(o[7], pa3, Bl1, Bh1, );
}
#undef TRV
#undef RD2
#undef GAPV
#undef PKF
__device__ __forceinline__ void finish_tail(const f32x16& p1, float ps, float alpha, float& l_reg, bf16x8& pa3) {
  { auto rr = __builtin_amdgcn_permlane32_swap(__float_as_uint(ps), __float_as_uint(ps), false, false); ps = __uint_as_float(rr[0]) + __uint_as_float(rr[1]); }
  l_reg = l_reg * alpha + ps;
  pa3 = pk4t<8>(p1);
}
__device__ __forceinline__ void diff_run(const rsrc_t rs, const unsigned qoffB, const unsigned kcolB, const unsigned vcolB  ,
                                         const int krow1, const int NT, ATT_LAS char* lds, f32x16 (&o)[8], float (&rli)[16], const int wid  ) {
  int lane = lane_of(); asm volatile("" : "+v"(lane));
  const int tid = wid * 64 + lane, r32 = lane & 31, hi = lane >> 5;
  ATT_LAS float* wsf = (ATT_LAS float*)(lds + L_WS) + wid * 64; ATT_LAS float* li_l = wsf; ATT_LAS float* al_l = wsf + 32;
  float m_reg = NEG, l_reg = 0; bf16x8 qr[8];
#pragma unroll
  for (int d = 0; d < 8; ++d) o[d] = f32x16{};
  { const unsigned qv = (unsigned)((wid * QBLK + r32) * LD + hi * 8) * 2u;
#pragma unroll
    for (int d0 = 0; d0 < 8; ++d0) qr[d0] = bld(rs, qv + d0 * 32, qoffB); }
  const unsigned kvo = (unsigned)((tid >> 4) * LD * 2 + (((tid & 15) ^ ((tid >> 4) & 7)) << 4));
  const int kkb = (tid >> 7) * 8 + ((tid & 31) >> 2), kbr = (kkb & ~0xC) | ((kkb & 4) << 1) | ((kkb & 8) >> 1);
  const unsigned vvo = (unsigned)(kbr * LD * 2 + ((((tid >> 5) & 3) * 32 + (tid & 3) * 8) << 1));
  ATT_LAS char* kd = lds + L_K + wid * 1024; ATT_LAS char* vd = lds + L_V + wid * 1024;
  constexpr unsigned R32 = 32u * LD * 2u;
#define TROW(j) ((j) == 0 ? META_ROW : krow1 + ((j) - 1) * KVBLK)
#define DMA_K(j, b) do { const unsigned t0_ = (unsigned)TROW(j) * (unsigned)(LD * 2) + kcolB; dma16(rs, kd + (b) * KB, kvo, t0_); dma16(rs, kd + (b) * KB + 8192, kvo, t0_ + R32); } while (0)
#define DMA_V(j, b) do { const unsigned t0_ = (unsigned)TROW(j) * (unsigned)(LD * 2) + vcolB; dma16(rs, vd + (b) * VB, vvo, t0_); dma16(rs, vd + (b) * VB + 8192, vvo, t0_ + R32); \
    dma16(rs, vd + (b) * VB + 16384, vvo, t0_ + 256u); dma16(rs, vd + (b) * VB + 24576, vvo, t0_ + R32 + 256u); } while (0)
#define RESC(a) do { if (__any((a) < 1.f)) { if (hi == 0) al_l[r32] = (a); asm volatile("s_waitcnt lgkmcnt(0)" ::: "memory"); \
    _Pragma("unroll") for (int d = 0; d < 8; ++d) _Pragma("unroll") for (int r = 0; r < 16; ++r) o[d][r] *= al_l[crow(r, hi)]; } } while (0)
  const int vb0 = (int)(unsigned)(uintptr_t)(lds + L_V) + v_rd_base(lane);
  f32x16 p0, p1; float mn, al; bf16x8 pa0, pa1, pa2, pa3;
  asm volatile("s_waitcnt vmcnt(0) lgkmcnt(0)" ::: "memory"); __builtin_amdgcn_s_barrier();
  DMA_K(0, 0); DMA_K(1, 1); DMA_V(0, 0);
  WAITBAR(6);
  {
    SBAR(); qkt(p0, p1, lds + L_K, qr, r32, hi);
#pragma unroll
    for (int r = 8; r < 16; ++r) p0[r] = NEG;
#pragma unroll
    for (int r = 0; r < 16; ++r) p1[r] = NEG;
    WAITBAR(6);
    { const int jn = 2 < NT ? 2 : NT - 1; DMA_K(jn, 0); }
    partialSM(p0, p1, m_reg, mn, al); finishSM(p0, p1, al, l_reg, pa0, pa1, pa2, pa3);
    WAITBAR(6);
    { const int jn = 1 < NT ? 1 : NT - 1; DMA_V(jn, 1); }
  }
  for (int j = 1; j < NT; ++j) {
    const int jb = j & 1;
    int r32o = r32; asm volatile("" : "+v"(r32o));
    SBAR(); qkt(p0, p1, lds + L_K + jb * KB, qr, r32o, hi);
    WAITBAR(6);
    { const int jn = j + 2 < NT ? j + 2 : NT - 1; DMA_K(jn, jb); }
    float ps; pv8_softmax(o, vb0 + (jb ^ 1) * VB, pa0, pa1, pa2, pa3, p0, p1, m_reg, al, ps);
    RESC(al);
    finish_tail(p1, ps, al, l_reg, pa3);
    WAITBAR(6);
    { const int jn = j + 1 < NT ? j + 1 : NT - 1; DMA_V(jn, jb ^ 1); }
  }
  WAITBAR(0);
  pv8(o, vb0 + ((NT - 1) & 1) * VB, pa0, pa1, pa2, pa3);
  if (hi == 0) li_l[r32] = l_reg; asm volatile("s_waitcnt lgkmcnt(0)" ::: "memory");
#pragma unroll
  for (int r = 0; r < 16; ++r) rli[r] = __builtin_amdgcn_rcpf(li_l[crow(r, hi)]);
#undef TROW
#undef DMA_K
#undef DMA_V
#undef RESC
}
#undef WAITBAR
}


#ifndef PROBE_FOLD
#define PROBE_FOLD 0
#endif
#ifndef MK_N_LAUNCHES
#define MK_N_LAUNCHES 1
#endif
constexpr int NWAVES = 8;
constexpr int N_PHASES = 12;
constexpr int N_LAUNCHES = MK_N_LAUNCHES;

constexpr int DM = 4096, DFF = 11008, NMETA = 16;
constexpr int S_P = 8192, S_S = 4096, NB_S = 4;
constexpr int NTOK = S_P + NB_S * S_S;
constexpr int MP = NTOK + 256;
constexpr int NA_W = 2048, DF_W = 2048, IN_W = 12288;
constexpr int C_QNA = 0, C_KNA = 2048, C_VNA = 4096, C_QD = 6144, C_KD = 8192, C_VD = 10240;
constexpr float EPS = 1e-6f, SUBLN_EPS = 1e-5f, LAM_INIT = 0.2f;

constexpr size_t MiB = 1u << 20;
constexpr size_t WS_CTL = 0, CTL_ZERO_BYTES = 1 * MiB;
constexpr size_t SZ_WA = (size_t)2 * DFF * DM * 2, SZ_WD = (size_t)DM * DFF * 2, SZ_WIN = (size_t)IN_W * DM * 2, SZ_WOUT = (size_t)DM * DM * 2;
constexpr size_t WS_WA = 1 * MiB, WS_WD = WS_WA + SZ_WA, WS_WIN = WS_WD + SZ_WD, WS_WOUT = WS_WIN + SZ_WIN;
constexpr size_t WS_HMETA = WS_WOUT + SZ_WOUT;
constexpr size_t WS_RSTD = WS_HMETA + (size_t)NMETA * DM * 4;
constexpr size_t WS_SSQP = WS_RSTD + (size_t)MP * 4 + 3072;
constexpr size_t WS_HN = WS_SSQP + (size_t)NTOK * 64 * 4;
constexpr size_t WS_HB = WS_HN + (size_t)MP * DM * 2;
constexpr size_t WS_BIG = WS_HB + (size_t)MP * DM * 2;
constexpr size_t WS_SCR = WS_BIG + (size_t)MP * IN_W * 2;
constexpr int L_MAX = NMETA + S_P;
constexpr size_t WS_ROPE = WS_SCR + (size_t)256 * 2 * 64 * 512 * 4;
constexpr size_t WS_END = WS_ROPE + (size_t)L_MAX * 32 * 4;
static_assert(WS_SSQP % 256 == 0 && WS_HN % 256 == 0, "alignment");
constexpr size_t WS_H3 = WS_HN;
constexpr int CW_BAR = 4096;

constexpr int RING_OFF = 0, RING_BYTES = 131072;
constexpr int ATT_RPB_OFF = 69632, ATT_SSQ_OFF = ATT_RPB_OFF + 2048;
constexpr int TR_BYTES = 64 * 65 * 4;
constexpr int LDSCTL_OFF = 143360, MISC_OFF = LDSCTL_OFF + 320;
constexpr int LDS_BYTES = 147456;
static_assert(att2::SHM2 <= RING_BYTES && NWAVES * TR_BYTES <= LDSCTL_OFF && att::SHM_ATTN <= ATT_RPB_OFF && ATT_SSQ_OFF + 1024 <= LDSCTL_OFF && MISC_OFF + 128 <= LDS_BYTES, "LDS map");

#define GAS __attribute__((address_space(1)))
#define LAS __attribute__((address_space(3)))
typedef unsigned short bf16;
typedef unsigned v4u __attribute__((ext_vector_type(4)));
typedef float f32x4 __attribute__((ext_vector_type(4)));
typedef short bf16x8 __attribute__((ext_vector_type(8)));
typedef GAS unsigned gu32;
typedef GAS unsigned long long gu64;
#define RLX_AGENT __ATOMIC_RELAXED, __HIP_MEMORY_SCOPE_AGENT
#define LDS_WAIT() asm volatile("s_waitcnt lgkmcnt(0)" ::: "memory")
#define VM_WAIT() asm volatile("s_waitcnt vmcnt(0)" ::: "memory")
__device__ __forceinline__ unsigned long long rt() { return __builtin_amdgcn_s_memrealtime(); }
__device__ __forceinline__ unsigned f2bf(float f) { unsigned u = __builtin_bit_cast(unsigned, f); return (u + 0x7fffu + ((u >> 16) & 1u)) >> 16; }
__device__ __forceinline__ unsigned pk2(float lo, float hi) { return f2bf(lo) | (f2bf(hi) << 16); }

#define XB_TMO      128
#define XB_XCNT(j)  (256  + 64 * (j))
#define XB_XSUB(j)  (1280 + 64 * (j))
#define XB_XGEN(j)  (2304 + 64 * (j))
#define XB_TOP      3328
#define XB_TOPGEN   3392
#define XCD_BAR_WORDS 3456
#define XB_SPIN_CAP (1u << 18)

__device__ __forceinline__ unsigned xb_ld(unsigned* p)              { return __hip_atomic_load(p, __ATOMIC_RELAXED, __HIP_MEMORY_SCOPE_AGENT); }
__device__ __forceinline__ unsigned xb_add(unsigned* p, unsigned v) { return __hip_atomic_fetch_add(p, v, __ATOMIC_RELAXED, __HIP_MEMORY_SCOPE_AGENT); }
__device__ __forceinline__ unsigned xb_xcc_id() { return (unsigned)__builtin_amdgcn_s_getreg((3 << 11) | 20) & 0xFu; }
#define XB_SPIN(cond, bar) do { unsigned _sp = 0; while (cond) { __builtin_amdgcn_s_sleep(1); \
    if ((++_sp & 255u) == 0u) { if (xb_ld(&(bar)[XB_TMO])) break; if (_sp > XB_SPIN_CAP) { atomicAdd(&(bar)[XB_TMO], 1u); break; } } } } while (0)

struct XcdBarrier {
    unsigned* bar; unsigned x;
    volatile LAS unsigned* st;
};

__device__ __forceinline__ XcdBarrier xcd_barrier_post(unsigned* bar, volatile LAS unsigned* st, const int tid_) {
    XcdBarrier b; b.bar = bar; b.x = xb_xcc_id(); b.st = st;
    if (tid_ == 0) (void)xb_add(&bar[XB_XCNT(b.x)], 1u);
    return b;
}
__device__ __forceinline__ void xcd_barrier_complete(unsigned* bar, unsigned x, unsigned& nloc, unsigned& nx) {
    const unsigned G = gridDim.x * gridDim.y * gridDim.z;
    unsigned sum, cnt, mine, sp = 0u;
    for (;;) {
        sum = 0u; cnt = 0u; mine = 0u;
#pragma unroll
        for (unsigned j = 0; j < 16; ++j) { const unsigned c = xb_ld(&bar[XB_XCNT(j)]); sum += c; cnt += (c > 0u) ? 1u : 0u; mine = (j == x) ? c : mine; }
        if (sum == G) break;
        __builtin_amdgcn_s_sleep(1);
        if ((++sp & 255u) == 0u) { if (xb_ld(&bar[XB_TMO])) break; if (sp > XB_SPIN_CAP) { atomicAdd(&bar[XB_TMO], 1u); break; } }
    }
    nloc = mine > 0u ? mine : 1u; nx = cnt > 0u ? cnt : 1u;
}

__device__ __forceinline__ void xcd_barrier(const XcdBarrier& b, const int tid_) {
    asm volatile("s_waitcnt vmcnt(0)" ::: "memory");
    __syncthreads();
    if (tid_ == 0) {
        unsigned* bar = b.bar;
        __builtin_amdgcn_s_waitcnt(0);
        unsigned nloc = b.st[0], nx = b.st[1];
        if (nloc == 0u) { xcd_barrier_complete(bar, b.x, nloc, nx); b.st[0] = nloc; b.st[1] = nx; }
        const unsigned old = xb_add(&bar[XB_XSUB(b.x)], 1u);
        const unsigned gen = old / nloc;
        if (old + 1u == (gen + 1u) * nloc) {
            __builtin_amdgcn_fence(__ATOMIC_RELEASE, "agent");
            asm volatile("s_waitcnt vmcnt(0)" ::: "memory");
            const unsigned og = xb_add(&bar[XB_TOP], 1u);
            const unsigned tg = og / nx;
            if (og + 1u == (tg + 1u) * nx) xb_add(&bar[XB_TOPGEN], 1u);
            else XB_SPIN(xb_ld(&bar[XB_TOPGEN]) == tg, bar);
            __builtin_amdgcn_fence(__ATOMIC_ACQUIRE, "agent");
            xb_add(&bar[XB_XGEN(b.x)], 1u);
            asm volatile("s_waitcnt vmcnt(0)" ::: "memory");
        } else {
            XB_SPIN(xb_ld(&bar[XB_XGEN(b.x)]) == gen, bar);
            __builtin_amdgcn_fence(__ATOMIC_ACQUIRE, "agent");
            asm volatile("s_waitcnt vmcnt(0)" ::: "memory");
        }
    }
    __syncthreads();
}


struct Frame {
    LAS unsigned char* lds;
    volatile LAS unsigned* MISC;
    gu32* ctl;
    int wave;
    __device__ __forceinline__ int lane_now() const { return att::lane_of(); }
    int vcu, G;
};
__device__ __forceinline__ float wave_sum(float v) {
#pragma unroll
    for (int o = 1; o < 64; o <<= 1) v += __shfl_xor(v, o);
    return v;
}
__device__ __forceinline__ unsigned short f2bf_s(float f) { return (unsigned short)f2bf(f); }

__device__ __forceinline__ void transpose_item(const float* __restrict__ W, int K, int N, bf16* __restrict__ WT, int mode, LAS float* scr, int item, int lane, const float* __restrict__ gk = nullptr) {
    const int nblk = N / 64, kb = item / nblk, nb = item - kb * nblk, k0 = 64 * kb, n0 = 64 * nb;
    const int q = lane & 15, kr = lane >> 4;
    f32x4 v[16];
#pragma unroll
    for (int i = 0; i < 16; ++i) v[i] = *(const f32x4*)(W + (size_t)(k0 + 4 * i + kr) * N + n0 + 4 * q);
    if (gk) {
#pragma unroll
        for (int i = 0; i < 16; ++i) v[i] = v[i] * gk[k0 + 4 * i + kr]; }
#pragma unroll
    for (int i = 0; i < 16; ++i) { LAS float* s = scr + (4 * i + kr) * 65 + 4 * q; s[0] = v[i].x; s[1] = v[i].y; s[2] = v[i].z; s[3] = v[i].w; }
    LDS_WAIT(); asm volatile("" ::: "memory");
    const int c = lane & 7;
#pragma unroll
    for (int j = 0; j < 8; ++j) { const int n = 8 * j + (lane >> 3); const LAS float* s = scr + (8 * c) * 65 + n;
        v4u o; o.x = pk2(s[0 * 65], s[1 * 65]); o.y = pk2(s[2 * 65], s[3 * 65]); o.z = pk2(s[4 * 65], s[5 * 65]); o.w = pk2(s[6 * 65], s[7 * 65]);
        const int ng = n0 + n; const int row = mode == 0 ? ng : 256 * (ng >> 7) + 128 * (mode - 1) + (ng & 127);
        *(v4u*)(WT + (size_t)row * K + k0 + 8 * c) = o; }
    LDS_WAIT(); asm volatile("" ::: "memory");
}
template <bool OUT_F32>
__device__ __forceinline__ void rms_row(const float* __restrict__ xrow, const float* __restrict__ g, void* orow, int lane) {
    const f32x4* xr = (const f32x4*)xrow + lane; const f32x4* gr = (const f32x4*)g + lane;
    f32x4 v[16]; float s = 0.f;
#pragma unroll
    for (int j = 0; j < 16; ++j) { v[j] = xr[64 * j]; s += (v[j].x * v[j].x + v[j].y * v[j].y) + (v[j].z * v[j].z + v[j].w * v[j].w); }
    const float rstd = 1.f / sqrtf(wave_sum(s) * (1.f / DM) + EPS);
    if constexpr (OUT_F32) { f32x4* o = (f32x4*)orow + lane;
#pragma unroll
        for (int j = 0; j < 16; ++j) { const f32x4 gg = gr[64 * j]; o[64 * j] = v[j] * rstd * gg; } }
    else { unsigned long long* o8 = (unsigned long long*)orow + lane;
#pragma unroll
        for (int j = 0; j < 16; ++j) { const f32x4 gg = gr[64 * j]; const f32x4 y = v[j] * rstd * gg;
            o8[64 * j] = (unsigned long long)pk2(y.x, y.y) | ((unsigned long long)pk2(y.z, y.w) << 32); } }
}
__device__ __forceinline__ void zero_row_bf16(bf16* orow, int lane) {
    unsigned long long* o8 = (unsigned long long*)orow + lane;
#pragma unroll
    for (int j = 0; j < 16; ++j) o8[64 * j] = 0ull;
}

struct Args { const float* in[22]; float* out; unsigned char* ws; int ph_lo, ph_hi, probe, pad; };
typedef const Args __attribute__((address_space(4)))* ArgsP;
#define ARGS_HERE(name) ArgsP name = (ArgsP)__builtin_amdgcn_kernarg_segment_ptr(); asm volatile("" : "+s"(name))

__device__ __forceinline__ void rope_consts(int i, float& rh, float& rl) {
    constexpr float RH[16] = {0x1.45c0000000000p-3f, 0x1.1f00000000000p-4f, 0x1.f980000000000p-6f, 0x1.bd40000000000p-7f, 0x1.8800000000000p-8f, 0x1.5940000000000p-9f, 0x1.3040000000000p-10f, 0x1.0bc0000000000p-11f, 0x1.d800000000000p-13f, 0x1.9f80000000000p-14f, 0x1.6e00000000000p-15f, 0x1.4240000000000p-16f, 0x1.1c00000000000p-17f, 0x1.f440000000000p-19f, 0x1.b880000000000p-20f, 0x1.8400000000000p-21f};
    constexpr float RL[16] = {0x1.9836e40000000p-14f, 0x1.30b61c0000000p-16f, 0x1.600ce80000000p-17f, 0x1.cae3200000000p-19f, 0x1.f6072c0000000p-19f, 0x1.b4dc9a0000000p-20f, 0x1.68c2f60000000p-25f, 0x1.c83dda0000000p-22f, 0x1.9a44960000000p-27f, 0x1.d334540000000p-25f, 0x1.2a1e800000000p-26f, 0x1.cffd9e0000000p-27f, 0x1.0312900000000p-31f, 0x1.19196a0000000p-32f, 0x1.df43180000000p-32f, 0x1.0e74a40000000p-33f};
    rh = RH[0]; rl = RL[0];
#pragma unroll
    for (int k = 1; k < 16; ++k) if (i == k) { rh = RH[k]; rl = RL[k]; }
}
__device__ __forceinline__ void p_weights(Frame& F, ArgsP a, const int set, const int wrank, const int nwaves) {
    LAS float* scr = (LAS float*)(F.lds + RING_OFF + F.wave * TR_BYTES);
    const int lane = F.lane_now();
    unsigned char* ws = a->ws;
    constexpr int I_G = (DM / 64) * (DFF / 64), I_D = (DFF / 64) * (DM / 64), I_IN = (DM / 64) * (IN_W / 64), I_OUT = (DM / 64) * (DM / 64);
    if (set == 0) {
        for (int it = wrank; it < 2 * I_G + I_D + I_OUT; it += nwaves) {
            int r = it;
            if (r < I_G) { transpose_item(a->in[4], DM, DFF, (bf16*)(ws + WS_WA), 1, scr, r, lane, a->in[3]); continue; } r -= I_G;
            if (r < I_G) { transpose_item(a->in[5], DM, DFF, (bf16*)(ws + WS_WA), 2, scr, r, lane, a->in[3]); continue; } r -= I_G;
            if (r < I_D) { transpose_item(a->in[6], DFF, DM, (bf16*)(ws + WS_WD), 0, scr, r, lane); continue; } r -= I_D;
            transpose_item(a->in[16], DM, DM, (bf16*)(ws + WS_WOUT), 0, scr, r, lane);
        }
    } else if (set == 1) {
        for (int it = wrank; it < I_IN; it += nwaves) transpose_item(a->in[8], DM, IN_W, (bf16*)(ws + WS_WIN), 0, scr, it, lane, a->in[7]);
    } else if (set == 2) {
        for (int it = wrank; it < 2 * I_G; it += nwaves) {
            if (it < I_G) transpose_item(a->in[18], DM, DFF, (bf16*)(ws + WS_WA), 1, scr, it, lane, a->in[17]);
            else transpose_item(a->in[19], DM, DFF, (bf16*)(ws + WS_WA), 2, scr, it - I_G, lane, a->in[17]);
        }
    } else {
        for (int it = wrank; it < I_D; it += nwaves) transpose_item(a->in[20], DFF, DM, (bf16*)(ws + WS_WD), 0, scr, it, lane);
    }
}
__device__ __forceinline__ int idle_rank(const int nwg, const int G, const int c, int& nidle) {
    const int last = (nwg + G - 1) / G - 1, first_idle = nwg - last * G;
    nidle = G - first_idle; return c >= first_idle ? c - first_idle : -1;
}
__device__ __forceinline__ void p0_prologue(Frame& F, ArgsP a) {
    {
      float* tab = (float*)(a->ws + WS_ROPE); const int t0 = (F.vcu * NWAVES + F.wave) * 64 + F.lane_now();
      for (int t = t0; t < L_MAX * 16; t += F.G * NWAVES * 64) { const int pos = t >> 4, i = t & 15; float rh, rl; rope_consts(i, rh, rl);
          const float pf = (float)pos, ang = fmaf(pf, rl, __builtin_amdgcn_fractf(pf * rh));
          tab[pos * 32 + i] = __builtin_amdgcn_cosf(ang); tab[pos * 32 + 16 + i] = __builtin_amdgcn_sinf(ang); } }
    p_weights(F, a, 0, F.vcu * NWAVES + F.wave, F.G * NWAVES);
    const int gw = F.vcu * NWAVES + F.wave, NGW = F.G * NWAVES, lane = F.lane_now();
    bf16* HN = (bf16*)(a->ws + WS_HN); float* RSTD = (float*)(a->ws + WS_RSTD);
    for (int m = gw; m < MP; m += NGW) {
        if (m < NTOK + NMETA) { const float* x = m < S_P ? a->in[0] + (size_t)m * DM : (m < NTOK ? a->in[1] + (size_t)(m - S_P) * DM : a->in[2] + (size_t)(m - NTOK) * DM);
            const f32x4* xr = (const f32x4*)x + lane; unsigned long long* o8 = (unsigned long long*)(HN + (size_t)m * DM) + lane; f32x4 v[16]; float s = 0.f;
#pragma unroll
            for (int j = 0; j < 16; ++j) { v[j] = xr[64 * j]; s += (v[j].x * v[j].x + v[j].y * v[j].y) + (v[j].z * v[j].z + v[j].w * v[j].w); }
#pragma unroll
            for (int j = 0; j < 16; ++j) o8[64 * j] = (unsigned long long)pk2(v[j].x, v[j].y) | ((unsigned long long)pk2(v[j].z, v[j].w) << 32);
            s = wave_sum(s); if (lane == 0) RSTD[m] = 1.f / sqrtf(s * (1.f / DM) + EPS); }
        else { zero_row_bf16(HN + (size_t)m * DM, lane); if (lane == 0) RSTD[m] = 1.f; }
    }
}
__device__ __forceinline__ void p_stats(Frame& F, ArgsP a, const int which) {
    const int gw = F.vcu * NWAVES + F.wave, NGW = F.G * NWAVES, lane = F.lane_now();
    const float* SSQP = (const float*)(a->ws + WS_SSQP); float* RSTD = (float*)(a->ws + WS_RSTD);
    for (int m0 = gw; m0 < NTOK; m0 += 12 * NGW) {
        float v[12];
#pragma unroll
        for (int j = 0; j < 12; ++j) { const int m = m0 + j * NGW; v[j] = m < NTOK ? SSQP[(size_t)m * 64 + lane] : 0.f; }
#pragma unroll
        for (int j = 0; j < 12; ++j) { const int m = m0 + j * NGW; const float s = wave_sum(v[j]); if (m < NTOK && lane == 0) RSTD[m] = 1.f / sqrtf(s * (1.f / DM) + EPS); } }
    if (which == 1) { const float* HM = (const float*)(a->ws + WS_HMETA);
        for (int i = gw; i < NMETA; i += NGW) { const f32x4* xr = (const f32x4*)(HM + (size_t)i * DM) + lane; float s = 0.f;
#pragma unroll
            for (int j = 0; j < 16; ++j) { const f32x4 v = xr[64 * j]; s += (v.x * v.x + v.y * v.y) + (v.z * v.z + v.w * v.w); }
            s = wave_sum(s); if (lane == 0) RSTD[NTOK + i] = 1.f / sqrtf(s * (1.f / DM) + EPS); } }
}
template <class Epi> __device__ __forceinline__ void meta_gemm(Frame& F, const bf16* __restrict__ A16, const int lda, const bf16* __restrict__ Bt, const int K, const int nblk, const Epi& E) {
    LAS f32x4* red = (LAS f32x4*)(F.lds + RING_OFF);
    const int lane = F.lane_now(), row = lane & 15, quad = lane >> 4, kw = K / NWAVES;
    for (int cb = F.vcu; cb < nblk; cb += F.G) {
        const bf16* ap = A16 + (size_t)row * lda + F.wave * kw + quad * 8;
        const bf16* bp = Bt + (size_t)(E.brow(cb) + row) * K + F.wave * kw + quad * 8;
        f32x4 acc = {0.f, 0.f, 0.f, 0.f};
#pragma unroll 4
        for (int k = 0; k < kw; k += 32) { const bf16x8 av = *(const bf16x8*)(ap + k), bv = *(const bf16x8*)(bp + k); acc = __builtin_amdgcn_mfma_f32_16x16x32_bf16(bv, av, acc, 0, 0, 0); }
        __syncthreads();
        red[F.wave * 64 + lane] = acc;
        __syncthreads();
        if (F.wave == 0) { f32x4 s = red[lane];
#pragma unroll
            for (int w = 1; w < NWAVES; ++w) s = s + red[w * 64 + lane];
            E(cb, row, 4 * quad, s); }
    }
    __syncthreads();
}
struct MetaEpiDown {
    const float* xm; float* hm; bf16* hb;
    __device__ __forceinline__ int brow(int cb) const { return 16 * cb; }
    __device__ __forceinline__ void operator()(int cb, int r, int c4, f32x4 s) const { const int col = 16 * cb + c4;
        const f32x4 h = *(const f32x4*)(xm + (size_t)r * DM + col) + s * 0.5f; *(f32x4*)(hm + (size_t)r * DM + col) = h;
        *(unsigned long long*)(hb + (size_t)(NTOK + r) * DM + col) = (unsigned long long)pk2(h.x, h.y) | ((unsigned long long)pk2(h.z, h.w) << 32); }
};
struct MetaEpiKV {
    const float* rstd; bf16* pr; const float* tab;
    __device__ __forceinline__ int brow(int cb) const { const int c32 = 32 * cb, seg = c32 >> 11; return (seg == 0 ? C_KNA : seg == 1 ? C_VNA : seg == 2 ? C_KD : C_VD) + (c32 & 2047); }
    __device__ __forceinline__ void operator()(int cb, int r, int c4, f32x4 s0, f32x4 s1) const { const float sc = rstd[NTOK + r]; f32x4 v0 = s0 * sc, v1 = s1 * sc; const int col = brow(cb) + c4;
        if (col >= C_KD && col < C_VD && (col & 127) < 16) {
            const f32x4 c = *(const f32x4*)(tab + r * 32 + c4), s = *(const f32x4*)(tab + r * 32 + 16 + c4); const f32x4 x1 = v0, x2 = v1; v0 = x1 * c - x2 * s; v1 = x1 * s + x2 * c; }
        bf16* p = pr + (size_t)(NTOK + r) * IN_W + col;
        *(unsigned long long*)p = (unsigned long long)pk2(v0.x, v0.y) | ((unsigned long long)pk2(v0.z, v0.w) << 32);
        *(unsigned long long*)(p + 16) = (unsigned long long)pk2(v1.x, v1.y) | ((unsigned long long)pk2(v1.z, v1.w) << 32);
#pragma unroll
        for (int z = 1; z < 4; ++z) { *(unsigned long long*)(p + (size_t)16 * z * IN_W) = 0ull; *(unsigned long long*)(p + (size_t)16 * z * IN_W + 16) = 0ull; } }
};
template <class Epi> __device__ __forceinline__ void meta_gemm2(Frame& F, const bf16* __restrict__ A16, const int lda, const bf16* __restrict__ Bt, const int K, const int nblk, const Epi& E) {
    LAS f32x4* red = (LAS f32x4*)(F.lds + RING_OFF);
    const int lane = F.lane_now(), row = lane & 15, quad = lane >> 4, kw = K / NWAVES;
    for (int cb = F.vcu; cb < nblk; cb += F.G) {
        const bf16* ap = A16 + (size_t)row * lda + F.wave * kw + quad * 8;
        const bf16* bp = Bt + (size_t)(E.brow(cb) + row) * K + F.wave * kw + quad * 8;
        f32x4 acc0 = {0.f, 0.f, 0.f, 0.f}, acc1 = acc0;
#pragma unroll 4
        for (int k = 0; k < kw; k += 32) { const bf16x8 av = *(const bf16x8*)(ap + k), b0 = *(const bf16x8*)(bp + k), b1 = *(const bf16x8*)(bp + (size_t)16 * K + k);
            acc0 = __builtin_amdgcn_mfma_f32_16x16x32_bf16(b0, av, acc0, 0, 0, 0); acc1 = __builtin_amdgcn_mfma_f32_16x16x32_bf16(b1, av, acc1, 0, 0, 0); }
        __syncthreads();
        red[(F.wave * 64 + lane) * 2] = acc0; red[(F.wave * 64 + lane) * 2 + 1] = acc1;
        __syncthreads();
        if (F.wave == 0) { f32x4 s0 = red[lane * 2], s1 = red[lane * 2 + 1];
#pragma unroll
            for (int w = 1; w < NWAVES; ++w) { s0 = s0 + red[(w * 64 + lane) * 2]; s1 = s1 + red[(w * 64 + lane) * 2 + 1]; }
            E(cb, row, 4 * quad, s0, s1); }
    }
    __syncthreads();
}
__device__ __forceinline__ void p_final(Frame& F, ArgsP a) {
    const int gw = F.vcu * NWAVES + F.wave, NGW = F.G * NWAVES, lane = F.lane_now();
    const bf16* H3 = (const bf16*)(a->ws + WS_H3); const float* SSQP = (const float*)(a->ws + WS_SSQP); const f32x4* gr = (const f32x4*)a->in[21] + lane;
    for (int m = gw; m < NTOK; m += NGW) {
        const float rstd = 1.f / sqrtf(wave_sum(SSQP[(size_t)m * 64 + lane]) * (1.f / DM) + EPS);
        const unsigned long long* hr = (const unsigned long long*)(H3 + (size_t)m * DM) + lane;
        f32x4* o = (f32x4*)(a->out + (size_t)m * DM) + lane;
        unsigned long long w[16];
#pragma unroll
        for (int j = 0; j < 16; ++j) w[j] = hr[64 * j];
#pragma unroll
        for (int j = 0; j < 16; ++j) { const unsigned lo = (unsigned)w[j], hi = (unsigned)(w[j] >> 32); const f32x4 gg = gr[64 * j];
            o[64 * j] = (f32x4){__uint_as_float(lo << 16), __uint_as_float(lo & 0xffff0000u), __uint_as_float(hi << 16), __uint_as_float(hi & 0xffff0000u)} * rstd * gg; }
    }
}

__device__ __forceinline__ void diff_unit(Frame& F, ArgsP a, int seq_row0, int S, int h, int qb) {
    using namespace att;
    const att::rsrc_t rs = __builtin_amdgcn_make_buffer_rsrc((void*)(a->ws + WS_BIG), 0, (int)((size_t)MP * IN_W * 2), 0x00020000);
    ATT_LAS char* lds = (ATT_LAS char*)(F.lds + RING_OFF);
    const int qrow0 = seq_row0 + qb * 256, NT = 1 + S / 64;
    for (int map = 0; map < 2; ++map) {
        f32x16 o[8]; float rli[16];
        att2::diff_run(rs, ((unsigned)qrow0 * LD + C_QD + (h * 2 + map) * 128) * 2u, (unsigned)(C_KD + (h * 2 + map) * 128) * 2u, (unsigned)(C_VD + h * 256) * 2u, seq_row0, NT, lds, o, rli, F.wave);
        int ln_ = att::lane_of(); asm volatile("" : "+v"(ln_));
        const int tt = F.wave * 64 + ln_, r32 = ln_ & 31, hi = ln_ >> 5, wv = F.wave;
        float* scrw = (float*)(a->ws + WS_SCR) + (size_t)blockIdx.x * 512 * 128;
        const unsigned so = (unsigned)tt * 128u;
        if (map == 0) {
#pragma unroll
            for (int d = 0; d < 8; ++d)
#pragma unroll
                for (int q = 0; q < 4; ++q) *(f32x4*)(scrw + so + d * 16 + q * 4) = (f32x4){o[d][4 * q] * rli[4 * q], o[d][4 * q + 1] * rli[4 * q + 1], o[d][4 * q + 2] * rli[4 * q + 2], o[d][4 * q + 3] * rli[4 * q + 3]};
        } else {
            float lam; { const int ln = tt & 63; const float* lq1 = a->in[11]; const float* lk1 = a->in[12]; const float* lq2 = a->in[13]; const float* lk2 = a->in[14];
                const float d1 = wave_sum(lq1[ln] * lk1[ln] + lq1[ln + 64] * lk1[ln + 64]), d2 = wave_sum(lq2[ln] * lk2[ln] + lq2[ln + 64] * lk2[ln + 64]);
                lam = expf(d1) - expf(d2) + LAM_INIT; }
#pragma unroll
            for (int r = 0; r < 16; ++r) rli[r] *= -lam;
            float ssq[16];
#pragma unroll
            for (int r = 0; r < 16; ++r) ssq[r] = 0.f;
#pragma unroll
            for (int d = 0; d < 8; ++d) {
#pragma unroll
                for (int q = 0; q < 4; ++q) { const f32x4 t = *(const f32x4*)(scrw + so + d * 16 + q * 4);
#pragma unroll
                    for (int e = 0; e < 4; ++e) { const float v = fmaf(o[d][4 * q + e], rli[4 * q + e], t[e]); ssq[4 * q + e] = fmaf(v, v, ssq[4 * q + e]); } }
                asm volatile("" ::: "memory"); }
#pragma unroll
            for (int r = 0; r < 16; ++r) ssq[r] = (1.0f - LAM_INIT) / sqrtf(half_sum(ssq[r]) * (1.0f / 256.0f) + SUBLN_EPS);
            const float* gn = a->in[15];
            bf16* obase = (bf16*)(a->ws + WS_HN) + (size_t)qrow0 * DM + NA_W + h * 256;
            const unsigned oo = (unsigned)((wv * 32 + 4 * hi) * DM + r32);
#pragma unroll
            for (int d = 0; d < 8; ++d) { const float g = gn[d * 32 + r32];
#pragma unroll
                for (int q = 0; q < 4; ++q) { const f32x4 t = *(const f32x4*)(scrw + so + d * 16 + q * 4);
#pragma unroll
                    for (int e = 0; e < 4; ++e) { const int r = 4 * q + e; const float v = fmaf(o[d][r], rli[r], t[e]);
                        obase[oo + (unsigned)(((r & 3) + 8 * (r >> 2)) * DM + d * 32)] = f2bf_s(v * ssq[r] * g); } }
                asm volatile("" ::: "memory"); }
        }
    }
}
__device__ __forceinline__ void na_unit(Frame& F, ArgsP a, int seq_row0, int nrows, int h, int qb) {
    using namespace att;
    const att::rsrc_t rs = __builtin_amdgcn_make_buffer_rsrc((void*)(a->ws + WS_BIG), 0, (int)((size_t)MP * IN_W * 2), 0x00020000); bf16* MIX = (bf16*)(a->ws + WS_HN);
    ATT_LAS char* lds = (ATT_LAS char*)(F.lds + RING_OFF);
    ATT_LAS float* rpb = (ATT_LAS float*)(F.lds + ATT_RPB_OFF);
    const int lane = F.lane_now(), r32 = lane & 31, hi = lane >> 5;
    __syncthreads();
    for (int i = F.wave * 64 + lane; i < 15 * 31; i += NWAVES * 64) rpb[i] = a->in[9][h * 465 + i] * (1.0f / SCALE);
    const int qrow0 = seq_row0 + qb * 256;
    NaCtx na; na.qrow = 4 * qb + (F.wave >> 1); na.r0 = min(max(na.qrow - 4, 0), nrows - 8); na.kr_first = min(max(4 * qb - 4, 0), nrows - 11);
    na.c = 32 * (F.wave & 1) + r32; na.c0 = min(max(na.c - 8, 0), 48); na.rpb = rpb;
    f32x16 o[4];
    attn_run<true>(rs, ((unsigned)qrow0 * LD + C_QNA + h * 128) * 2u, (unsigned)(C_KNA + h * 128) * 2u, (unsigned)(C_VNA + h * 128) * 2u, seq_row0 + na.kr_first * 64, 12, lds, na, o, F.wave);
    int ln_ = att::lane_of(); asm volatile("" : "+v"(ln_));
    const int e32 = ln_ & 31, ehi = ln_ >> 5, wv = F.wave;
    const float* gn = a->in[10] + h * 128;
    float g[4];
#pragma unroll
    for (int d = 0; d < 4; ++d) g[d] = gn[d * 32 + e32];
    bf16* ob = MIX + (size_t)(qrow0 + wv * 32 + 4 * ehi) * DM + h * 128 + e32;
#pragma unroll
    for (int r = 0; r < 16; ++r) { float s = 0.f;
#pragma unroll
        for (int d = 0; d < 4; ++d) s += o[d][r] * o[d][r];
        const float rs = 1.0f / sqrtf(half_sum(s) * (1.0f / 128.0f) + EPS);
        bf16* op = ob + (size_t)((r & 3) + 8 * (r >> 2)) * DM;
#pragma unroll
        for (int d = 0; d < 4; ++d) op[d * 32] = f2bf_s(o[d][r] * rs * g[d]); }
}
__device__ __forceinline__ void p_attention(Frame& F, ArgsP a) {
    if (F.wave >= 4) __builtin_amdgcn_s_setprio(1);
    const int v = F.vcu;
    for (int u = v; u < 256 + 512; u += F.G) {
        int seq_row0, S, h, qb;
        if (u < 256) { seq_row0 = 0; S = S_P; h = u >> 5; qb = u & 31; }
        else { const int t = u - 256, pair = t >> 4; seq_row0 = S_P + (pair >> 3) * S_S; S = S_S; h = pair & 7; qb = t & 15; }
#ifndef ATT_NO_DIFF
        diff_unit(F, a, seq_row0, S, h, qb);
#endif
    }
    for (int n = v; n < 16 * 96; n += F.G) { const int h = n / 96, q = n - h * 96; int seq_row0, nrows, qb;
        if (q < 32) { seq_row0 = 0; nrows = S_P / 64; qb = q; }
        else { const int t = q - 32; seq_row0 = S_P + (t >> 4) * S_S; nrows = S_S / 64; qb = t & 15; }
#ifndef ATT_NO_NA
        na_unit(F, a, seq_row0, nrows, h, qb);
#endif
    }
    __builtin_amdgcn_s_setprio(0);
}

__global__ void __launch_bounds__(NWAVES * 64, 2) mk_fwd(Args args) {
    extern __shared__ __attribute__((aligned(16))) unsigned char lds[];
    Frame F;
    F.lds = (LAS unsigned char*)lds;
    F.MISC = (volatile LAS unsigned*)(F.lds + MISC_OFF);
    F.wave = __builtin_amdgcn_readfirstlane((int)threadIdx.x >> 6);
    F.G = gridDim.x; { const int bx = blockIdx.x; F.vcu = (F.G % 8 == 0) ? (bx % 8) * (F.G / 8) + bx / 8 : bx; }
    int lo, hi;
    { ARGS_HERE(a0); F.ctl = (gu32*)(a0->ws + WS_CTL); lo = a0->ph_lo; hi = a0->ph_hi; }
    for (int u = F.wave * 64 + F.lane_now(); u < (LDS_BYTES - LDSCTL_OFF) / 4; u += NWAVES * 64) ((LAS unsigned*)(F.lds + LDSCTL_OFF))[u] = 0u;
    __syncthreads();
    XcdBarrier bar; bar.bar = (unsigned*)(F.ctl + CW_BAR); bar.x = 0; bar.st = nullptr;
    if (N_LAUNCHES == 1) bar = xcd_barrier_post((unsigned*)(F.ctl + CW_BAR), F.MISC + 8, F.wave * 64 + att::lane_of());
#ifndef PH_MASK
#define PH_MASK 0xFFF
#endif
#define IN(k) ((((PH_MASK) >> (k)) & 1) && lo <= (k) && (k) < hi)
#define SEAM(k) do { if (IN(k) && IN((k) + 1 + ((k) == 4))) xcd_barrier(bar, F.wave * 64 + att::lane_of()); } while (0)
#define WSP(T, off) ((T*)(a->ws + (off)))

#define PHASE(k) if (IN(k))

    PHASE(0) { ARGS_HERE(a); p0_prologue(F, a); } SEAM(0);
    PHASE(1) {
        ARGS_HERE(a);
        pg8::Gemm g{WSP(bf16, WS_HN), WSP(bf16, WS_WA), MP, 2 * DFF, DM}; pg8::StaticOrder S; S.init(MP, 2 * DFF, F.G, (int)blockIdx.x);
        pg8::EpiSwiglu E{WSP(bf16, WS_BIG), DFF, WSP(float, WS_RSTD)};
        pg8::gemm_phase<pg8::EpiSwiglu, pg8::StaticOrder, true, true>(F.lds + RING_OFF, g, S, E, F.wave);
        { int nidle; const int r = idle_rank(S.nwg, F.G, (int)blockIdx.x, nidle);
          if (nidle == 0) p_weights(F, a, 1, F.vcu * NWAVES + F.wave, F.G * NWAVES); else if (r >= 0) p_weights(F, a, 1, r * NWAVES + F.wave, nidle * NWAVES); } } SEAM(1);
    PHASE(2) {
        ARGS_HERE(a);
        { MetaEpiDown ME{a->in[2], WSP(float, WS_HMETA), WSP(bf16, WS_HB)}; meta_gemm(F, WSP(bf16, WS_BIG) + (size_t)NTOK * DFF, DFF, WSP(bf16, WS_WD), DFF, DM / 16, ME); }
        pg8::Gemm g{WSP(bf16, WS_BIG), WSP(bf16, WS_WD), NTOK, DM, DFF}; pg8::StaticOrder S; S.init(NTOK, DM, F.G, (int)blockIdx.x);
        pg8::EpiRes<1, 1> E{nullptr, nullptr, WSP(bf16, WS_HN), nullptr, WSP(bf16, WS_HB), WSP(float, WS_SSQP), 0.5f, DM};
        pg8::gemm_phase<pg8::EpiRes<1, 1>, pg8::StaticOrder, false, true>(F.lds + RING_OFF, g, S, E, F.wave); } SEAM(2);
    PHASE(3) { ARGS_HERE(a); p_stats(F, a, 1); } SEAM(3);
    PHASE(4) {
        ARGS_HERE(a);
        { MetaEpiKV ME{WSP(float, WS_RSTD), WSP(bf16, WS_BIG), WSP(float, WS_ROPE)}; meta_gemm2(F, WSP(bf16, WS_HB) + (size_t)NTOK * DM, DM, WSP(bf16, WS_WIN), DM, 8192 / 32, ME); }
        pg8::Gemm g{WSP(bf16, WS_HB), WSP(bf16, WS_WIN), NTOK, IN_W, DM}; pg8::StaticOrder S; S.init(NTOK, IN_W, F.G, (int)blockIdx.x);
        pg8::EpiProj E{WSP(bf16, WS_BIG), IN_W, WSP(float, WS_RSTD), WSP(float, WS_ROPE), C_QD / 256, C_VD / 256};
        pg8::gemm_phase<pg8::EpiProj, pg8::StaticOrder, true, true>(F.lds + RING_OFF, g, S, E, F.wave); } SEAM(4);
    PHASE(6) { ARGS_HERE(a); p_attention(F, a); } SEAM(6);
    PHASE(7) {
        ARGS_HERE(a);
        pg8::Gemm g{WSP(bf16, WS_HN), WSP(bf16, WS_WOUT), NTOK, DM, DM}; pg8::StaticOrder S; S.init(NTOK, DM, F.G, (int)blockIdx.x);
        pg8::EpiRes<1, 1> E{nullptr, nullptr, WSP(bf16, WS_HB), nullptr, WSP(bf16, WS_HB), WSP(float, WS_SSQP), 1.0f, DM};
        const bool early = (((int)blockIdx.x >> 3) & 1) == 0;
        if (early) { p_weights(F, a, 2, F.vcu * NWAVES + F.wave, F.G * NWAVES); __syncthreads(); }
        pg8::gemm_phase<pg8::EpiRes<1, 1>, pg8::StaticOrder, false, true>(F.lds + RING_OFF, g, S, E, F.wave);
        if (!early) p_weights(F, a, 2, F.vcu * NWAVES + F.wave, F.G * NWAVES); } SEAM(7);
    PHASE(8) { ARGS_HERE(a); p_stats(F, a, 2); } SEAM(8);
    PHASE(9) {
        ARGS_HERE(a);
        pg8::Gemm g{WSP(bf16, WS_HB), WSP(bf16, WS_WA), NTOK, 2 * DFF, DM}; pg8::StaticOrder S; S.init(NTOK, 2 * DFF, F.G, (int)blockIdx.x);
        pg8::EpiSwiglu E{WSP(bf16, WS_BIG), DFF, WSP(float, WS_RSTD)};
        pg8::gemm_phase<pg8::EpiSwiglu, pg8::StaticOrder, true, true>(F.lds + RING_OFF, g, S, E, F.wave);
        { int nidle; const int r = idle_rank(S.nwg, F.G, (int)blockIdx.x, nidle);
          if (nidle == 0) p_weights(F, a, 3, F.vcu * NWAVES + F.wave, F.G * NWAVES); else if (r >= 0) p_weights(F, a, 3, r * NWAVES + F.wave, nidle * NWAVES); } } SEAM(9);
    PHASE(10) {
        ARGS_HERE(a);
        pg8::Gemm g{WSP(bf16, WS_BIG), WSP(bf16, WS_WD), NTOK, DM, DFF}; pg8::StaticOrder S; S.init(NTOK, DM, F.G, (int)blockIdx.x);
        pg8::EpiRes<1, 1> E{nullptr, nullptr, WSP(bf16, WS_HB), nullptr, WSP(bf16, WS_H3), WSP(float, WS_SSQP), 0.5f, DM};
        pg8::gemm_phase<pg8::EpiRes<1, 1>, pg8::StaticOrder, false, true>(F.lds + RING_OFF, g, S, E, F.wave); } SEAM(10);
    PHASE(11) { ARGS_HERE(a); p_final(F, a); }
#undef PHASE
#undef IN
#undef SEAM
#undef WSP
}

extern "C" void kernel_launch(void* const* d_in, const int* in_sizes, int n_in, void* d_out, int out_size, void* d_ws, size_t ws_size, hipStream_t stream) {
    static int grid = 0;
    if (grid == 0) {
        if (n_in != 22 || in_sizes[0] != S_P * DM || in_sizes[1] != NB_S * S_S * DM || out_size != NTOK * DM || ws_size < WS_END) {
            fprintf(stderr, "kernel_launch: shape mismatch: n_in %d in0 %d in1 %d out %d ws %zu (need %zu)\n", n_in, n_in > 0 ? in_sizes[0] : -1, n_in > 1 ? in_sizes[1] : -1, out_size, ws_size, (size_t)WS_END); grid = -1; return; }
        int dev = 0, cus = 0, per_cu = 0;
        if (hipGetDevice(&dev) != hipSuccess || hipDeviceGetAttribute(&cus, hipDeviceAttributeMultiprocessorCount, dev) != hipSuccess) { grid = -1; return; }
        if (hipFuncSetAttribute((const void*)mk_fwd, hipFuncAttributeMaxDynamicSharedMemorySize, LDS_BYTES) != hipSuccess) { fprintf(stderr, "kernel_launch: hipFuncSetAttribute failed\n"); grid = -1; return; }
        if (hipOccupancyMaxActiveBlocksPerMultiprocessor(&per_cu, (const void*)mk_fwd, NWAVES * 64, LDS_BYTES) != hipSuccess || per_cu < 1)
            fprintf(stderr, "kernel_launch: note: occupancy query reports %d workgroups per CU\n", per_cu);
        (void)hipGetLastError();
        grid = cus;
    }
    if (grid < 0) return;
    if (hipMemsetAsync((char*)d_ws + WS_CTL, 0, CTL_ZERO_BYTES, stream) != hipSuccess) { fprintf(stderr, "kernel_launch: memset failed\n"); return; }
    Args a{};
    for (int i = 0; i < 22; ++i) a.in[i] = (const float*)d_in[i];
    a.out = (float*)d_out; a.ws = (unsigned char*)d_ws;
#if defined(PROBE_TWICE)
    for (int pass_ = 0; pass_ < 2; ++pass_)
#endif
    for (int li = 0; li < N_LAUNCHES; ++li) {
        a.ph_lo = (N_LAUNCHES == 1) ? 0 : li; a.ph_hi = (N_LAUNCHES == 1) ? N_PHASES : li + 1;
        hipLaunchKernelGGL(mk_fwd, dim3(grid), dim3(NWAVES * 64), LDS_BYTES, stream, a);
#if defined(PROBE_REPEAT)
#ifndef PROBE_TIMES
#define PROBE_TIMES 1
#endif
        if (N_LAUNCHES > 1 && (((PROBE_REPEAT) >> li) & 1)) for (int rp_ = 0; rp_ < PROBE_TIMES; ++rp_) hipLaunchKernelGGL(mk_fwd, dim3(grid), dim3(NWAVES * 64), LDS_BYTES, stream, a);
#endif
#if defined(PROBE_SEQ01)
        if (N_LAUNCHES > 1 && li == 1) { Args b = a; b.ph_lo = 0; b.ph_hi = 1; hipLaunchKernelGGL(mk_fwd, dim3(grid), dim3(NWAVES * 64), LDS_BYTES, stream, b); hipLaunchKernelGGL(mk_fwd, dim3(grid), dim3(NWAVES * 64), LDS_BYTES, stream, a); }
#endif
#if defined(PROBE_ROPE)
        if (N_LAUNCHES > 1 && li == 5) { Args b = a; b.probe = 1; hipLaunchKernelGGL(mk_fwd, dim3(grid), dim3(NWAVES * 64), LDS_BYTES, stream, b); hipLaunchKernelGGL(mk_fwd, dim3(grid), dim3(NWAVES * 64), LDS_BYTES, stream, a); }
#endif
#if defined(PROBE_REPEAT_ALT)
        if (N_LAUNCHES > 1 && (((PROBE_REPEAT_ALT) >> li) & 1)) { Args b = a; b.out = (float*)((unsigned char*)d_ws + WS_BIG); b.probe = PROBE_FOLD;
            hipLaunchKernelGGL(mk_fwd, dim3(grid), dim3(NWAVES * 64), LDS_BYTES, stream, b); }
#endif
        const hipError_t le = hipPeekAtLastError();
        if (le != hipSuccess) { fprintf(stderr, "kernel_launch: launch %d failed: %s\n", li, hipGetErrorName(le)); break; }
    }
#if defined(PROBE_APPEND)
    if (N_LAUNCHES > 1) for (int rp_ = 0; rp_ < PROBE_TIMES; ++rp_) for (int li = 0; li < N_PHASES; ++li) if (((PROBE_APPEND) >> li) & 1) {
        a.ph_lo = li; a.ph_hi = li + 1; hipLaunchKernelGGL(mk_fwd, dim3(grid), dim3(NWAVES * 64), LDS_BYTES, stream, a); }
#endif
}
```

```cpp
#include <hip/hip_runtime.h>
#include <cstdio>
#include <cstdint>
#include <cmath>
namespace pg8 {
#define PG8_LAS __attribute__((address_space(3)))
typedef unsigned short bf16_t;
typedef short bf16x8 __attribute__((ext_vector_type(8)));
typedef float f32x4 __attribute__((ext_vector_type(4)));
typedef unsigned u32x4 __attribute__((ext_vector_type(4)));
constexpr int BM = 256, BK = 64, HALF = 128, HTB = HALF * BK * 2  , STAGE_BYTES = 8 * HTB, NXCD = 8, WGM = 8;

__host__ __device__ __forceinline__ int lds_byte(int r, int c) { const int st = (r >> 4) * 2 + (c >> 5), rr = r & 15, cc = c & 31, ob = rr * 64 + cc * 2; return st * 1024 + (ob ^ (((ob >> 9) & 1) << 5)); }
__host__ __device__ __forceinline__ void stage_rc(int b, int& R, int& C) { const int st = b / 1024, sb = b % 1024, swz = sb ^ (((sb >> 9) & 1) << 5); R = (st >> 1) * 16 + swz / 64; C = (st & 1) * 32 + (swz % 64) / 2; }
__host__ __device__ __forceinline__ int perm32(int rho) { const int n = rho >> 4, i = rho & 15; return 8 * (i >> 2) + 4 * n + (i & 3); }

struct Unit { int pm, pn; };
struct Gemm { const bf16_t* A; const bf16_t* Bt; int M, N, K; };

struct StaticOrder {
    int nM, nN, nwg, G, c, fold, mode;
    __host__ __device__ void init(int M, int N, int G_, int c_) { nM = M / BM; nN = N / BM; nwg = nM * nN; G = G_; c = c_; fold = 0; mode = 0; }
    __host__ __device__ int rounds() const {
        if (mode == 1) return (nM / 16) * (nN / 16);
        if (mode == 2) { const int nMm = nM & ~15, nmain = (nMm / 16) * (nN / 2), extra = (nM - nMm) * nN; return (nmain + (extra + 31) / 32 + 7) / 8; }
        return (nwg + G - 1) / G; }
    __host__ __device__ bool next(int i, Unit& u) const {
        if (mode == 1) { const int ncb = nN / 16; if (i >= (nM / 16) * ncb) return false;
            const int rg = i / ncb, cb = i - rg * ncb, x = c & 7, k = c >> 3; u.pm = 16 * rg + 8 * (x & 1) + (k & 7); u.pn = 16 * cb + 4 * (x >> 1) + (k >> 3);
            if (fold) { u.pm &= 1; u.pn &= 1; } return true; }
        if (mode == 2) { const int nMm = nM & ~15, npair = nN / 2, nmain = (nMm / 16) * npair, x = c & 7, k = c >> 3, B = i * 8 + x;
            if (B < nmain) { const int rg = B / npair, cp = B - rg * npair; u.pm = 16 * rg + (k & 15); u.pn = 2 * cp + (k >> 4); }
            else { const int L = (B - nmain) * 32 + k; if (L >= (nM - nMm) * nN) return false; const int q = L / nN; u.pm = nMm + q; u.pn = L - q * nN; }
            if (fold) { u.pm &= 1; u.pn &= 1; } return true; }
        const long L = (long)i * G + c; if (L >= nwg) return false;
        int wgid = (int)L; { const int q = nwg / NXCD, r = nwg % NXCD, xcd = wgid % NXCD, off = wgid / NXCD; wgid = (xcd < r ? xcd * (q + 1) : r * (q + 1) + (xcd - r) * q) + off; }
        const int nig = WGM * nN, gid = wgid / nig, fm = gid * WGM, gsz = (nM - fm) < WGM ? (nM - fm) : WGM;
        u.pm = fm + ((wgid % nig) % gsz); u.pn = (wgid % nig) / gsz; if (fold) { u.pm &= 1; u.pn &= 1; } return true;
    }
    __device__ __forceinline__ void a_ready(const Unit&) const {}
    __device__ __forceinline__ void done(const Unit&) const {}
};

__device__ __forceinline__ unsigned cvt_pk_bf16(float lo, float hi) { unsigned r; asm volatile("v_cvt_pk_bf16_f32 %0, %1, %2" : "=v"(r) : "v"(lo), "v"(hi)); return r; }
typedef float f32x2 __attribute__((ext_vector_type(2)));

__device__ __forceinline__ int pg8_lane_now() { int l; asm volatile("v_mbcnt_lo_u32_b32 %0, -1, 0\n\tv_mbcnt_hi_u32_b32 %0, -1, %0" : "=v"(l)); return l; }
__device__ __forceinline__ float silu_mul(float g, float up) { const float e = __builtin_amdgcn_exp2f(g * -1.4426950408889634f); return g * __builtin_amdgcn_rcpf(1.0f + e) * up; }
__device__ __forceinline__ float bf_lo(unsigned w) { return __uint_as_float(w << 16); }
__device__ __forceinline__ float bf_hi(unsigned w) { return __uint_as_float(w & 0xffff0000u); }
struct EpiSwiglu {
    static constexpr bool PERM = true, AFTER_DRAIN = false;
    bf16_t* O; int ldc; const float* rs;
    __device__ __forceinline__ void operator()(const f32x4 (&acc)[2][2][4][2], const Unit& u, int wr, int wc, int fr, int fq) const {
        const int row0 = u.pm * BM + wr * 64 + fr, col0 = u.pn * HALF + wc * 32 + 8 * fq;
#pragma unroll
        for (int ai = 0; ai < 2; ++ai)
#pragma unroll
            for (int m = 0; m < 4; ++m) { const int row = row0 + ai * HALF + m * 16; bf16_t* rowp = O + (size_t)row * ldc + col0;
                const float sc = rs ? rs[row] : 1.0f;
                float v[8];
#pragma unroll
                for (int n = 0; n < 2; ++n)
#pragma unroll
                    for (int j = 0; j < 4; ++j) v[n * 4 + j] = silu_mul(acc[ai][0][m][n][j] * sc, acc[ai][1][m][n][j] * sc);
                u32x4 w; w.x = cvt_pk_bf16(v[0], v[1]); w.y = cvt_pk_bf16(v[2], v[3]); w.z = cvt_pk_bf16(v[4], v[5]); w.w = cvt_pk_bf16(v[6], v[7]);
                *(u32x4*)rowp = w; }
    }
};
struct EpiProj {
    static constexpr bool PERM = true, AFTER_DRAIN = false;
    bf16_t* O; int ldc; const float* rs; const float* tab; int pn_lo, pn_hi;
    __device__ __forceinline__ void operator()(const f32x4 (&acc)[2][2][4][2], const Unit& u, int wr, int wc, int fr, int fq) const {
        const int row0 = u.pm * BM + wr * 64 + fr, col0 = u.pn * BM + wc * 32 + 8 * fq;
        const bool rope = wc == 0 && u.pn >= pn_lo && u.pn < pn_hi;
        const float sg = fq < 2 ? -1.f : 1.f;
#pragma unroll
        for (int ai = 0; ai < 2; ++ai)
#pragma unroll
            for (int m = 0; m < 4; ++m) { const int row = row0 + ai * HALF + m * 16; bf16_t* rowp = O + (size_t)row * ldc + col0;
                const float sc = rs ? rs[row] : 1.0f;
                f32x4 c0, c1, s0, s1;
                if (rope) { const int pos = row < 8192 ? 16 + row : 16 + ((row - 8192) & 4095); const float* tb = tab + pos * 32 + 8 * (fq & 1);
                    c0 = *(const f32x4*)tb; c1 = *(const f32x4*)(tb + 4); s0 = *(const f32x4*)(tb + 16) * sg; s1 = *(const f32x4*)(tb + 20) * sg; }
#pragma unroll
                for (int bj = 0; bj < 2; ++bj) { f32x4 v0 = acc[ai][bj][m][0] * sc, v1 = acc[ai][bj][m][1] * sc;
                    if (rope) { f32x4 q0, q1;
#pragma unroll
                        for (int e2 = 0; e2 < 4; ++e2) { q0[e2] = __shfl_xor(v0[e2], 32); q1[e2] = __shfl_xor(v1[e2], 32); }
                        v0 = v0 * c0 + q0 * s0; v1 = v1 * c1 + q1 * s1; }
                    u32x4 w; w.x = cvt_pk_bf16(v0[0], v0[1]); w.y = cvt_pk_bf16(v0[2], v0[3]); w.z = cvt_pk_bf16(v1[0], v1[1]); w.w = cvt_pk_bf16(v1[2], v1[3]);
                    *(u32x4*)(rowp + bj * HALF) = w; } }
    }
};
template <int SRC, int DST> struct EpiRes {
    static constexpr bool PERM = true, AFTER_DRAIN = false;
    const float* s0; const float* s1; const bf16_t* sb; float* df; bf16_t* db; float* ssq; float alpha; int ldc;
    __device__ __forceinline__ void operator()(const f32x4 (&acc)[2][2][4][2], const Unit& u, int wr, int wc, int fr, int fq) const {
        const int pm = u.pm;
        const char* sfb = (const char*)(pm < 32 ? s0 + (size_t)pm * BM * ldc : s1 + (size_t)(pm - 32) * BM * ldc);
        const char* sbb = (const char*)(sb + (size_t)pm * BM * ldc); char* dbb = (char*)(db + (size_t)pm * BM * ldc); char* dfb = (char*)(df + (size_t)pm * BM * ldc);
        float* sqb = ssq + (size_t)pm * BM * 64 + 4 * u.pn + wc;
        const int rloc0 = wr * 64 + fr; const unsigned col0 = (unsigned)(u.pn * BM + wc * 32 + 8 * fq);
#pragma unroll
        for (int ai = 0; ai < 2; ++ai) {
            f32x4 hf[SRC == 0 ? 4 : 1][2][2]; u32x4 hw[SRC == 1 ? 4 : 1][2];
            if constexpr (SRC != 2)
#pragma unroll
            for (int m = 0; m < 4; ++m) { const unsigned eoff = (unsigned)(rloc0 + ai * HALF + m * 16) * (unsigned)ldc + col0;
#pragma unroll
                for (int bj = 0; bj < 2; ++bj) {
                    if constexpr (SRC == 0) { hf[m][bj][0] = *(const f32x4*)(sfb + (eoff + bj * HALF) * 4u); hf[m][bj][1] = *(const f32x4*)(sfb + (eoff + bj * HALF + 4) * 4u); }
                    else hw[m][bj] = *(const u32x4*)(sbb + (eoff + bj * HALF) * 2u); } }
#pragma unroll
            for (int m = 0; m < 4; ++m) { const int rloc = rloc0 + ai * HALF + m * 16; const unsigned eoff = (unsigned)rloc * (unsigned)ldc + col0;
                float sq = 0.f;
#pragma unroll
                for (int bj = 0; bj < 2; ++bj) { f32x4 h0, h1;
                    if constexpr (SRC == 0) { h0 = hf[m][bj][0]; h1 = hf[m][bj][1]; }
                    else if constexpr (SRC == 2) { h0 = (f32x4){0.f, 0.f, 0.f, 0.f}; h1 = h0; }
                    else { const u32x4 w = hw[m][bj]; h0 = (f32x4){bf_lo(w.x), bf_hi(w.x), bf_lo(w.y), bf_hi(w.y)}; h1 = (f32x4){bf_lo(w.z), bf_hi(w.z), bf_lo(w.w), bf_hi(w.w)}; }
                    h0 = h0 + acc[ai][bj][m][0] * alpha; h1 = h1 + acc[ai][bj][m][1] * alpha;
                    if constexpr (DST == 1) sq += ((h0[0] * h0[0] + h0[1] * h0[1]) + (h0[2] * h0[2] + h0[3] * h0[3])) + ((h1[0] * h1[0] + h1[1] * h1[1]) + (h1[2] * h1[2] + h1[3] * h1[3]));
                    if constexpr (DST == 0) { *(f32x4*)(dfb + (eoff + bj * HALF) * 4u) = h0; *(f32x4*)(dfb + (eoff + bj * HALF + 4) * 4u) = h1; }
                    else { u32x4 w; w.x = cvt_pk_bf16(h0[0], h0[1]); w.y = cvt_pk_bf16(h0[2], h0[3]); w.z = cvt_pk_bf16(h1[0], h1[1]); w.w = cvt_pk_bf16(h1[2], h1[3]);
                        *(u32x4*)(dbb + (eoff + bj * HALF) * 2u) = w; } }
                if constexpr (DST == 1) { sq += __shfl_xor(sq, 16); sq += __shfl_xor(sq, 32);
                    if (fq == 0) sqb[(unsigned)rloc * 64u] = sq; } }
            asm volatile("" ::: "memory"); }
    }
};

template <class Epi, class Sched, bool ALIGN_EPI = false, bool SP2 = false>
__device__ __forceinline__ void gemm_phase(PG8_LAS unsigned char* lds, const Gemm g, const Sched& S, const Epi& E, const int wave_) {
    const int wid = wave_, lane = pg8_lane_now(), tid = wid * 64 + lane, wr = wid >> 2, wc = wid & 3, fr = lane & 15, fq = lane >> 4;
    const int K = g.K, nt = K / BK;
    unsigned voffA[2], voffB[2];
#pragma unroll
    for (int i = 0; i < 2; ++i) { int R, C; stage_rc(tid * 16 + i * 8192, R, C); const int Rb = Epi::PERM ? ((R & ~31) + perm32(R & 31)) : R;
        voffA[i] = (unsigned)(R * K + C) * 2u; voffB[i] = (unsigned)(Rb * K + C) * 2u; }
    const size_t kstep = (size_t)(BK * 2);
    const size_t hstep = (size_t)HALF * K * 2;
    const size_t tstep = 2 * hstep;
    const unsigned ldsw = (unsigned)wid * 1024u;
    const int aoff = lds_byte(wr * 64 + fr, fq * 8), boff = lds_byte(wc * 32 + fr, fq * 8);
#define PG8_SA(b, h) (((b) * 2 + (h)) * HTB)
#define PG8_SB(b, h) ((4 + (b) * 2 + (h)) * HTB)
#define PG8_STAGE(bufoff, gbase, voff) do { _Pragma("unroll") for (int _i = 0; _i < 2; ++_i) \
        __builtin_amdgcn_global_load_lds((const unsigned*)((const char*)(gbase) + (voff)[_i]), (PG8_LAS unsigned*)(lds + (bufoff) + ldsw + _i * 8192), 16, 0, 0); } while (0)
#define PG8_LDA(dst, b, h) do { _Pragma("unroll") for (int m = 0; m < 4; ++m) _Pragma("unroll") for (int k = 0; k < 2; ++k) dst[m][k] = *(const PG8_LAS bf16x8*)(lds + PG8_SA(b, h) + aoff + m * 2048 + k * 1024); } while (0)
#define PG8_LDB(dst, b, h) do { _Pragma("unroll") for (int n = 0; n < 2; ++n) _Pragma("unroll") for (int k = 0; k < 2; ++k) dst[n][k] = *(const PG8_LAS bf16x8*)(lds + PG8_SB(b, h) + boff + n * 2048 + k * 1024); } while (0)
#define PG8_MMA(ai, bj, At, Bt) do { __builtin_amdgcn_s_setprio(1); _Pragma("unroll") for (int m = 0; m < 4; ++m) _Pragma("unroll") for (int n = 0; n < 2; ++n) _Pragma("unroll") for (int k = 0; k < 2; ++k) \
        acc[ai][bj][m][n] = __builtin_amdgcn_mfma_f32_16x16x32_bf16(Bt[n][k], At[m][k], acc[ai][bj][m][n], 0, 0, 0); __builtin_amdgcn_s_setprio(0); } while (0)
#define PG8_WAIT_V(n) asm volatile("s_waitcnt vmcnt(" #n ")" ::: "memory")
#define PG8_WAIT_L(n) asm volatile("s_waitcnt lgkmcnt(" #n ")" ::: "memory")
#define PG8_BAR __builtin_amdgcn_s_barrier()
#define PG8_SCHED __builtin_amdgcn_sched_barrier(0)
    Unit cur, nxt; int ui = 0;
    if (!S.next(0, cur)) return;
    f32x4 acc[2][2][4][2];
#pragma unroll
    for (int a = 0; a < 2; ++a)
#pragma unroll
        for (int b = 0; b < 2; ++b)
#pragma unroll
            for (int m = 0; m < 4; ++m)
#pragma unroll
                for (int n = 0; n < 2; ++n) acc[a][b][m][n] = (f32x4){0.f, 0.f, 0.f, 0.f};
    bf16x8 At[4][2], B0[2][2], B1[2][2];
    const char* cA = (const char*)g.A + (size_t)cur.pm * tstep; const char* cB = (const char*)g.Bt + (size_t)cur.pn * tstep;
    S.a_ready(cur);
    if constexpr (SP2) {
        PG8_STAGE(PG8_SB(0, 0), cB, voffB); PG8_STAGE(PG8_SB(0, 1), cB + hstep, voffB); PG8_STAGE(PG8_SA(0, 0), cA, voffA); PG8_STAGE(PG8_SA(0, 1), cA + hstep, voffA);
        if (wr == 1) PG8_BAR;
        PG8_WAIT_V(2); PG8_BAR;
        PG8_STAGE(PG8_SB(1, 0), cB + kstep, voffB); PG8_STAGE(PG8_SA(1, 0), cA + kstep, voffA); PG8_STAGE(PG8_SB(1, 1), cB + hstep + kstep, voffB);
        PG8_WAIT_V(6); PG8_BAR;
    } else {
        PG8_STAGE(PG8_SB(0, 0), cB, voffB); PG8_STAGE(PG8_SA(0, 0), cA, voffA); PG8_STAGE(PG8_SB(0, 1), cB + hstep, voffB); PG8_STAGE(PG8_SA(0, 1), cA + hstep, voffA);
        if (wr == 1) PG8_BAR;
        PG8_WAIT_V(4); PG8_BAR;
        PG8_STAGE(PG8_SB(1, 0), cB + kstep, voffB); PG8_STAGE(PG8_SA(1, 0), cA + kstep, voffA); PG8_STAGE(PG8_SB(1, 1), cB + hstep + kstep, voffB);
        PG8_WAIT_V(6); PG8_BAR;
    }
    for (;;) {
        const bool has_next = S.next(ui + 1, nxt);
        const char* nA = has_next ? (const char*)g.A + (size_t)nxt.pm * tstep : cA; const char* nB = has_next ? (const char*)g.Bt + (size_t)nxt.pn * tstep : cB;
        for (int t = 0; t < nt; t += 2) {
            const bool last = (t == nt - 2);
            const char* a1 = cA + (size_t)(t + 1) * kstep;
            const char* a2 = last ? nA : cA + (size_t)(t + 2) * kstep; const char* b2 = last ? nB : cB + (size_t)(t + 2) * kstep;
            const char* a3 = a2 + kstep; const char* b3 = b2 + kstep;
            if (last && has_next) S.a_ready(nxt);
            if constexpr (SP2) {
            PG8_LDB(B0, 0, 0); PG8_LDB(B1, 0, 1); PG8_SCHED; PG8_LDA(At, 0, 0); PG8_STAGE(PG8_SA(1, 1), a1 + hstep, voffA);
            PG8_WAIT_V(8); PG8_WAIT_L(0); PG8_BAR; PG8_MMA(0, 0, At, B0); PG8_MMA(0, 1, At, B1); PG8_BAR; PG8_SCHED;
            PG8_LDA(At, 0, 1); PG8_STAGE(PG8_SB(0, 0), b2, voffB); PG8_STAGE(PG8_SB(0, 1), b2 + hstep, voffB); PG8_STAGE(PG8_SA(0, 0), a2, voffA);
            PG8_WAIT_V(8); PG8_WAIT_L(0); PG8_BAR; PG8_MMA(1, 0, At, B0); PG8_MMA(1, 1, At, B1); PG8_BAR; PG8_SCHED;
            PG8_LDB(B0, 1, 0); PG8_LDB(B1, 1, 1); PG8_SCHED; PG8_LDA(At, 1, 0); PG8_STAGE(PG8_SA(0, 1), a2 + hstep, voffA);
            PG8_WAIT_V(8); PG8_WAIT_L(0); PG8_BAR; PG8_MMA(0, 0, At, B0); PG8_MMA(0, 1, At, B1); PG8_BAR; PG8_SCHED;
            PG8_LDA(At, 1, 1); PG8_STAGE(PG8_SB(1, 0), b3, voffB); PG8_STAGE(PG8_SB(1, 1), b3 + hstep, voffB); PG8_STAGE(PG8_SA(1, 0), a3, voffA);
            PG8_WAIT_V(8); PG8_WAIT_L(0); PG8_BAR; PG8_MMA(1, 0, At, B0); PG8_MMA(1, 1, At, B1); PG8_BAR; PG8_SCHED;
            } else {
            PG8_LDB(B0, 0, 0); PG8_SCHED; PG8_LDA(At, 0, 0); PG8_STAGE(PG8_SA(1, 1), a1 + hstep, voffA);
            PG8_WAIT_L(8); PG8_BAR; PG8_WAIT_L(0); PG8_MMA(0, 0, At, B0); PG8_BAR; PG8_SCHED;
            PG8_LDB(B1, 0, 1); PG8_STAGE(PG8_SB(0, 0), b2, voffB);
            PG8_BAR; PG8_WAIT_L(0); PG8_MMA(0, 1, At, B1); PG8_BAR;
            PG8_LDA(At, 0, 1); PG8_STAGE(PG8_SA(0, 0), a2, voffA);
            PG8_BAR; PG8_WAIT_L(0); PG8_MMA(1, 0, At, B0); PG8_BAR; PG8_SCHED;
            PG8_STAGE(PG8_SB(0, 1), b2 + hstep, voffB);
            PG8_WAIT_V(6); PG8_BAR; PG8_MMA(1, 1, At, B1); PG8_BAR;
            PG8_LDB(B0, 1, 0); PG8_SCHED; PG8_LDA(At, 1, 0); PG8_STAGE(PG8_SA(0, 1), a2 + hstep, voffA);
            PG8_WAIT_L(8); PG8_BAR; PG8_WAIT_L(0); PG8_MMA(0, 0, At, B0); PG8_BAR; PG8_SCHED;
            PG8_LDB(B1, 1, 1); PG8_STAGE(PG8_SB(1, 0), b3, voffB);
            PG8_BAR; PG8_WAIT_L(0); PG8_MMA(0, 1, At, B1); PG8_BAR;
            PG8_LDA(At, 1, 1); PG8_STAGE(PG8_SA(1, 0), a3, voffA);
            PG8_BAR; PG8_WAIT_L(0); PG8_MMA(1, 0, At, B0); PG8_BAR; PG8_SCHED;
            PG8_STAGE(PG8_SB(1, 1), b3 + hstep, voffB);
            PG8_WAIT_V(6); PG8_BAR; PG8_MMA(1, 1, At, B1); PG8_BAR;
            }
        }
        if constexpr (ALIGN_EPI) { if (wr == 0) PG8_BAR; }
        if constexpr (!Epi::AFTER_DRAIN) { E(acc, cur, wr, wc, fr, fq); S.done(cur); }
        if (!has_next) break;
#pragma unroll
        for (int a = 0; a < 2; ++a)
#pragma unroll
            for (int b = 0; b < 2; ++b)
#pragma unroll
                for (int m = 0; m < 4; ++m)
#pragma unroll
                    for (int n = 0; n < 2; ++n) acc[a][b][m][n] = (f32x4){0.f, 0.f, 0.f, 0.f};
        cur = nxt; cA = nA; cB = nB; ++ui;
        if constexpr (ALIGN_EPI) { if (wr == 1) PG8_BAR; }
    }
    PG8_WAIT_V(0);
    if constexpr (!ALIGN_EPI) { if (wr == 0) PG8_BAR; }
    PG8_BAR;
    if constexpr (Epi::AFTER_DRAIN) { E.fused(acc, cur, wr, wc, fr, fq, lds, wid, lane); S.done(cur); }
#undef PG8_SA
#undef PG8_SB
#undef PG8_STAGE
#undef PG8_LDA
#undef PG8_LDB
#undef PG8_MMA
#undef PG8_WAIT_V
#undef PG8_WAIT_L
#undef PG8_BAR
#undef PG8_SCHED
}
}

namespace att {
#define ATT_LAS __attribute__((address_space(3)))
typedef unsigned short bf16_t;
using bf16x8 = __attribute__((ext_vector_type(8))) short;
using s16x4  = __attribute__((ext_vector_type(4))) short;
using f32x16 = __attribute__((ext_vector_type(16))) float;
using u32x4  = __attribute__((ext_vector_type(4))) unsigned;
constexpr int   D = 128, NW = 8, QBLK = 32, KVBLK = 64;
constexpr float SCALE = 0.088388347648318440f;
constexpr float THR = 8.f;
constexpr float NEG = -1.0e30f;
constexpr int   LD = 12288;
constexpr int   META_ROW = 24576;
constexpr int   SHM_V = KVBLK * D * 2, SHM_K = KVBLK * D * 2, SHM_ATTN = 2 * SHM_V + 2 * SHM_K + NW * 64 * 4;
#define KSWZ(row, colB) ((row) * 256 + ((colB) ^ (((row) & 7) << 4)))
#define SBAR() __builtin_amdgcn_sched_barrier(0)
__device__ __forceinline__ int crow(int r, int hi) { return (r & 3) + 8 * (r >> 2) + 4 * hi; }
__device__ __forceinline__ int lane_of() { int l; asm volatile("v_mbcnt_lo_u32_b32 %0, -1, 0\n\tv_mbcnt_hi_u32_b32 %0, -1, %0" : "=v"(l)); return l; }
__device__ __forceinline__ unsigned cvtpk(float lo, float hi) { unsigned r; asm volatile("v_cvt_pk_bf16_f32 %0, %1, %2" : "=v"(r) : "v"(lo), "v"(hi)); return r; }

struct NaCtx { int qrow, r0, kr_first, c, c0; const ATT_LAS float* rpb; };

__device__ __forceinline__ void partialSM(f32x16& p0, f32x16& p1, float& m_reg, float& mn, float& alpha) {
  constexpr float C = SCALE * 1.4426950408889634f;
  float pmax = p0[0];
#pragma unroll
  for (int r = 1; r < 16; ++r) pmax = fmaxf(pmax, p0[r]);
#pragma unroll
  for (int r = 0; r < 16; ++r) pmax = fmaxf(pmax, p1[r]);
  { auto rr = __builtin_amdgcn_permlane32_swap(__float_as_uint(pmax), __float_as_uint(pmax), false, false);
    pmax = fmaxf(__uint_as_float(rr[0]), __uint_as_float(rr[1])); }
  if (__builtin_expect(__all(pmax - m_reg <= THR / SCALE), 1)) { mn = m_reg; alpha = 1.f; }
  else { mn = fmaxf(m_reg, pmax); alpha = __builtin_amdgcn_exp2f((m_reg - mn) * C); m_reg = mn; }
  float mnC = -mn * C;
#pragma unroll
  for (int r = 0; r < 16; ++r) p0[r] = fmaf(p0[r], C, mnC);
#pragma unroll
  for (int r = 0; r < 16; ++r) p1[r] = fmaf(p1[r], C, mnC);
#pragma unroll
  for (int r = 0; r < 16; ++r) p0[r] = __builtin_amdgcn_exp2f(p0[r]);
}
__device__ __forceinline__ void finishSM(f32x16& p0, f32x16& p1, float alpha, float& l_reg, bf16x8& pa0, bf16x8& pa1, bf16x8& pa2, bf16x8& pa3) {
#pragma unroll
  for (int r = 0; r < 16; ++r) p1[r] = __builtin_amdgcn_exp2f(p1[r]);
  float ps = 0;
#pragma unroll
  for (int r = 0; r < 16; ++r) ps += p0[r];
#pragma unroll
  for (int r = 0; r < 16; ++r) ps += p1[r];
  { auto rr = __builtin_amdgcn_permlane32_swap(__float_as_uint(ps), __float_as_uint(ps), false, false);
    ps = __uint_as_float(rr[0]) + __uint_as_float(rr[1]); }
  l_reg = l_reg * alpha + ps;
#define PK4(P, BASE, OUT) do { unsigned a0 = cvtpk(P[BASE + 0], P[BASE + 1]), a1 = cvtpk(P[BASE + 2], P[BASE + 3]);   \
    unsigned b0 = cvtpk(P[BASE + 4], P[BASE + 5]), b1 = cvtpk(P[BASE + 6], P[BASE + 7]);                              \
    auto r0 = __builtin_amdgcn_permlane32_swap(a0, b0, false, false); auto r1 = __builtin_amdgcn_permlane32_swap(a1, b1, false, false); \
    u32x4 w = {r0[0], r1[0], r0[1], r1[1]}; OUT = *reinterpret_cast<bf16x8*>(&w); } while (0)
  PK4(p0, 0, pa0); PK4(p0, 8, pa1); PK4(p1, 0, pa2); PK4(p1, 8, pa3);
#undef PK4
}
__device__ __forceinline__ void qkt(f32x16& p0, f32x16& p1, const ATT_LAS char* Ks, const bf16x8* qr, int r32, int hi) {
  p0 = f32x16{}; p1 = f32x16{};
#pragma unroll
  for (int d0 = 0; d0 < 8; ++d0) { int cb = (d0 * 16 + hi * 8) * 2;
    bf16x8 b0 = *reinterpret_cast<const ATT_LAS bf16x8*>(Ks + KSWZ(r32, cb));
    bf16x8 b1 = *reinterpret_cast<const ATT_LAS bf16x8*>(Ks + KSWZ(32 + r32, cb));
    p0 = __builtin_amdgcn_mfma_f32_32x32x16_bf16(b0, qr[d0], p0, 0, 0, 0);
    p1 = __builtin_amdgcn_mfma_f32_32x32x16_bf16(b1, qr[d0], p1, 0, 0, 0); }
}
__device__ __forceinline__ int v_st(int k, int c) { const int kk = (k & ~0xC) | ((k & 4) << 1) | ((k & 8) >> 1); return ((kk >> 3) * 4 + (c >> 5)) * 512 + ((kk & 7) * 32 + (c & 31)) * 2; }
__device__ __forceinline__ int v_rd_base(int lane) { return ((lane & 3) << 3) | (((lane >> 2) & 3) << 6) | (((lane >> 4) & 1) << 5) | (((lane >> 5) & 1) << 8); }
constexpr int v_rd_off(int d0, int ks, int half) { return d0 * 512 + ks * 4096 + half * 2048; }
template <int OFF> __device__ __forceinline__ s16x4 tr_read(int vb) {
  s16x4 r; asm volatile("ds_read_b64_tr_b16 %0, %1 offset:%2" : "=&v"(r) : "v"(vb), "i"(OFF) : "memory"); return r;
}
template <int D0> __device__ __forceinline__ void pv_one(f32x16& od, int vb, bf16x8 pa0, bf16x8 pa1, bf16x8 pa2, bf16x8 pa3) {
  const s16x4 l0 = tr_read<v_rd_off(D0, 0, 0)>(vb), h0 = tr_read<v_rd_off(D0, 0, 1)>(vb), l1 = tr_read<v_rd_off(D0, 1, 0)>(vb), h1 = tr_read<v_rd_off(D0, 1, 1)>(vb);
  const s16x4 l2 = tr_read<v_rd_off(D0, 2, 0)>(vb), h2 = tr_read<v_rd_off(D0, 2, 1)>(vb), l3 = tr_read<v_rd_off(D0, 3, 0)>(vb), h3 = tr_read<v_rd_off(D0, 3, 1)>(vb);
  asm volatile("s_waitcnt lgkmcnt(0)" ::: "memory"); SBAR();
#define PK(L, H) (bf16x8){L[0], L[1], L[2], L[3], H[0], H[1], H[2], H[3]}
  od = __builtin_amdgcn_mfma_f32_32x32x16_bf16(pa0, PK(l0, h0), od, 0, 0, 0);
  od = __builtin_amdgcn_mfma_f32_32x32x16_bf16(pa1, PK(l1, h1), od, 0, 0, 0);
  od = __builtin_amdgcn_mfma_f32_32x32x16_bf16(pa2, PK(l2, h2), od, 0, 0, 0);
  od = __builtin_amdgcn_mfma_f32_32x32x16_bf16(pa3, PK(l3, h3), od, 0, 0, 0);
#undef PK
}
__device__ __forceinline__ void pv_d0(f32x16* o, int vb, bf16x8 pa0, bf16x8 pa1, bf16x8 pa2, bf16x8 pa3) {
  pv_one<0>(o[0], vb, pa0, pa1, pa2, pa3); pv_one<1>(o[1], vb, pa0, pa1, pa2, pa3); pv_one<2>(o[2], vb, pa0, pa1, pa2, pa3); pv_one<3>(o[3], vb, pa0, pa1, pa2, pa3);
}
template <bool IS_NA> __device__ __forceinline__ void mask_tile(f32x16& p0, f32x16& p1, int j, const NaCtx& na, int hi) {
  if constexpr (IS_NA) {
    const int kr = na.kr_first + (j - 1);
    if ((unsigned)(kr - na.r0) >= 8u) {
#pragma unroll
      for (int r = 0; r < 16; ++r) { p0[r] = NEG; p1[r] = NEG; }
    } else {
      const ATT_LAS float* rb = na.rpb + (kr - na.qrow + 7) * 31 + 15 - na.c + 4 * hi;
      const int dbase = 4 * hi - na.c0;
#pragma unroll
      for (int r = 0; r < 16; ++r) { const int kc = (r & 3) + 8 * (r >> 2);
        const float b0 = rb[kc], b1 = rb[kc + 32];
        p0[r] = ((unsigned)(kc + dbase) < 16u) ? p0[r] + b0 : NEG;
        p1[r] = ((unsigned)(kc + 32 + dbase) < 16u) ? p1[r] + b1 : NEG; }
    }
  }
}

typedef __amdgpu_buffer_rsrc_t rsrc_t;
__device__ __forceinline__ bf16x8 bld(rsrc_t rs, unsigned voff, unsigned soff) { auto v = __builtin_amdgcn_raw_buffer_load_b128(rs, (int)voff, (int)soff, 0); return __builtin_bit_cast(bf16x8, v); }
template <bool IS_NA>
__device__ __forceinline__ void attn_run(const rsrc_t rs, const unsigned qoffB  , const unsigned kcolB, const unsigned vcolB  ,
                                         const int krow1, const int NT, ATT_LAS char* lds, const NaCtx na, f32x16 (&o)[4], const int wid  ) {
  const int lane = lane_of(), tid = wid * 64 + lane, r32 = lane & 31, hi = lane >> 5;
  ATT_LAS char* V_lds = lds; ATT_LAS char* K_lds = lds + 2 * SHM_V;
  ATT_LAS float* wsf = (ATT_LAS float*)(lds + 2 * SHM_V + 2 * SHM_K) + wid * 64; ATT_LAS float* li_l = wsf; ATT_LAS float* al_l = wsf + 32;
  float m_reg = NEG, l_reg = 0; bf16x8 qr[8];
#pragma unroll
  for (int d = 0; d < 4; ++d) o[d] = f32x16{};
  { const unsigned qv = (unsigned)((wid * QBLK + r32) * LD + hi * 8) * 2u;
#pragma unroll
    for (int d0 = 0; d0 < 8; ++d0) qr[d0] = bld(rs, qv + d0 * 32, qoffB); }
  const int sr = tid >> 4, sc = (tid & 15) * 8, vst0 = v_st(sr, sc), vst1 = v_st(32 + sr, sc);
  const int vb0 = (int)(unsigned)(uintptr_t)V_lds + v_rd_base(lane);
  struct { bf16x8 vs0, vs1, ks0, ks1; } sr_[2];
#define TROW(j) ((j) == 0 ? META_ROW : krow1 + ((j) - 1) * KVBLK)
  const unsigned stv = (unsigned)(sr * LD + sc) * 2u;
#define SLOAD(i, j) do { const unsigned t0_ = (unsigned)TROW(j) * (unsigned)(LD * 2); sr_[i].vs0 = bld(rs, stv, t0_ + vcolB); sr_[i].vs1 = bld(rs, stv, t0_ + vcolB + 32u * LD * 2u); \
    sr_[i].ks0 = bld(rs, stv, t0_ + kcolB); sr_[i].ks1 = bld(rs, stv, t0_ + kcolB + 32u * LD * 2u); } while (0)
#define SWRITE(b, i) do { *(ATT_LAS bf16x8*)(V_lds + (b) * SHM_V + vst0) = sr_[i].vs0;          \
    *(ATT_LAS bf16x8*)(V_lds + (b) * SHM_V + vst1) = sr_[i].vs1; const int kc_ = sc * 2;               \
    *(ATT_LAS bf16x8*)(K_lds + (b) * SHM_K + KSWZ(sr, kc_)) = sr_[i].ks0;                       \
    *(ATT_LAS bf16x8*)(K_lds + (b) * SHM_K + KSWZ(32 + sr, kc_)) = sr_[i].ks1; } while (0)
#define SWAIT() asm volatile("s_waitcnt vmcnt(4)" ::: "memory")
#define RESC(a) do { if (__any((a) < 1.f)) { if (hi == 0) al_l[r32] = (a); asm volatile("s_waitcnt lgkmcnt(0)" ::: "memory"); \
    _Pragma("unroll") for (int d = 0; d < 4; ++d) _Pragma("unroll") for (int r = 0; r < 16; ++r) o[d][r] *= al_l[crow(r, hi)]; } } while (0)
  f32x16 pA0, pA1, pB0, pB1; float mnA, mnB, alA, alB; bf16x8 pa0, pa1, pa2, pa3;
  constexpr int SE = 0, SO = 1;
  __syncthreads();
  SLOAD(SE, 0); asm volatile("s_waitcnt vmcnt(0)" ::: "memory"); SWRITE(0, SE); __syncthreads();
  qkt(pA0, pA1, K_lds, qr, r32, hi);
#pragma unroll
  for (int r = 8; r < 16; ++r) pA0[r] = NEG;
#pragma unroll
  for (int r = 0; r < 16; ++r) pA1[r] = NEG;
  partialSM(pA0, pA1, m_reg, mnA, alA);
  SLOAD(SO, 1); if (2 < NT) SLOAD(SE, 2);
  SWAIT(); SWRITE(1, SO); __syncthreads();
  for (int j = 1; j + 2 < NT; j += 2) {
    SBAR(); qkt(pB0, pB1, K_lds + SHM_K, qr, r32, hi);
    finishSM(pA0, pA1, alA, l_reg, pa0, pa1, pa2, pa3); SBAR();
    if (j + 2 < NT) SLOAD(SO, j + 2); SBAR();
    pv_d0(o, vb0, pa0, pa1, pa2, pa3); mask_tile<IS_NA>(pB0, pB1, j, na, hi); partialSM(pB0, pB1, m_reg, mnB, alB);
    __syncthreads(); SWAIT(); SWRITE(0, SE);
    RESC(alB); __syncthreads();
    SBAR(); qkt(pA0, pA1, K_lds, qr, r32, hi);
    finishSM(pB0, pB1, alB, l_reg, pa0, pa1, pa2, pa3); SBAR();
    if (j + 3 < NT) SLOAD(SE, j + 3); SBAR();
    pv_d0(o, vb0 + SHM_V, pa0, pa1, pa2, pa3); mask_tile<IS_NA>(pA0, pA1, j + 1, na, hi); partialSM(pA0, pA1, m_reg, mnA, alA);
    __syncthreads(); SWAIT(); if (j + 2 < NT) SWRITE(1, SO);
    RESC(alA); __syncthreads();
  }
  SBAR(); qkt(pB0, pB1, K_lds + SHM_K, qr, r32, hi);
  finishSM(pA0, pA1, alA, l_reg, pa0, pa1, pa2, pa3); SBAR();
  pv_d0(o, vb0, pa0, pa1, pa2, pa3); mask_tile<IS_NA>(pB0, pB1, NT - 1, na, hi); partialSM(pB0, pB1, m_reg, mnB, alB);
  RESC(alB);
  finishSM(pB0, pB1, alB, l_reg, pa0, pa1, pa2, pa3); SBAR();
  pv_d0(o, vb0 + SHM_V, pa0, pa1, pa2, pa3);
  if (hi == 0) li_l[r32] = l_reg; asm volatile("s_waitcnt lgkmcnt(0)" ::: "memory");
#pragma unroll
  for (int r = 0; r < 16; ++r) { const float rl = __builtin_amdgcn_rcpf(li_l[crow(r, hi)]);
#pragma unroll
    for (int d = 0; d < 4; ++d) o[d][r] *= rl; }
#undef TROW
#undef SLOAD
#undef SWRITE
#undef SWAIT
#undef RESC
}
__device__ __forceinline__ float half_sum(float v) {
#pragma unroll
  for (int o = 1; o < 32; o <<= 1) v += __shfl_xor(v, o);
  return v;
}
}


namespace att2 {
using namespace att;
constexpr int KB = 16384, VB = 32768;
constexpr int L_K = 0, L_V = 2 * KB, L_WS = 2 * KB + 2 * VB, SHM2 = L_WS + NW * 64 * 4;
__device__ __forceinline__ void dma16(const rsrc_t rs, ATT_LAS char* dst, unsigned voff, unsigned soff) { __builtin_amdgcn_raw_ptr_buffer_load_lds(rs, (ATT_LAS void*)dst, 16, (int)voff, (int)soff, 0, 0); }
#define WAITBAR(N) asm volatile("s_waitcnt vmcnt(" #N ") lgkmcnt(0)\n\ts_barrier" ::: "memory")
template <int D0, int VH> __device__ __forceinline__ void pv_one2(f32x16& od, int vb, bf16x8 pa0, bf16x8 pa1, bf16x8 pa2, bf16x8 pa3) {
  constexpr int B = VH * 16384;
  const s16x4 l0 = tr_read<B + v_rd_off(D0, 0, 0)>(vb), h0 = tr_read<B + v_rd_off(D0, 0, 1)>(vb), l1 = tr_read<B + v_rd_off(D0, 1, 0)>(vb), h1 = tr_read<B + v_rd_off(D0, 1, 1)>(vb);
  const s16x4 l2 = tr_read<B + v_rd_off(D0, 2, 0)>(vb), h2 = tr_read<B + v_rd_off(D0, 2, 1)>(vb), l3 = tr_read<B + v_rd_off(D0, 3, 0)>(vb), h3 = tr_read<B + v_rd_off(D0, 3, 1)>(vb);
  asm volatile("s_waitcnt lgkmcnt(0)" ::: "memory"); SBAR();
#define PK(L, H) (bf16x8){L[0], L[1], L[2], L[3], H[0], H[1], H[2], H[3]}
  od = __builtin_amdgcn_mfma_f32_32x32x16_bf16(pa0, PK(l0, h0), od, 0, 0, 0);
  od = __builtin_amdgcn_mfma_f32_32x32x16_bf16(pa1, PK(l1, h1), od, 0, 0, 0);
  od = __builtin_amdgcn_mfma_f32_32x32x16_bf16(pa2, PK(l2, h2), od, 0, 0, 0);
  od = __builtin_amdgcn_mfma_f32_32x32x16_bf16(pa3, PK(l3, h3), od, 0, 0, 0);
#undef PK
}
__device__ __forceinline__ void pv8(f32x16* o, int vb, bf16x8 pa0, bf16x8 pa1, bf16x8 pa2, bf16x8 pa3) {
  pv_one2<0, 0>(o[0], vb, pa0, pa1, pa2, pa3); pv_one2<1, 0>(o[1], vb, pa0, pa1, pa2, pa3); pv_one2<2, 0>(o[2], vb, pa0, pa1, pa2, pa3); pv_one2<3, 0>(o[3], vb, pa0, pa1, pa2, pa3);
  pv_one2<0, 1>(o[4], vb, pa0, pa1, pa2, pa3); pv_one2<1, 1>(o[5], vb, pa0, pa1, pa2, pa3); pv_one2<2, 1>(o[6], vb, pa0, pa1, pa2, pa3); pv_one2<3, 1>(o[7], vb, pa0, pa1, pa2, pa3);
}
template <int BASE> __device__ __forceinline__ bf16x8 pk4t(const f32x16& P) {
  unsigned a0 = cvtpk(P[BASE + 0], P[BASE + 1]), a1 = cvtpk(P[BASE + 2], P[BASE + 3]), b0 = cvtpk(P[BASE + 4], P[BASE + 5]), b1 = cvtpk(P[BASE + 6], P[BASE + 7]);
  auto r0 = __builtin_amdgcn_permlane32_swap(a0, b0, false, false); auto r1 = __builtin_amdgcn_permlane32_swap(a1, b1, false, false);
  u32x4 w = {r0[0], r1[0], r0[1], r1[1]}; return *reinterpret_cast<bf16x8*>(&w);
}
#define TRV(D, KS, HF) tr_read<((D) >> 2) * 16384 + v_rd_off((D) & 3, KS, HF)>(vb)
#define PKF(L, H) (bf16x8){L[0], L[1], L[2], L[3], H[0], H[1], H[2], H[3]}
#define RD2(S, KS, D) do { S##l0 = TRV((D), KS, 0); S##h0 = TRV((D), KS, 1); S##l1 = TRV((D) + 1, KS, 0); S##h1 = TRV((D) + 1, KS, 1); } while (0)
#define GAPV(OD, PA, L, H, STMT) do { OD = __builtin_amdgcn_mfma_f32_32x32x16_bf16(PA, PKF(L, H), OD, 0, 0, 0); STMT SBAR(); } while (0)
__device__ __forceinline__ void pv8_softmax(f32x16* o, const int vb, bf16x8& pa0, bf16x8& pa1, bf16x8& pa2, const bf16x8 pa3, f32x16& p0, f32x16& p1, float& m_reg, float& al, float& ps) {
  constexpr float CSM = SCALE * 1.4426950408889634f;
  s16x4 Al0, Ah0, Al1, Ah1, Bl0, Bh0, Bl1, Bh1; float pm, mn, mnC;
  RD2(A, 0, 0); SBAR();
  asm volatile("s_waitcnt lgkmcnt(0)" ::: "memory"); SBAR();
  RD2(B, 0, 2); SBAR();
  GAPV(o[0], pa0, Al0, Ah0, pm = fmaxf(p0[0], p0[1]); pm = fmaxf(pm, p0[2]); pm = fmaxf(pm, p0[3]); pm = fmaxf(pm, p0[4]); pm = fmaxf(pm, p0[5]); asm volatile("" : "+v"(pm)););
  GAPV(o[1], pa0, Al1, Ah1, pm = fmaxf(pm, p0[6]); pm = fmaxf(pm, p0[7]); pm = fmaxf(pm, p0[8]); pm = fmaxf(pm, p0[9]); pm = fmaxf(pm, p0[10]); pm = fmaxf(pm, p0[11]); asm volatile("" : "+v"(pm)););
  asm volatile("s_waitcnt lgkmcnt(0)" ::: "memory"); SBAR();
  RD2(A, 0, 4); SBAR();
  GAPV(o[2], pa0, Bl0, Bh0, pm = fmaxf(pm, p0[12]); pm = fmaxf(pm, p0[13]); pm = fmaxf(pm, p0[14]); pm = fmaxf(pm, p0[15]); pm = fmaxf(pm, p1[0]); pm = fmaxf(pm, p1[1]); asm volatile("" : "+v"(pm)););
  GAPV(o[3], pa0, Bl1, Bh1, pm = fmaxf(pm, p1[2]); pm = fmaxf(pm, p1[3]); pm = fmaxf(pm, p1[4]); pm = fmaxf(pm, p1[5]); pm = fmaxf(pm, p1[6]); pm = fmaxf(pm, p1[7]); asm volatile("" : "+v"(pm)););
  asm volatile("s_waitcnt lgkmcnt(0)" ::: "memory"); SBAR();
  RD2(B, 0, 6); SBAR();
  GAPV(o[4], pa0, Al0, Ah0, pm = fmaxf(pm, p1[8]); pm = fmaxf(pm, p1[9]); pm = fmaxf(pm, p1[10]); pm = fmaxf(pm, p1[11]); pm = fmaxf(pm, p1[12]); pm = fmaxf(pm, p1[13]); asm volatile("" : "+v"(pm)););
  GAPV(o[5], pa0, Al1, Ah1, pm = fmaxf(pm, p1[14]); pm = fmaxf(pm, p1[15]); { auto rr_ = __builtin_amdgcn_permlane32_swap(__float_as_uint(pm), __float_as_uint(pm), false, false); pm = fmaxf(__uint_as_float(rr_[0]), __uint_as_float(rr_[1])); } asm volatile("" : "+v"(pm)););
  asm volatile("s_waitcnt lgkmcnt(0)" ::: "memory"); SBAR();
  RD2(A, 1, 0); SBAR();
  GAPV(o[6], pa0, Bl0, Bh0, if (__builtin_expect(__all(pm - m_reg <= THR / SCALE), 1)) { mn = m_reg; al = 1.f; } else { mn = fmaxf(m_reg, pm); al = __builtin_amdgcn_exp2f((m_reg - mn) * CSM); m_reg = mn; } mnC = -mn * CSM; asm volatile("" : "+v"(mnC)); asm volatile("" : "+v"(al)););
  GAPV(o[7], pa0, Bl1, Bh1, p0[0] = fmaf(p0[0], CSM, mnC); p0[1] = fmaf(p0[1], CSM, mnC); p0[2] = fmaf(p0[2], CSM, mnC); p0[3] = fmaf(p0[3], CSM, mnC); p0[4] = fmaf(p0[4], CSM, mnC); p0[5] = fmaf(p0[5], CSM, mnC); asm volatile("" : "+v"(p0)););
  asm volatile("s_waitcnt lgkmcnt(0)" ::: "memory"); SBAR();
  RD2(B, 1, 2); SBAR();
  GAPV(o[0], pa1, Al0, Ah0, p0[6] = fmaf(p0[6], CSM, mnC); p0[7] = fmaf(p0[7], CSM, mnC); p0[8] = fmaf(p0[8], CSM, mnC); p0[9] = fmaf(p0[9], CSM, mnC); p0[10] = fmaf(p0[10], CSM, mnC); p0[11] = fmaf(p0[11], CSM, mnC); asm volatile("" : "+v"(p0)););
  GAPV(o[1], pa1, Al1, Ah1, p0[12] = fmaf(p0[12], CSM, mnC); p0[13] = fmaf(p0[13], CSM, mnC); p0[14] = fmaf(p0[14], CSM, mnC); p0[15] = fmaf(p0[15], CSM, mnC); p1[0] = fmaf(p1[0], CSM, mnC); p1[1] = fmaf(p1[1], CSM, mnC); asm volatile("" : "+v"(p0)); asm volatile("" : "+v"(p1)););
  asm volatile("s_waitcnt lgkmcnt(0)" ::: "memory"); SBAR();
  RD2(A, 1, 4); SBAR();
  GAPV(o[2], pa1, Bl0, Bh0, p1[2] = fmaf(p1[2], CSM, mnC); p1[3] = fmaf(p1[3], CSM, mnC); p1[4] = fmaf(p1[4], CSM, mnC); p1[5] = fmaf(p1[5], CSM, mnC); p1[6] = fmaf(p1[6], CSM, mnC); p1[7] = fmaf(p1[7], CSM, mnC); asm volatile("" : "+v"(p1)););
  GAPV(o[3], pa1, Bl1, Bh1, p1[8] = fmaf(p1[8], CSM, mnC); p1[9] = fmaf(p1[9], CSM, mnC); p1[10] = fmaf(p1[10], CSM, mnC); p1[11] = fmaf(p1[11], CSM, mnC); p1[12] = fmaf(p1[12], CSM, mnC); p1[13] = fmaf(p1[13], CSM, mnC); asm volatile("" : "+v"(p1)););
  asm volatile("s_waitcnt lgkmcnt(0)" ::: "memory"); SBAR();
  RD2(B, 1, 6); SBAR();
  GAPV(o[4], pa1, Al0, Ah0, p1[14] = fmaf(p1[14], CSM, mnC); p1[15] = fmaf(p1[15], CSM, mnC); asm volatile("" : "+v"(p1)););
  GAPV(o[5], pa1, Al1, Ah1, p0[0] = __builtin_amdgcn_exp2f(p0[0]); p0[1] = __builtin_amdgcn_exp2f(p0[1]); p0[2] = __builtin_amdgcn_exp2f(p0[2]); asm volatile("" : "+v"(p0)););
  asm volatile("s_waitcnt lgkmcnt(0)" ::: "memory"); SBAR();
  RD2(A, 2, 0); SBAR();
  GAPV(o[6], pa1, Bl0, Bh0, p0[3] = __builtin_amdgcn_exp2f(p0[3]); p0[4] = __builtin_amdgcn_exp2f(p0[4]); p0[5] = __builtin_amdgcn_exp2f(p0[5]); asm volatile("" : "+v"(p0)););
  GAPV(o[7], pa1, Bl1, Bh1, p0[6] = __builtin_amdgcn_exp2f(p0[6]); p0[7] = __builtin_amdgcn_exp2f(p0[7]); p0[8] = __builtin_amdgcn_exp2f(p0[8]); asm volatile("" : "+v"(p0)););
  asm volatile("s_waitcnt lgkmcnt(0)" ::: "memory"); SBAR();
  RD2(B, 2, 2); SBAR();
  GAPV(o[0], pa2, Al0, Ah0, p0[9] = __builtin_amdgcn_exp2f(p0[9]); p0[10] = __builtin_amdgcn_exp2f(p0[10]); p0[11] = __builtin_amdgcn_exp2f(p0[11]); asm volatile("" : "+v"(p0)););
  GAPV(o[1], pa2, Al1, Ah1, p0[12] = __builtin_amdgcn_exp2f(p0[12]); p0[13] = __builtin_amdgcn_exp2f(p0[13]); p0[14] = __builtin_amdgcn_exp2f(p0[14]); asm volatile("" : "+v"(p0)););
  asm volatile("s_waitcnt lgkmcnt(0)" ::: "memory"); SBAR();
  RD2(A, 2, 4); SBAR();
  GAPV(o[2], pa2, Bl0, Bh0, p0[15] = __builtin_amdgcn_exp2f(p0[15]); p1[0] = __builtin_amdgcn_exp2f(p1[0]); p1[1] = __builtin_amdgcn_exp2f(p1[1]); asm volatile("" : "+v"(p0)); asm volatile("" : "+v"(p1)););
  GAPV(o[3], pa2, Bl1, Bh1, p1[2] = __builtin_amdgcn_exp2f(p1[2]); p1[3] = __builtin_amdgcn_exp2f(p1[3]); p1[4] = __builtin_amdgcn_exp2f(p1[4]); asm volatile("" : "+v"(p1)););
  asm volatile("s_waitcnt lgkmcnt(0)" ::: "memory"); SBAR();
  RD2(B, 2, 6); SBAR();
  GAPV(o[4], pa2, Al0, Ah0, p1[5] = __builtin_amdgcn_exp2f(p1[5]); p1[6] = __builtin_amdgcn_exp2f(p1[6]); p1[7] = __builtin_amdgcn_exp2f(p1[7]); asm volatile("" : "+v"(p1)););
  GAPV(o[5], pa2, Al1, Ah1, p1[8] = __builtin_amdgcn_exp2f(p1[8]); p1[9] = __builtin_amdgcn_exp2f(p1[9]); p1[10] = __builtin_amdgcn_exp2f(p1[10]); asm volatile("" : "+v"(p1)););
  asm volatile("s_waitcnt lgkmcnt(0)" ::: "memory"); SBAR();
  RD2(A, 3, 0); SBAR();
  GAPV(o[6], pa2, Bl0, Bh0, p1[11] = __builtin_amdgcn_exp2f(p1[11]); p1[12] = __builtin_amdgcn_exp2f(p1[12]); p1[13] = __builtin_amdgcn_exp2f(p1[13]); asm volatile("" : "+v"(p1)););
  GAPV(o[7], pa2, Bl1, Bh1, p1[14] = __builtin_amdgcn_exp2f(p1[14]); p1[15] = __builtin_amdgcn_exp2f(p1[15]); asm volatile("" : "+v"(p1)););
  asm volatile("s_waitcnt lgkmcnt(0)" ::: "memory"); SBAR();
  RD2(B, 3, 2); SBAR();
  GAPV(o[0], pa3, Al0, Ah0, ps = p0[0] + p0[1]; ps += p0[2]; ps += p0[3]; ps += p0[4]; ps += p0[5]; ps += p0[6]; ps += p0[7]; asm volatile("" : "+v"(ps)););
  GAPV(o[1], pa3, Al1, Ah1, ps += p0[8]; ps += p0[9]; ps += p0[10]; ps += p0[11]; ps += p0[12]; ps += p0[13]; ps += p0[14]; ps += p0[15]; asm volatile("" : "+v"(ps)););
  asm volatile("s_waitcnt lgkmcnt(0)" ::: "memory"); SBAR();
  RD2(A, 3, 4); SBAR();
  GAPV(o[2], pa3, Bl0, Bh0, ps += p1[0]; ps += p1[1]; ps += p1[2]; ps += p1[3]; ps += p1[4]; ps += p1[5]; ps += p1[6]; ps += p1[7]; asm volatile("" : "+v"(ps)););
  GAPV(o[3], pa3, Bl1, Bh1, ps += p1[8]; ps += p1[9]; ps += p1[10]; ps += p1[11]; ps += p1[12]; ps += p1[13]; ps += p1[14]; ps += p1[15]; asm volatile("" : "+v"(ps)););
  asm volatile("s_waitcnt lgkmcnt(0)" ::: "memory"); SBAR();
  RD2(B, 3, 6); SBAR();
  GAPV(o[4], pa3, Al0, Ah0, pa0 = pk4t<0>(p0); asm volatile("" : "+v"(pa0)););
  GAPV(o[5], pa3, Al1, Ah1, pa1 = pk4t<8>(p0); asm volatile("" : "+v"(pa1)););
  asm volatile("s_waitcnt lgkmcnt(0)" ::: "memory"); SBAR();
  GAPV(o[6], pa3, Bl0, Bh0, pa2 = pk4t<0>(p1); asm volatile("" : "+v"(pa2)););
  GAPV(o[7], pa3, Bl1, Bh1, );
}
#undef TRV
#undef RD2
#undef GAPV
#undef PKF
__device__ __forceinline__ void finish_tail(const f32x16& p1, float ps, float alpha, float& l_reg, bf16x8& pa3) {
  { auto rr = __builtin_amdgcn_permlane32_swap(__float_as_uint(ps), __float_as_uint(ps), false, false); ps = __uint_as_float(rr[0]) + __uint_as_float(rr[1]); }
  l_reg = l_reg * alpha + ps;
  pa3 = pk4t<8>(p1);
}
__device__ __forceinline__ void diff_run(const rsrc_t rs, const unsigned qoffB, const unsigned kcolB, const unsigned vcolB  ,
                                         const int krow1, const int NT, ATT_LAS char* lds, f32x16 (&o)[8], float (&rli)[16], const int wid  ) {
  int lane = lane_of(); asm volatile("" : "+v"(lane));
  const int tid = wid * 64 + lane, r32 = lane & 31, hi = lane >> 5;
  ATT_LAS float* wsf = (ATT_LAS float*)(lds + L_WS) + wid * 64; ATT_LAS float* li_l = wsf; ATT_LAS float* al_l = wsf + 32;
  float m_reg = NEG, l_reg = 0; bf16x8 qr[8];
#pragma unroll
  for (int d = 0; d < 8; ++d) o[d] = f32x16{};
  { const unsigned qv = (unsigned)((wid * QBLK + r32) * LD + hi * 8) * 2u;
#pragma unroll
    for (int d0 = 0; d0 < 8; ++d0) qr[d0] = bld(rs, qv + d0 * 32, qoffB); }
  const unsigned kvo = (unsigned)((tid >> 4) * LD * 2 + (((tid & 15) ^ ((tid >> 4) & 7)) << 4));
  const int kkb = (tid >> 7) * 8 + ((tid & 31) >> 2), kbr = (kkb & ~0xC) | ((kkb & 4) << 1) | ((kkb & 8) >> 1);
  const unsigned vvo = (unsigned)(kbr * LD * 2 + ((((tid >> 5) & 3) * 32 + (tid & 3) * 8) << 1));
  ATT_LAS char* kd = lds + L_K + wid * 1024; ATT_LAS char* vd = lds + L_V + wid * 1024;
  constexpr unsigned R32 = 32u * LD * 2u;
#define TROW(j) ((j) == 0 ? META_ROW : krow1 + ((j) - 1) * KVBLK)
#define DMA_K(j, b) do { const unsigned t0_ = (unsigned)TROW(j) * (unsigned)(LD * 2) + kcolB; dma16(rs, kd + (b) * KB, kvo, t0_); dma16(rs, kd + (b) * KB + 8192, kvo, t0_ + R32); } while (0)
#define DMA_V(j, b) do { const unsigned t0_ = (unsigned)TROW(j) * (unsigned)(LD * 2) + vcolB; dma16(rs, vd + (b) * VB, vvo, t0_); dma16(rs, vd + (b) * VB + 8192, vvo, t0_ + R32); \
    dma16(rs, vd + (b) * VB + 16384, vvo, t0_ + 256u); dma16(rs, vd + (b) * VB + 24576, vvo, t0_ + R32 + 256u); } while (0)
#define RESC(a) do { if (__any((a) < 1.f)) { if (hi == 0) al_l[r32] = (a); asm volatile("s_waitcnt lgkmcnt(0)" ::: "memory"); \
    _Pragma("unroll") for (int d = 0; d < 8; ++d) _Pragma("unroll") for (int r = 0; r < 16; ++r) o[d][r] *= al_l[crow(r, hi)]; } } while (0)
  const int vb0 = (int)(unsigned)(uintptr_t)(lds + L_V) + v_rd_base(lane);
  f32x16 p0, p1; float mn, al; bf16x8 pa0, pa1, pa2, pa3;
  asm volatile("s_waitcnt vmcnt(0) lgkmcnt(0)" ::: "memory"); __builtin_amdgcn_s_barrier();
  DMA_K(0, 0); DMA_K(1, 1); DMA_V(0, 0);
  WAITBAR(6);
  {
    SBAR(); qkt(p0, p1, lds + L_K, qr, r32, hi);
#pragma unroll
    for (int r = 8; r < 16; ++r) p0[r] = NEG;
#pragma unroll
    for (int r = 0; r < 16; ++r) p1[r] = NEG;
    WAITBAR(6);
    { const int jn = 2 < NT ? 2 : NT - 1; DMA_K(jn, 0); }
    partialSM(p0, p1, m_reg, mn, al); finishSM(p0, p1, al, l_reg, pa0, pa1, pa2, pa3);
    WAITBAR(6);
    { const int jn = 1 < NT ? 1 : NT - 1; DMA_V(jn, 1); }
  }
  for (int j = 1; j < NT; ++j) {
    const int jb = j & 1;
    int r32o = r32; asm volatile("" : "+v"(r32o));
    SBAR(); qkt(p0, p1, lds + L_K + jb * KB, qr, r32o, hi);
    WAITBAR(6);
    { const int jn = j + 2 < NT ? j + 2 : NT - 1; DMA_K(jn, jb); }
    float ps; pv8_softmax(o, vb0 + (jb ^ 1) * VB, pa0, pa1, pa2, pa3, p0, p1, m_reg, al, ps);
    RESC(al);
    finish_tail(p1, ps, al, l_reg, pa3);
    WAITBAR(6);
    { const int jn = j + 1 < NT ? j + 1 : NT - 1; DMA_V(jn, jb ^ 1); }
  }
  WAITBAR(0);
  pv8(o, vb0 + ((NT - 1) & 1) * VB, pa0, pa1, pa2, pa3);
  if (hi == 0) li_l[r32] = l_reg; asm volatile("s_waitcnt lgkmcnt(0)" ::: "memory");
#pragma unroll
  for (int r = 0; r < 16; ++r) rli[r] = __builtin_amdgcn_rcpf(li_l[crow(r, hi)]);
#undef TROW
#undef DMA_K
#undef DMA_V
#undef RESC
}
#undef WAITBAR
}


#ifndef PROBE_FOLD
#define PROBE_FOLD 0
#endif
#ifndef MK_N_LAUNCHES
#define MK_N_LAUNCHES 1
#endif
constexpr int NWAVES = 8;
constexpr int N_PHASES = 12;
constexpr int N_LAUNCHES = MK_N_LAUNCHES;

constexpr int DM = 4096, DFF = 11008, NMETA = 16;
constexpr int S_P = 8192, S_S = 4096, NB_S = 4;
constexpr int NTOK = S_P + NB_S * S_S;
constexpr int MP = NTOK + 256;
constexpr int NA_W = 2048, DF_W = 2048, IN_W = 12288;
constexpr int C_QNA = 0, C_KNA = 2048, C_VNA = 4096, C_QD = 6144, C_KD = 8192, C_VD = 10240;
constexpr float EPS = 1e-6f, SUBLN_EPS = 1e-5f, LAM_INIT = 0.2f;

constexpr size_t MiB = 1u << 20;
constexpr size_t WS_CTL = 0, CTL_ZERO_BYTES = 1 * MiB;
constexpr size_t SZ_WA = (size_t)2 * DFF * DM * 2, SZ_WD = (size_t)DM * DFF * 2, SZ_WIN = (size_t)IN_W * DM * 2, SZ_WOUT = (size_t)DM * DM * 2;
constexpr size_t WS_WA = 1 * MiB, WS_WD = WS_WA + SZ_WA, WS_WIN = WS_WD + SZ_WD, WS_WOUT = WS_WIN + SZ_WIN;
constexpr size_t WS_HMETA = WS_WOUT + SZ_WOUT;
constexpr size_t WS_RSTD = WS_HMETA + (size_t)NMETA * DM * 4;
constexpr size_t WS_SSQP = WS_RSTD + (size_t)MP * 4 + 3072;
constexpr size_t WS_HN = WS_SSQP + (size_t)NTOK * 64 * 4;
constexpr size_t WS_HB = WS_HN + (size_t)MP * DM * 2;
constexpr size_t WS_BIG = WS_HB + (size_t)MP * DM * 2;
constexpr size_t WS_SCR = WS_BIG + (size_t)MP * IN_W * 2;
constexpr int L_MAX = NMETA + S_P;
constexpr size_t WS_ROPE = WS_SCR + (size_t)256 * 2 * 64 * 512 * 4;
constexpr size_t WS_END = WS_ROPE + (size_t)L_MAX * 32 * 4;
static_assert(WS_SSQP % 256 == 0 && WS_HN % 256 == 0, "alignment");
constexpr size_t WS_H3 = WS_HN;
constexpr int CW_BAR = 4096;

constexpr int RING_OFF = 0, RING_BYTES = 131072;
constexpr int ATT_RPB_OFF = 69632, ATT_SSQ_OFF = ATT_RPB_OFF + 2048;
constexpr int TR_BYTES = 64 * 65 * 4;
constexpr int LDSCTL_OFF = 143360, MISC_OFF = LDSCTL_OFF + 320;
constexpr int LDS_BYTES = 147456;
static_assert(att2::SHM2 <= RING_BYTES && NWAVES * TR_BYTES <= LDSCTL_OFF && att::SHM_ATTN <= ATT_RPB_OFF && ATT_SSQ_OFF + 1024 <= LDSCTL_OFF && MISC_OFF + 128 <= LDS_BYTES, "LDS map");

#define GAS __attribute__((address_space(1)))
#define LAS __attribute__((address_space(3)))
typedef unsigned short bf16;
typedef unsigned v4u __attribute__((ext_vector_type(4)));
typedef float f32x4 __attribute__((ext_vector_type(4)));
typedef short bf16x8 __attribute__((ext_vector_type(8)));
typedef GAS unsigned gu32;
typedef GAS unsigned long long gu64;
#define RLX_AGENT __ATOMIC_RELAXED, __HIP_MEMORY_SCOPE_AGENT
#define LDS_WAIT() asm volatile("s_waitcnt lgkmcnt(0)" ::: "memory")
#define VM_WAIT() asm volatile("s_waitcnt vmcnt(0)" ::: "memory")
__device__ __forceinline__ unsigned long long rt() { return __builtin_amdgcn_s_memrealtime(); }
__device__ __forceinline__ unsigned f2bf(float f) { unsigned u = __builtin_bit_cast(unsigned, f); return (u + 0x7fffu + ((u >> 16) & 1u)) >> 16; }
__device__ __forceinline__ unsigned pk2(float lo, float hi) { return f2bf(lo) | (f2bf(hi) << 16); }

#define XB_TMO      128
#define XB_XCNT(j)  (256  + 64 * (j))
#define XB_XSUB(j)  (1280 + 64 * (j))
#define XB_XGEN(j)  (2304 + 64 * (j))
#define XB_TOP      3328
#define XB_TOPGEN   3392
#define XCD_BAR_WORDS 3456
#define XB_SPIN_CAP (1u << 18)

__device__ __forceinline__ unsigned xb_ld(unsigned* p)              { return __hip_atomic_load(p, __ATOMIC_RELAXED, __HIP_MEMORY_SCOPE_AGENT); }
__device__ __forceinline__ unsigned xb_add(unsigned* p, unsigned v) { return __hip_atomic_fetch_add(p, v, __ATOMIC_RELAXED, __HIP_MEMORY_SCOPE_AGENT); }
__device__ __forceinline__ unsigned xb_xcc_id() { return (unsigned)__builtin_amdgcn_s_getreg((3 << 11) | 20) & 0xFu; }
#define XB_SPIN(cond, bar) do { unsigned _sp = 0; while (cond) { __builtin_amdgcn_s_sleep(1); \
    if ((++_sp & 255u) == 0u) { if (xb_ld(&(bar)[XB_TMO])) break; if (_sp > XB_SPIN_CAP) { atomicAdd(&(bar)[XB_TMO], 1u); break; } } } } while (0)

struct XcdBarrier {
    unsigned* bar; unsigned x;
    volatile LAS unsigned* st;
};

__device__ __forceinline__ XcdBarrier xcd_barrier_post(unsigned* bar, volatile LAS unsigned* st, const int tid_) {
    XcdBarrier b; b.bar = bar; b.x = xb_xcc_id(); b.st = st;
    if (tid_ == 0) (void)xb_add(&bar[XB_XCNT(b.x)], 1u);
    return b;
}
__device__ __forceinline__ void xcd_barrier_complete(unsigned* bar, unsigned x, unsigned& nloc, unsigned& nx) {
    const unsigned G = gridDim.x * gridDim.y * gridDim.z;
    unsigned sum, cnt, mine, sp = 0u;
    for (;;) {
        sum = 0u; cnt = 0u; mine = 0u;
#pragma unroll
        for (unsigned j = 0; j < 16; ++j) { const unsigned c = xb_ld(&bar[XB_XCNT(j)]); sum += c; cnt += (c > 0u) ? 1u : 0u; mine = (j == x) ? c : mine; }
        if (sum == G) break;
        __builtin_amdgcn_s_sleep(1);
        if ((++sp & 255u) == 0u) { if (xb_ld(&bar[XB_TMO])) break; if (sp > XB_SPIN_CAP) { atomicAdd(&bar[XB_TMO], 1u); break; } }
    }
    nloc = mine > 0u ? mine : 1u; nx = cnt > 0u ? cnt : 1u;
}

__device__ __forceinline__ void xcd_barrier(const XcdBarrier& b, const int tid_) {
    asm volatile("s_waitcnt vmcnt(0)" ::: "memory");
    __syncthreads();
    if (tid_ == 0) {
        unsigned* bar = b.bar;
        __builtin_amdgcn_s_waitcnt(0);
        unsigned nloc = b.st[0], nx = b.st[1];
        if (nloc == 0u) { xcd_barrier_complete(bar, b.x, nloc, nx); b.st[0] = nloc; b.st[1] = nx; }
        const unsigned old = xb_add(&bar[XB_XSUB(b.x)], 1u);
        const unsigned gen = old / nloc;
        if (old + 1u == (gen + 1u) * nloc) {
            __builtin_amdgcn_fence(__ATOMIC_RELEASE, "agent");
            asm volatile("s_waitcnt vmcnt(0)" ::: "memory");
            const unsigned og = xb_add(&bar[XB_TOP], 1u);
            const unsigned tg = og / nx;
            if (og + 1u == (tg + 1u) * nx) xb_add(&bar[XB_TOPGEN], 1u);
            else XB_SPIN(xb_ld(&bar[XB_TOPGEN]) == tg, bar);
            __builtin_amdgcn_fence(__ATOMIC_ACQUIRE, "agent");
            xb_add(&bar[XB_XGEN(b.x)], 1u);
            asm volatile("s_waitcnt vmcnt(0)" ::: "memory");
        } else {
            XB_SPIN(xb_ld(&bar[XB_XGEN(b.x)]) == gen, bar);
            __builtin_amdgcn_fence(__ATOMIC_ACQUIRE, "agent");
            asm volatile("s_waitcnt vmcnt(0)" ::: "memory");
        }
    }
    __syncthreads();
}


struct Frame {
    LAS unsigned char* lds;
    volatile LAS unsigned* MISC;
    gu32* ctl;
    int wave;
    __device__ __forceinline__ int lane_now() const { return att::lane_of(); }
    int vcu, G;
};
__device__ __forceinline__ float wave_sum(float v) {
#pragma unroll
    for (int o = 1; o < 64; o <<= 1) v += __shfl_xor(v, o);
    return v;
}
__device__ __forceinline__ unsigned short f2bf_s(float f) { return (unsigned short)f2bf(f); }

__device__ __forceinline__ void transpose_item(const float* __restrict__ W, int K, int N, bf16* __restrict__ WT, int mode, LAS float* scr, int item, int lane, const float* __restrict__ gk = nullptr) {
    const int nblk = N / 64, kb = item / nblk, nb = item - kb * nblk, k0 = 64 * kb, n0 = 64 * nb;
    const int q = lane & 15, kr = lane >> 4;
    f32x4 v[16];
#pragma unroll
    for (int i = 0; i < 16; ++i) v[i] = *(const f32x4*)(W + (size_t)(k0 + 4 * i + kr) * N + n0 + 4 * q);
    if (gk) {
#pragma unroll
        for (int i = 0; i < 16; ++i) v[i] = v[i] * gk[k0 + 4 * i + kr]; }
#pragma unroll
    for (int i = 0; i < 16; ++i) { LAS float* s = scr + (4 * i + kr) * 65 + 4 * q; s[0] = v[i].x; s[1] = v[i].y; s[2] = v[i].z; s[3] = v[i].w; }
    LDS_WAIT(); asm volatile("" ::: "memory");
    const int c = lane & 7;
#pragma unroll
    for (int j = 0; j < 8; ++j) { const int n = 8 * j + (lane >> 3); const LAS float* s = scr + (8 * c) * 65 + n;
        v4u o; o.x = pk2(s[0 * 65], s[1 * 65]); o.y = pk2(s[2 * 65], s[3 * 65]); o.z = pk2(s[4 * 65], s[5 * 65]); o.w = pk2(s[6 * 65], s[7 * 65]);
        const int ng = n0 + n; const int row = mode == 0 ? ng : 256 * (ng >> 7) + 128 * (mode - 1) + (ng & 127);
        *(v4u*)(WT + (size_t)row * K + k0 + 8 * c) = o; }
    LDS_WAIT(); asm volatile("" ::: "memory");
}
template <bool OUT_F32>
__device__ __forceinline__ void rms_row(const float* __restrict__ xrow, const float* __restrict__ g, void* orow, int lane) {
    const f32x4* xr = (const f32x4*)xrow + lane; const f32x4* gr = (const f32x4*)g + lane;
    f32x4 v[16]; float s = 0.f;
#pragma unroll
    for (int j = 0; j < 16; ++j) { v[j] = xr[64 * j]; s += (v[j].x * v[j].x + v[j].y * v[j].y) + (v[j].z * v[j].z + v[j].w * v[j].w); }
    const float rstd = 1.f / sqrtf(wave_sum(s) * (1.f / DM) + EPS);
    if constexpr (OUT_F32) { f32x4* o = (f32x4*)orow + lane;
#pragma unroll
        for (int j = 0; j < 16; ++j) { const f32x4 gg = gr[64 * j]; o[64 * j] = v[j] * rstd * gg; } }
    else { unsigned long long* o8 = (unsigned long long*)orow + lane;
#pragma unroll
        for (int j = 0; j < 16; ++j) { const f32x4 gg = gr[64 * j]; const f32x4 y = v[j] * rstd * gg;
            o8[64 * j] = (unsigned long long)pk2(y.x, y.y) | ((unsigned long long)pk2(y.z, y.w) << 32); } }
}
__device__ __forceinline__ void zero_row_bf16(bf16* orow, int lane) {
    unsigned long long* o8 = (unsigned long long*)orow + lane;
#pragma unroll
    for (int j = 0; j < 16; ++j) o8[64 * j] = 0ull;
}

struct Args { const float* in[22]; float* out; unsigned char* ws; int ph_lo, ph_hi, probe, pad; };
typedef const Args __attribute__((address_space(4)))* ArgsP;
#define ARGS_HERE(name) ArgsP name = (ArgsP)__builtin_amdgcn_kernarg_segment_ptr(); asm volatile("" : "+s"(name))

__device__ __forceinline__ void rope_consts(int i, float& rh, float& rl) {
    constexpr float RH[16] = {0x1.45c0000000000p-3f, 0x1.1f00000000000p-4f, 0x1.f980000000000p-6f, 0x1.bd40000000000p-7f, 0x1.8800000000000p-8f, 0x1.5940000000000p-9f, 0x1.3040000000000p-10f, 0x1.0bc0000000000p-11f, 0x1.d800000000000p-13f, 0x1.9f80000000000p-14f, 0x1.6e00000000000p-15f, 0x1.4240000000000p-16f, 0x1.1c00000000000p-17f, 0x1.f440000000000p-19f, 0x1.b880000000000p-20f, 0x1.8400000000000p-21f};
    constexpr float RL[16] = {0x1.9836e40000000p-14f, 0x1.30b61c0000000p-16f, 0x1.600ce80000000p-17f, 0x1.cae3200000000p-19f, 0x1.f6072c0000000p-19f, 0x1.b4dc9a0000000p-20f, 0x1.68c2f60000000p-25f, 0x1.c83dda0000000p-22f, 0x1.9a44960000000p-27f, 0x1.d334540000000p-25f, 0x1.2a1e800000000p-26f, 0x1.cffd9e0000000p-27f, 0x1.0312900000000p-31f, 0x1.19196a0000000p-32f, 0x1.df43180000000p-32f, 0x1.0e74a40000000p-33f};
    rh = RH[0]; rl = RL[0];
#pragma unroll
    for (int k = 1; k < 16; ++k) if (i == k) { rh = RH[k]; rl = RL[k]; }
}
__device__ __forceinline__ void p_weights(Frame& F, ArgsP a, const int set, const int wrank, const int nwaves) {
    LAS float* scr = (LAS float*)(F.lds + RING_OFF + F.wave * TR_BYTES);
    const int lane = F.lane_now();
    unsigned char* ws = a->ws;
    constexpr int I_G = (DM / 64) * (DFF / 64), I_D = (DFF / 64) * (DM / 64), I_IN = (DM / 64) * (IN_W / 64), I_OUT = (DM / 64) * (DM / 64);
    if (set == 0) {
        for (int it = wrank; it < 2 * I_G + I_D + I_OUT; it += nwaves) {
            int r = it;
            if (r < I_G) { transpose_item(a->in[4], DM, DFF, (bf16*)(ws + WS_WA), 1, scr, r, lane, a->in[3]); continue; } r -= I_G;
            if (r < I_G) { transpose_item(a->in[5], DM, DFF, (bf16*)(ws + WS_WA), 2, scr, r, lane, a->in[3]); continue; } r -= I_G;
            if (r < I_D) { transpose_item(a->in[6], DFF, DM, (bf16*)(ws + WS_WD), 0, scr, r, lane); continue; } r -= I_D;
            transpose_item(a->in[16], DM, DM, (bf16*)(ws + WS_WOUT), 0, scr, r, lane);
        }
    } else if (set == 1) {
        for (int it = wrank; it < I_IN; it += nwaves) transpose_item(a->in[8], DM, IN_W, (bf16*)(ws + WS_WIN), 0, scr, it, lane, a->in[7]);
    } else if (set == 2) {
        for (int it = wrank; it < 2 * I_G; it += nwaves) {
            if (it < I_G) transpose_item(a->in[18], DM, DFF, (bf16*)(ws + WS_WA), 1, scr, it, lane, a->in[17]);
            else transpose_item(a->in[19], DM, DFF, (bf16*)(ws + WS_WA), 2, scr, it - I_G, lane, a->in[17]);
        }
    } else {
        for (int it = wrank; it < I_D; it += nwaves) transpose_item(a->in[20], DFF, DM, (bf16*)(ws + WS_WD), 0, scr, it, lane);
    }
}
__device__ __forceinline__ int idle_rank(const pg8::StaticOrder& S, int& nidle) {
    const int last = S.rounds() - 1; int n = 0, r = -1;
    for (int cc = 0; cc < S.G; ++cc) { pg8::StaticOrder T = S; T.c = cc; pg8::Unit u; if (!T.next(last, u)) { if (cc == S.c) r = n; ++n; } }
    nidle = n; return r;
}
__device__ __forceinline__ void p0_prologue(Frame& F, ArgsP a) {
    {
      float* tab = (float*)(a->ws + WS_ROPE); const int t0 = (F.vcu * NWAVES + F.wave) * 64 + F.lane_now();
      for (int t = t0; t < L_MAX * 16; t += F.G * NWAVES * 64) { const int pos = t >> 4, i = t & 15; float rh, rl; rope_consts(i, rh, rl);
          const float pf = (float)pos, ang = fmaf(pf, rl, __builtin_amdgcn_fractf(pf * rh));
          tab[pos * 32 + i] = __builtin_amdgcn_cosf(ang); tab[pos * 32 + 16 + i] = __builtin_amdgcn_sinf(ang); } }
    p_weights(F, a, 0, F.vcu * NWAVES + F.wave, F.G * NWAVES);
    const int gw = F.vcu * NWAVES + F.wave, NGW = F.G * NWAVES, lane = F.lane_now();
    bf16* HN = (bf16*)(a->ws + WS_HN); float* RSTD = (float*)(a->ws + WS_RSTD);
    for (int m = gw; m < MP; m += NGW) {
        if (m < NTOK + NMETA) { const float* x = m < S_P ? a->in[0] + (size_t)m * DM : (m < NTOK ? a->in[1] + (size_t)(m - S_P) * DM : a->in[2] + (size_t)(m - NTOK) * DM);
            const f32x4* xr = (const f32x4*)x + lane; unsigned long long* o8 = (unsigned long long*)(HN + (size_t)m * DM) + lane; f32x4 v[16]; float s = 0.f;
#pragma unroll
            for (int j = 0; j < 16; ++j) { v[j] = xr[64 * j]; s += (v[j].x * v[j].x + v[j].y * v[j].y) + (v[j].z * v[j].z + v[j].w * v[j].w); }
#pragma unroll
            for (int j = 0; j < 16; ++j) o8[64 * j] = (unsigned long long)pk2(v[j].x, v[j].y) | ((unsigned long long)pk2(v[j].z, v[j].w) << 32);
            s = wave_sum(s); if (lane == 0) RSTD[m] = 1.f / sqrtf(s * (1.f / DM) + EPS); }
        else { zero_row_bf16(HN + (size_t)m * DM, lane); if (lane == 0) RSTD[m] = 1.f; }
    }
}
__device__ __forceinline__ void p_stats(Frame& F, ArgsP a, const int which) {
    const int gw = F.vcu * NWAVES + F.wave, NGW = F.G * NWAVES, lane = F.lane_now();
    const float* SSQP = (const float*)(a->ws + WS_SSQP); float* RSTD = (float*)(a->ws + WS_RSTD);
    for (int m0 = gw; m0 < NTOK; m0 += 12 * NGW) {
        float v[12];
#pragma unroll
        for (int j = 0; j < 12; ++j) { const int m = m0 + j * NGW; v[j] = m < NTOK ? SSQP[(size_t)m * 64 + lane] : 0.f; }
#pragma unroll
        for (int j = 0; j < 12; ++j) { const int m = m0 + j * NGW; const float s = wave_sum(v[j]); if (m < NTOK && lane == 0) RSTD[m] = 1.f / sqrtf(s * (1.f / DM) + EPS); } }
    if (which == 1) { const float* HM = (const float*)(a->ws + WS_HMETA);
        for (int i = gw; i < NMETA; i += NGW) { const f32x4* xr = (const f32x4*)(HM + (size_t)i * DM) + lane; float s = 0.f;
#pragma unroll
            for (int j = 0; j < 16; ++j) { const f32x4 v = xr[64 * j]; s += (v.x * v.x + v.y * v.y) + (v.z * v.z + v.w * v.w); }
            s = wave_sum(s); if (lane == 0) RSTD[NTOK + i] = 1.f / sqrtf(s * (1.f / DM) + EPS); } }
}
template <class Epi> __device__ __forceinline__ void meta_gemm(Frame& F, const bf16* __restrict__ A16, const int lda, const bf16* __restrict__ Bt, const int K, const int nblk, const Epi& E) {
    LAS f32x4* red = (LAS f32x4*)(F.lds + RING_OFF);
    const int lane = F.lane_now(), row = lane & 15, quad = lane >> 4, kw = K / NWAVES;
    for (int cb = F.vcu; cb < nblk; cb += F.G) {
        const bf16* ap = A16 + (size_t)row * lda + F.wave * kw + quad * 8;
        const bf16* bp = Bt + (size_t)(E.brow(cb) + row) * K + F.wave * kw + quad * 8;
        f32x4 acc = {0.f, 0.f, 0.f, 0.f};
#pragma unroll 4
        for (int k = 0; k < kw; k += 32) { const bf16x8 av = *(const bf16x8*)(ap + k), bv = *(const bf16x8*)(bp + k); acc = __builtin_amdgcn_mfma_f32_16x16x32_bf16(bv, av, acc, 0, 0, 0); }
        __syncthreads();
        red[F.wave * 64 + lane] = acc;
        __syncthreads();
        if (F.wave == 0) { f32x4 s = red[lane];
#pragma unroll
            for (int w = 1; w < NWAVES; ++w) s = s + red[w * 64 + lane];
            E(cb, row, 4 * quad, s); }
    }
    __syncthreads();
}
struct MetaEpiDown {
    const float* xm; float* hm; bf16* hb;
    __device__ __forceinline__ int brow(int cb) const { return 16 * cb; }
    __device__ __forceinline__ void operator()(int cb, int r, int c4, f32x4 s) const { const int col = 16 * cb + c4;
        const f32x4 h = *(const f32x4*)(xm + (size_t)r * DM + col) + s * 0.5f; *(f32x4*)(hm + (size_t)r * DM + col) = h;
        *(unsigned long long*)(hb + (size_t)(NTOK + r) * DM + col) = (unsigned long long)pk2(h.x, h.y) | ((unsigned long long)pk2(h.z, h.w) << 32); }
};
struct MetaEpiKV {
    const float* rstd; bf16* pr; const float* tab;
    __device__ __forceinline__ int brow(int cb) const { const int c32 = 32 * cb, seg = c32 >> 11; return (seg == 0 ? C_KNA : seg == 1 ? C_VNA : seg == 2 ? C_KD : C_VD) + (c32 & 2047); }
    __device__ __forceinline__ void operator()(int cb, int r, int c4, f32x4 s0, f32x4 s1) const { const float sc = rstd[NTOK + r]; f32x4 v0 = s0 * sc, v1 = s1 * sc; const int col = brow(cb) + c4;
        if (col >= C_KD && col < C_VD && (col & 127) < 16) {
            const f32x4 c = *(const f32x4*)(tab + r * 32 + c4), s = *(const f32x4*)(tab + r * 32 + 16 + c4); const f32x4 x1 = v0, x2 = v1; v0 = x1 * c - x2 * s; v1 = x1 * s + x2 * c; }
        bf16* p = pr + (size_t)(NTOK + r) * IN_W + col;
        *(unsigned long long*)p = (unsigned long long)pk2(v0.x, v0.y) | ((unsigned long long)pk2(v0.z, v0.w) << 32);
        *(unsigned long long*)(p + 16) = (unsigned long long)pk2(v1.x, v1.y) | ((unsigned long long)pk2(v1.z, v1.w) << 32);
#pragma unroll
        for (int z = 1; z < 4; ++z) { *(unsigned long long*)(p + (size_t)16 * z * IN_W) = 0ull; *(unsigned long long*)(p + (size_t)16 * z * IN_W + 16) = 0ull; } }
};
template <class Epi> __device__ __forceinline__ void meta_gemm2(Frame& F, const bf16* __restrict__ A16, const int lda, const bf16* __restrict__ Bt, const int K, const int nblk, const Epi& E) {
    LAS f32x4* red = (LAS f32x4*)(F.lds + RING_OFF);
    const int lane = F.lane_now(), row = lane & 15, quad = lane >> 4, kw = K / NWAVES;
    for (int cb = F.vcu; cb < nblk; cb += F.G) {
        const bf16* ap = A16 + (size_t)row * lda + F.wave * kw + quad * 8;
        const bf16* bp = Bt + (size_t)(E.brow(cb) + row) * K + F.wave * kw + quad * 8;
        f32x4 acc0 = {0.f, 0.f, 0.f, 0.f}, acc1 = acc0;
#pragma unroll 4
        for (int k = 0; k < kw; k += 32) { const bf16x8 av = *(const bf16x8*)(ap + k), b0 = *(const bf16x8*)(bp + k), b1 = *(const bf16x8*)(bp + (size_t)16 * K + k);
            acc0 = __builtin_amdgcn_mfma_f32_16x16x32_bf16(b0, av, acc0, 0, 0, 0); acc1 = __builtin_amdgcn_mfma_f32_16x16x32_bf16(b1, av, acc1, 0, 0, 0); }
        __syncthreads();
        red[(F.wave * 64 + lane) * 2] = acc0; red[(F.wave * 64 + lane) * 2 + 1] = acc1;
        __syncthreads();
        if (F.wave == 0) { f32x4 s0 = red[lane * 2], s1 = red[lane * 2 + 1];
#pragma unroll
            for (int w = 1; w < NWAVES; ++w) { s0 = s0 + red[(w * 64 + lane) * 2]; s1 = s1 + red[(w * 64 + lane) * 2 + 1]; }
            E(cb, row, 4 * quad, s0, s1); }
    }
    __syncthreads();
}
__device__ __forceinline__ void p_final(Frame& F, ArgsP a) {
    const int gw = F.vcu * NWAVES + F.wave, NGW = F.G * NWAVES, lane = F.lane_now();
    const bf16* H3 = (const bf16*)(a->ws + WS_H3); const float* SSQP = (const float*)(a->ws + WS_SSQP); const f32x4* gr = (const f32x4*)a->in[21] + lane;
    for (int m = gw; m < NTOK; m += NGW) {
        const float rstd = 1.f / sqrtf(wave_sum(SSQP[(size_t)m * 64 + lane]) * (1.f / DM) + EPS);
        const unsigned long long* hr = (const unsigned long long*)(H3 + (size_t)m * DM) + lane;
        f32x4* o = (f32x4*)(a->out + (size_t)m * DM) + lane;
        unsigned long long w[16];
#pragma unroll
        for (int j = 0; j < 16; ++j) w[j] = hr[64 * j];
#pragma unroll
        for (int j = 0; j < 16; ++j) { const unsigned lo = (unsigned)w[j], hi = (unsigned)(w[j] >> 32); const f32x4 gg = gr[64 * j];
            o[64 * j] = (f32x4){__uint_as_float(lo << 16), __uint_as_float(lo & 0xffff0000u), __uint_as_float(hi << 16), __uint_as_float(hi & 0xffff0000u)} * rstd * gg; }
    }
}

__device__ __forceinline__ void diff_unit(Frame& F, ArgsP a, int seq_row0, int S, int h, int qb) {
    using namespace att;
    const att::rsrc_t rs = __builtin_amdgcn_make_buffer_rsrc((void*)(a->ws + WS_BIG), 0, (int)((size_t)MP * IN_W * 2), 0x00020000);
    ATT_LAS char* lds = (ATT_LAS char*)(F.lds + RING_OFF);
    const int qrow0 = seq_row0 + qb * 256, NT = 1 + S / 64;
    for (int map = 0; map < 2; ++map) {
        f32x16 o[8]; float rli[16];
        att2::diff_run(rs, ((unsigned)qrow0 * LD + C_QD + (h * 2 + map) * 128) * 2u, (unsigned)(C_KD + (h * 2 + map) * 128) * 2u, (unsigned)(C_VD + h * 256) * 2u, seq_row0, NT, lds, o, rli, F.wave);
        int ln_ = att::lane_of(); asm volatile("" : "+v"(ln_));
        const int tt = F.wave * 64 + ln_, r32 = ln_ & 31, hi = ln_ >> 5, wv = F.wave;
        float* scrw = (float*)(a->ws + WS_SCR) + (size_t)blockIdx.x * 512 * 128;
        const unsigned so = (unsigned)tt * 128u;
        if (map == 0) {
#pragma unroll
            for (int d = 0; d < 8; ++d)
#pragma unroll
                for (int q = 0; q < 4; ++q) *(f32x4*)(scrw + so + d * 16 + q * 4) = (f32x4){o[d][4 * q] * rli[4 * q], o[d][4 * q + 1] * rli[4 * q + 1], o[d][4 * q + 2] * rli[4 * q + 2], o[d][4 * q + 3] * rli[4 * q + 3]};
        } else {
            float lam; { const int ln = tt & 63; const float* lq1 = a->in[11]; const float* lk1 = a->in[12]; const float* lq2 = a->in[13]; const float* lk2 = a->in[14];
                const float d1 = wave_sum(lq1[ln] * lk1[ln] + lq1[ln + 64] * lk1[ln + 64]), d2 = wave_sum(lq2[ln] * lk2[ln] + lq2[ln + 64] * lk2[ln + 64]);
                lam = expf(d1) - expf(d2) + LAM_INIT; }
#pragma unroll
            for (int r = 0; r < 16; ++r) rli[r] *= -lam;
            float ssq[16];
#pragma unroll
            for (int r = 0; r < 16; ++r) ssq[r] = 0.f;
#pragma unroll
            for (int d = 0; d < 8; ++d) {
#pragma unroll
                for (int q = 0; q < 4; ++q) { const f32x4 t = *(const f32x4*)(scrw + so + d * 16 + q * 4);
#pragma unroll
                    for (int e = 0; e < 4; ++e) { const float v = fmaf(o[d][4 * q + e], rli[4 * q + e], t[e]); ssq[4 * q + e] = fmaf(v, v, ssq[4 * q + e]); } }
                asm volatile("" ::: "memory"); }
#pragma unroll
            for (int r = 0; r < 16; ++r) ssq[r] = (1.0f - LAM_INIT) / sqrtf(half_sum(ssq[r]) * (1.0f / 256.0f) + SUBLN_EPS);
            const float* gn = a->in[15];
            bf16* obase = (bf16*)(a->ws + WS_HN) + (size_t)qrow0 * DM + NA_W + h * 256;
            const unsigned oo = (unsigned)((wv * 32 + 4 * hi) * DM + r32);
#pragma unroll
            for (int d = 0; d < 8; ++d) { const float g = gn[d * 32 + r32];
#pragma unroll
                for (int q = 0; q < 4; ++q) { const f32x4 t = *(const f32x4*)(scrw + so + d * 16 + q * 4);
#pragma unroll
                    for (int e = 0; e < 4; ++e) { const int r = 4 * q + e; const float v = fmaf(o[d][r], rli[r], t[e]);
                        obase[oo + (unsigned)(((r & 3) + 8 * (r >> 2)) * DM + d * 32)] = f2bf_s(v * ssq[r] * g); } }
                asm volatile("" ::: "memory"); }
        }
    }
}
__device__ __forceinline__ void na_unit(Frame& F, ArgsP a, int seq_row0, int nrows, int h, int qb) {
    using namespace att;
    const att::rsrc_t rs = __builtin_amdgcn_make_buffer_rsrc((void*)(a->ws + WS_BIG), 0, (int)((size_t)MP * IN_W * 2), 0x00020000); bf16* MIX = (bf16*)(a->ws + WS_HN);
    ATT_LAS char* lds = (ATT_LAS char*)(F.lds + RING_OFF);
    ATT_LAS float* rpb = (ATT_LAS float*)(F.lds + ATT_RPB_OFF);
    const int lane = F.lane_now(), r32 = lane & 31, hi = lane >> 5;
    __syncthreads();
    for (int i = F.wave * 64 + lane; i < 15 * 31; i += NWAVES * 64) rpb[i] = a->in[9][h * 465 + i] * (1.0f / SCALE);
    const int qrow0 = seq_row0 + qb * 256;
    NaCtx na; na.qrow = 4 * qb + (F.wave >> 1); na.r0 = min(max(na.qrow - 4, 0), nrows - 8); na.kr_first = min(max(4 * qb - 4, 0), nrows - 11);
    na.c = 32 * (F.wave & 1) + r32; na.c0 = min(max(na.c - 8, 0), 48); na.rpb = rpb;
    f32x16 o[4];
    attn_run<true>(rs, ((unsigned)qrow0 * LD + C_QNA + h * 128) * 2u, (unsigned)(C_KNA + h * 128) * 2u, (unsigned)(C_VNA + h * 128) * 2u, seq_row0 + na.kr_first * 64, 12, lds, na, o, F.wave);
    int ln_ = att::lane_of(); asm volatile("" : "+v"(ln_));
    const int e32 = ln_ & 31, ehi = ln_ >> 5, wv = F.wave;
    const float* gn = a->in[10] + h * 128;
    float g[4];
#pragma unroll
    for (int d = 0; d < 4; ++d) g[d] = gn[d * 32 + e32];
    bf16* ob = MIX + (size_t)(qrow0 + wv * 32 + 4 * ehi) * DM + h * 128 + e32;
#pragma unroll
    for (int r = 0; r < 16; ++r) { float s = 0.f;
#pragma unroll
        for (int d = 0; d < 4; ++d) s += o[d][r] * o[d][r];
        const float rs = 1.0f / sqrtf(half_sum(s) * (1.0f / 128.0f) + EPS);
        bf16* op = ob + (size_t)((r & 3) + 8 * (r >> 2)) * DM;
#pragma unroll
        for (int d = 0; d < 4; ++d) op[d * 32] = f2bf_s(o[d][r] * rs * g[d]); }
}
__device__ __forceinline__ void p_attention(Frame& F, ArgsP a) {
    if (F.wave >= 4) __builtin_amdgcn_s_setprio(1);
    const int v = F.vcu;
    for (int u = v; u < 256 + 512; u += F.G) {
        int seq_row0, S, h, qb;
        if (u < 256) { seq_row0 = 0; S = S_P; h = u >> 5; qb = u & 31; }
        else { const int t = u - 256, pair = t >> 4; seq_row0 = S_P + (pair >> 3) * S_S; S = S_S; h = pair & 7; qb = t & 15; }
#ifndef ATT_NO_DIFF
        diff_unit(F, a, seq_row0, S, h, qb);
#endif
    }
    for (int n = v; n < 16 * 96; n += F.G) { const int h = n / 96, q = n - h * 96; int seq_row0, nrows, qb;
        if (q < 32) { seq_row0 = 0; nrows = S_P / 64; qb = q; }
        else { const int t = q - 32; seq_row0 = S_P + (t >> 4) * S_S; nrows = S_S / 64; qb = t & 15; }
#ifndef ATT_NO_NA
        na_unit(F, a, seq_row0, nrows, h, qb);
#endif
    }
    __builtin_amdgcn_s_setprio(0);
}

__global__ void __launch_bounds__(NWAVES * 64, 2) mk_fwd(Args args) {
    extern __shared__ __attribute__((aligned(16))) unsigned char lds[];
    Frame F;
    F.lds = (LAS unsigned char*)lds;
    F.MISC = (volatile LAS unsigned*)(F.lds + MISC_OFF);
    F.wave = __builtin_amdgcn_readfirstlane((int)threadIdx.x >> 6);
    F.G = gridDim.x; { const int bx = blockIdx.x; F.vcu = (F.G % 8 == 0) ? (bx % 8) * (F.G / 8) + bx / 8 : bx; }
    int lo, hi;
    { ARGS_HERE(a0); F.ctl = (gu32*)(a0->ws + WS_CTL); lo = a0->ph_lo; hi = a0->ph_hi; }
    for (int u = F.wave * 64 + F.lane_now(); u < (LDS_BYTES - LDSCTL_OFF) / 4; u += NWAVES * 64) ((LAS unsigned*)(F.lds + LDSCTL_OFF))[u] = 0u;
    __syncthreads();
    XcdBarrier bar; bar.bar = (unsigned*)(F.ctl + CW_BAR); bar.x = 0; bar.st = nullptr;
    if (N_LAUNCHES == 1) bar = xcd_barrier_post((unsigned*)(F.ctl + CW_BAR), F.MISC + 8, F.wave * 64 + att::lane_of());
#ifndef PH_MASK
#define PH_MASK 0xFFF
#endif
#define IN(k) ((((PH_MASK) >> (k)) & 1) && lo <= (k) && (k) < hi)
#define SEAM(k) do { if (IN(k) && IN((k) + 1 + ((k) == 4))) xcd_barrier(bar, F.wave * 64 + att::lane_of()); } while (0)
#define WSP(T, off) ((T*)(a->ws + (off)))

#define PHASE(k) if (IN(k))
#ifndef ORD_MASK
#define ORD_MASK 0x404
#endif
#define ORD(k, m) ((F.G == 256 && (((ORD_MASK) >> (k)) & 1)) ? (m) : 0)

    PHASE(0) { ARGS_HERE(a); p0_prologue(F, a); } SEAM(0);
    PHASE(1) {
        ARGS_HERE(a);
        pg8::Gemm g{WSP(bf16, WS_HN), WSP(bf16, WS_WA), MP, 2 * DFF, DM}; pg8::StaticOrder S; S.init(MP, 2 * DFF, F.G, (int)blockIdx.x); S.mode = ORD(1, 2);
        pg8::EpiSwiglu E{WSP(bf16, WS_BIG), DFF, WSP(float, WS_RSTD)};
        pg8::gemm_phase<pg8::EpiSwiglu, pg8::StaticOrder, true, true>(F.lds + RING_OFF, g, S, E, F.wave);
        { int nidle; const int r = idle_rank(S, nidle);
          if (nidle == 0) p_weights(F, a, 1, F.vcu * NWAVES + F.wave, F.G * NWAVES); else if (r >= 0) p_weights(F, a, 1, r * NWAVES + F.wave, nidle * NWAVES); } } SEAM(1);
    PHASE(2) {
        ARGS_HERE(a);
        { MetaEpiDown ME{a->in[2], WSP(float, WS_HMETA), WSP(bf16, WS_HB)}; meta_gemm(F, WSP(bf16, WS_BIG) + (size_t)NTOK * DFF, DFF, WSP(bf16, WS_WD), DFF, DM / 16, ME); }
        pg8::Gemm g{WSP(bf16, WS_BIG), WSP(bf16, WS_WD), NTOK, DM, DFF}; pg8::StaticOrder S; S.init(NTOK, DM, F.G, (int)blockIdx.x); S.mode = ORD(2, 1);
        pg8::EpiRes<1, 1> E{nullptr, nullptr, WSP(bf16, WS_HN), nullptr, WSP(bf16, WS_HB), WSP(float, WS_SSQP), 0.5f, DM};
        pg8::gemm_phase<pg8::EpiRes<1, 1>, pg8::StaticOrder, false, true>(F.lds + RING_OFF, g, S, E, F.wave); } SEAM(2);
    PHASE(3) { ARGS_HERE(a); p_stats(F, a, 1); } SEAM(3);
    PHASE(4) {
        ARGS_HERE(a);
        { MetaEpiKV ME{WSP(float, WS_RSTD), WSP(bf16, WS_BIG), WSP(float, WS_ROPE)}; meta_gemm2(F, WSP(bf16, WS_HB) + (size_t)NTOK * DM, DM, WSP(bf16, WS_WIN), DM, 8192 / 32, ME); }
        pg8::Gemm g{WSP(bf16, WS_HB), WSP(bf16, WS_WIN), NTOK, IN_W, DM}; pg8::StaticOrder S; S.init(NTOK, IN_W, F.G, (int)blockIdx.x); S.mode = ORD(4, 1);
        pg8::EpiProj E{WSP(bf16, WS_BIG), IN_W, WSP(float, WS_RSTD), WSP(float, WS_ROPE), C_QD / 256, C_VD / 256};
        pg8::gemm_phase<pg8::EpiProj, pg8::StaticOrder, true, true>(F.lds + RING_OFF, g, S, E, F.wave); } SEAM(4);
    PHASE(6) { ARGS_HERE(a); p_attention(F, a); } SEAM(6);
    PHASE(7) {
        ARGS_HERE(a);
        pg8::Gemm g{WSP(bf16, WS_HN), WSP(bf16, WS_WOUT), NTOK, DM, DM}; pg8::StaticOrder S; S.init(NTOK, DM, F.G, (int)blockIdx.x); S.mode = ORD(7, 1);
        pg8::EpiRes<1, 1> E{nullptr, nullptr, WSP(bf16, WS_HB), nullptr, WSP(bf16, WS_HB), WSP(float, WS_SSQP), 1.0f, DM};
        const bool early = (((int)blockIdx.x >> 3) & 1) == 0;
        if (early) { p_weights(F, a, 2, F.vcu * NWAVES + F.wave, F.G * NWAVES); __syncthreads(); }
        pg8::gemm_phase<pg8::EpiRes<1, 1>, pg8::StaticOrder, false, true>(F.lds + RING_OFF, g, S, E, F.wave);
        if (!early) p_weights(F, a, 2, F.vcu * NWAVES + F.wave, F.G * NWAVES); } SEAM(7);
    PHASE(8) { ARGS_HERE(a); p_stats(F, a, 2); } SEAM(8);
    PHASE(9) {
        ARGS_HERE(a);
        pg8::Gemm g{WSP(bf16, WS_HB), WSP(bf16, WS_WA), NTOK, 2 * DFF, DM}; pg8::StaticOrder S; S.init(NTOK, 2 * DFF, F.G, (int)blockIdx.x); S.mode = ORD(9, 2);
        pg8::EpiSwiglu E{WSP(bf16, WS_BIG), DFF, WSP(float, WS_RSTD)};
        pg8::gemm_phase<pg8::EpiSwiglu, pg8::StaticOrder, true, true>(F.lds + RING_OFF, g, S, E, F.wave);
        { int nidle; const int r = idle_rank(S, nidle);
          if (nidle == 0) p_weights(F, a, 3, F.vcu * NWAVES + F.wave, F.G * NWAVES); else if (r >= 0) p_weights(F, a, 3, r * NWAVES + F.wave, nidle * NWAVES); } } SEAM(9);
    PHASE(10) {
        ARGS_HERE(a);
        pg8::Gemm g{WSP(bf16, WS_BIG), WSP(bf16, WS_WD), NTOK, DM, DFF}; pg8::StaticOrder S; S.init(NTOK, DM, F.G, (int)blockIdx.x); S.mode = ORD(10, 1);
        pg8::EpiRes<1, 1> E{nullptr, nullptr, WSP(bf16, WS_HB), nullptr, WSP(bf16, WS_H3), WSP(float, WS_SSQP), 0.5f, DM};
        pg8::gemm_phase<pg8::EpiRes<1, 1>, pg8::StaticOrder, false, true>(F.lds + RING_OFF, g, S, E, F.wave); } SEAM(10);
    PHASE(11) { ARGS_HERE(a); p_final(F, a); }
#undef PHASE
#undef IN
#undef SEAM
#undef WSP
}

extern "C" void kernel_launch(void* const* d_in, const int* in_sizes, int n_in, void* d_out, int out_size, void* d_ws, size_t ws_size, hipStream_t stream) {
    static int grid = 0;
    if (grid == 0) {
        if (n_in != 22 || in_sizes[0] != S_P * DM || in_sizes[1] != NB_S * S_S * DM || out_size != NTOK * DM || ws_size < WS_END) {
            fprintf(stderr, "kernel_launch: shape mismatch: n_in %d in0 %d in1 %d out %d ws %zu (need %zu)\n", n_in, n_in > 0 ? in_sizes[0] : -1, n_in > 1 ? in_sizes[1] : -1, out_size, ws_size, (size_t)WS_END); grid = -1; return; }
        int dev = 0, cus = 0, per_cu = 0;
        if (hipGetDevice(&dev) != hipSuccess || hipDeviceGetAttribute(&cus, hipDeviceAttributeMultiprocessorCount, dev) != hipSuccess) { grid = -1; return; }
        if (hipFuncSetAttribute((const void*)mk_fwd, hipFuncAttributeMaxDynamicSharedMemorySize, LDS_BYTES) != hipSuccess) { fprintf(stderr, "kernel_launch: hipFuncSetAttribute failed\n"); grid = -1; return; }
        if (hipOccupancyMaxActiveBlocksPerMultiprocessor(&per_cu, (const void*)mk_fwd, NWAVES * 64, LDS_BYTES) != hipSuccess || per_cu < 1)
            fprintf(stderr, "kernel_launch: note: occupancy query reports %d workgroups per CU\n", per_cu);
        (void)hipGetLastError();
        grid = cus;
    }
    if (grid < 0) return;
    if (hipMemsetAsync((char*)d_ws + WS_CTL, 0, CTL_ZERO_BYTES, stream) != hipSuccess) { fprintf(stderr, "kernel_launch: memset failed\n"); return; }
    Args a{};
    for (int i = 0; i < 22; ++i) a.in[i] = (const float*)d_in[i];
    a.out = (float*)d_out; a.ws = (unsigned char*)d_ws;
#if defined(PROBE_TWICE)
    for (int pass_ = 0; pass_ < 2; ++pass_)
#endif
    for (int li = 0; li < N_LAUNCHES; ++li) {
        a.ph_lo = (N_LAUNCHES == 1) ? 0 : li; a.ph_hi = (N_LAUNCHES == 1) ? N_PHASES : li + 1;
        hipLaunchKernelGGL(mk_fwd, dim3(grid), dim3(NWAVES * 64), LDS_BYTES, stream, a);
#if defined(PROBE_REPEAT)
#ifndef PROBE_TIMES
#define PROBE_TIMES 1
#endif
        if (N_LAUNCHES > 1 && (((PROBE_REPEAT) >> li) & 1)) for (int rp_ = 0; rp_ < PROBE_TIMES; ++rp_) hipLaunchKernelGGL(mk_fwd, dim3(grid), dim3(NWAVES * 64), LDS_BYTES, stream, a);
#endif
#if defined(PROBE_SEQ01)
        if (N_LAUNCHES > 1 && li == 1) { Args b = a; b.ph_lo = 0; b.ph_hi = 1; hipLaunchKernelGGL(mk_fwd, dim3(grid), dim3(NWAVES * 64), LDS_BYTES, stream, b); hipLaunchKernelGGL(mk_fwd, dim3(grid), dim3(NWAVES * 64), LDS_BYTES, stream, a); }
#endif
#if defined(PROBE_ROPE)
        if (N_LAUNCHES > 1 && li == 5) { Args b = a; b.probe = 1; hipLaunchKernelGGL(mk_fwd, dim3(grid), dim3(NWAVES * 64), LDS_BYTES, stream, b); hipLaunchKernelGGL(mk_fwd, dim3(grid), dim3(NWAVES * 64), LDS_BYTES, stream, a); }
#endif
#if defined(PROBE_REPEAT_ALT)
        if (N_LAUNCHES > 1 && (((PROBE_REPEAT_ALT) >> li) & 1)) { Args b = a; b.out = (float*)((unsigned char*)d_ws + WS_BIG); b.probe = PROBE_FOLD;
            hipLaunchKernelGGL(mk_fwd, dim3(grid), dim3(NWAVES * 64), LDS_BYTES, stream, b); }
#endif
        const hipError_t le = hipPeekAtLastError();
        if (le != hipSuccess) { fprintf(stderr, "kernel_launch: launch %d failed: %s\n", li, hipGetErrorName(le)); break; }
    }
#if defined(PROBE_APPEND)
    if (N_LAUNCHES > 1) for (int rp_ = 0; rp_ < PROBE_TIMES; ++rp_) for (int li = 0; li < N_PHASES; ++li) if (((PROBE_APPEND) >> li) & 1) {
        a.ph_lo = li; a.ph_hi = li + 1; hipLaunchKernelGGL(mk_fwd, dim3(grid), dim3(NWAVES * 64), LDS_BYTES, stream, a); }
#endif
}
```
